# Optimizing an MI355X kernel written in HIP

```python
import jax, jax.numpy as jnp
from jax import lax
import numpy as np

D_MODEL = 1024
BATCH = 4
SEQ = 4096
DEPTH = 1
DEC_BATCH = 8
DEC_SEQ = 16
PAST_LEN = 1024

CHUNK = 64
D_RNN = D_MODEL
N_LRU_BLOCKS = 16
LRU_BLOCK = D_RNN // N_LRU_BLOCKS
LRU_C = 8.0
RNN_CONV_W = 4
N_HEADS = 8
HEAD_DIM = D_MODEL // N_HEADS
D_ATTN = N_HEADS * HEAD_DIM
Q_BLOCK = 128
D_FF = 3 * D_MODEL
FFN_CONV_W = 3
NORM_EPS = 1e-6
D_IN = 2 * D_RNN + 3 * D_ATTN + 2 * D_MODEL

kernel_name = "hawk_stickbreak_convffn_stream"


def _rmsnorm(x, g):
    x32 = x.astype(jnp.float32)
    y = x32 * lax.rsqrt(jnp.mean(x32 * x32, axis=-1, keepdims=True) + NORM_EPS)
    return y.astype(x.dtype) * g


def _causal_dwconv(x, hist, w, b):
    W = w.shape[0]
    T = x.shape[1]
    xp = jnp.concatenate([hist.astype(x.dtype), x], axis=1)
    y = xp[:, 0:T] * w[0]
    for i in range(1, W):
        y = y + xp[:, i:i + T] * w[i]
    return y + b, xp[:, T:]


def _block_diag(x, w, b):
    B, T, C = x.shape
    xb = x.reshape(B, T, N_LRU_BLOCKS, LRU_BLOCK)
    return jnp.einsum('btnc,ncd->btnd', xb, w).reshape(B, T, C) + b


def _linear_scan(a, b, h0):
    b = b.at[:, 0].add(a[:, 0] * h0)
    def comb(l, r):
        return (l[0] * r[0], r[0] * l[1] + r[1])
    _, h = lax.associative_scan(comb, (a, b), axis=1)
    return h


def _rg_lru(x, h0, wa, ba, wx, bx, lam):
    r = jax.nn.sigmoid(_block_diag(x, wa, ba).astype(jnp.float32))
    i = jax.nn.sigmoid(_block_diag(x, wx, bx).astype(jnp.float32))
    log_a = -LRU_C * r * jax.nn.softplus(-lam.astype(jnp.float32))
    a = jnp.exp(log_a)
    b = jnp.sqrt(-jnp.expm1(2.0 * log_a)) * (i * x.astype(jnp.float32))
    h = _linear_scan(a, b, h0.astype(jnp.float32))
    return h.astype(x.dtype), h[:, -1].astype(x.dtype)


def _stick_breaking(q, k, v, q_pos, k_pos):
    z = jnp.einsum('bqhd,bkhd->bhqk', q, k).astype(jnp.float32) * (HEAD_DIM ** -0.5)
    mask = k_pos[None, :] < q_pos[:, None]
    log_beta = jax.nn.log_sigmoid(z)
    log_1m = jnp.where(mask, jax.nn.log_sigmoid(-z), 0.0)
    suffix = lax.cumsum(log_1m, axis=3, reverse=True) - log_1m
    w = jnp.where(mask, jnp.exp(log_beta + suffix), 0.0)
    return jnp.einsum('bhqk,bkhd->bqhd', w.astype(v.dtype), v)


def _stick_breaking_prompt(q, k, v):
    B, T, H, Dh = q.shape
    nb = T // Q_BLOCK
    qb = q.reshape(B, nb, Q_BLOCK, H, Dh).transpose(1, 0, 2, 3, 4)
    pos = jnp.arange(T, dtype=jnp.int32)
    qpos = pos.reshape(nb, Q_BLOCK)
    out = lax.map(lambda args: _stick_breaking(args[0], k, v, args[1], pos), (qb, qpos))
    return out.transpose(1, 0, 2, 3, 4).reshape(B, T, H, Dh)


def _layer(x, conv_hist, h0, k_past, v_past, ffn_hist,
           ln1, w_in, rnn_conv_w, rnn_conv_b, lru_wa, lru_ba, lru_wx, lru_bx, lru_lambda,
           q_norm_g, k_norm_g, w_proj_rnn, w_proj_attn, w_out,
           ln2, w_up, ffn_conv_w, ffn_conv_b, w_down):
    B, T, _ = x.shape
    u = _rmsnorm(x, ln1)
    proj = u @ w_in
    splits = [D_RNN, 2 * D_RNN, 2 * D_RNN + D_ATTN, 2 * D_RNN + 2 * D_ATTN,
              2 * D_RNN + 3 * D_ATTN, 2 * D_RNN + 3 * D_ATTN + D_MODEL]
    xr, gr, q, k, v, g_rnn, g_attn = jnp.split(proj, splits, axis=-1)
    xc, conv_tail = _causal_dwconv(xr, conv_hist, rnn_conv_w, rnn_conv_b)
    hseq, h_last = _rg_lru(xc, h0, lru_wa, lru_ba, lru_wx, lru_bx, lru_lambda)
    y_rnn = hseq * jax.nn.gelu(gr, approximate=True)
    q = _rmsnorm(q.reshape(B, T, N_HEADS, HEAD_DIM), q_norm_g)
    k = _rmsnorm(k.reshape(B, T, N_HEADS, HEAD_DIM), k_norm_g)
    v = v.reshape(B, T, N_HEADS, HEAD_DIM)
    if k_past is None:
        o = _stick_breaking_prompt(q, k, v)
    else:
        P = k_past.shape[1]
        k_all = jnp.concatenate([k_past.astype(k.dtype), k], axis=1)
        v_all = jnp.concatenate([v_past.astype(v.dtype), v], axis=1)
        q_pos = P + jnp.arange(T, dtype=jnp.int32)
        k_pos = jnp.arange(P + T, dtype=jnp.int32)
        o = _stick_breaking(q, k_all, v_all, q_pos, k_pos)
    y_attn = o.reshape(B, T, D_ATTN)
    merged = jax.nn.sigmoid(g_rnn) * (y_rnn @ w_proj_rnn) + jax.nn.sigmoid(g_attn) * (y_attn @ w_proj_attn)
    x = x + merged @ w_out
    u2 = _rmsnorm(x, ln2)
    gate_pre, val = jnp.split(u2 @ w_up, 2, axis=-1)
    gc, ffn_tail = _causal_dwconv(gate_pre, ffn_hist, ffn_conv_w, ffn_conv_b)
    x = x + (jax.nn.gelu(gc, approximate=True) * val) @ w_down
    return x, (k, v, conv_tail, h_last, ffn_tail)


def setup_inputs(seed: int = 0) -> dict:
    key = jax.random.key(seed)
    ks = iter(jax.random.split(key, 32))
    L = DEPTH
    def nrm(shape, scale=1.0):
        return jax.random.normal(next(ks), shape, jnp.float32) * scale
    u = jax.random.uniform(next(ks), (L, D_RNN), jnp.float32, minval=0.9, maxval=0.999)
    s = u ** (1.0 / LRU_C)
    return {
        "x_prompt": nrm((BATCH, SEQ, D_MODEL)),
        "x_sample": nrm((DEC_BATCH, DEC_SEQ, D_MODEL)),
        "cache_k": nrm((L, DEC_BATCH, PAST_LEN, N_HEADS, HEAD_DIM)),
        "cache_v": nrm((L, DEC_BATCH, PAST_LEN, N_HEADS, HEAD_DIM)),
        "state_rnn_conv": nrm((L, DEC_BATCH, RNN_CONV_W - 1, D_RNN)),
        "state_rnn_h": nrm((L, DEC_BATCH, D_RNN), 0.5),
        "state_ffn_conv": nrm((L, DEC_BATCH, FFN_CONV_W - 1, D_FF)),
        "ln1": 1.0 + nrm((L, D_MODEL), 0.01),
        "w_in": nrm((L, D_MODEL, D_IN), D_MODEL ** -0.5),
        "rnn_conv_w": nrm((L, RNN_CONV_W, D_RNN), RNN_CONV_W ** -0.5),
        "rnn_conv_b": nrm((L, D_RNN), 0.01),
        "lru_wa": nrm((L, N_LRU_BLOCKS, LRU_BLOCK, LRU_BLOCK), LRU_BLOCK ** -0.5),
        "lru_ba": nrm((L, D_RNN), 0.01),
        "lru_wx": nrm((L, N_LRU_BLOCKS, LRU_BLOCK, LRU_BLOCK), LRU_BLOCK ** -0.5),
        "lru_bx": nrm((L, D_RNN), 0.01),
        "lru_lambda": jnp.log(s) - jnp.log1p(-s),
        "q_norm_g": 1.0 + nrm((L, HEAD_DIM), 0.01),
        "k_norm_g": 1.0 + nrm((L, HEAD_DIM), 0.01),
        "w_proj_rnn": nrm((L, D_RNN, D_MODEL), D_RNN ** -0.5),
        "w_proj_attn": nrm((L, D_ATTN, D_MODEL), D_ATTN ** -0.5),
        "w_out": nrm((L, D_MODEL, D_MODEL), D_MODEL ** -0.5),
        "ln2": 1.0 + nrm((L, D_MODEL), 0.01),
        "w_up": nrm((L, D_MODEL, 2 * D_FF), D_MODEL ** -0.5),
        "ffn_conv_w": nrm((L, FFN_CONV_W, D_FF), FFN_CONV_W ** -0.5),
        "ffn_conv_b": nrm((L, D_FF), 0.01),
        "w_down": nrm((L, D_FF, D_MODEL), D_FF ** -0.5),
    }


def reference(x_prompt, x_sample, cache_k, cache_v, state_rnn_conv, state_rnn_h, state_ffn_conv,
              ln1, w_in, rnn_conv_w, rnn_conv_b, lru_wa, lru_ba, lru_wx, lru_bx, lru_lambda,
              q_norm_g, k_norm_g, w_proj_rnn, w_proj_attn, w_out,
              ln2, w_up, ffn_conv_w, ffn_conv_b, w_down):
    assert x_sample.shape[1] <= CHUNK
    yp, ys = x_prompt, x_sample
    Bp = x_prompt.shape[0]
    st_p, st_s = [], []
    for l in range(DEPTH):
        W = (ln1[l], w_in[l], rnn_conv_w[l], rnn_conv_b[l], lru_wa[l], lru_ba[l], lru_wx[l], lru_bx[l],
             lru_lambda[l], q_norm_g[l], k_norm_g[l], w_proj_rnn[l], w_proj_attn[l], w_out[l],
             ln2[l], w_up[l], ffn_conv_w[l], ffn_conv_b[l], w_down[l])
        zc = jnp.zeros((Bp, RNN_CONV_W - 1, D_RNN), yp.dtype)
        zh = jnp.zeros((Bp, D_RNN), yp.dtype)
        zf = jnp.zeros((Bp, FFN_CONV_W - 1, D_FF), yp.dtype)
        yp, sp = _layer(yp, zc, zh, None, None, zf, *W)
        ys, ss = _layer(ys, state_rnn_conv[l], state_rnn_h[l], cache_k[l], cache_v[l], state_ffn_conv[l], *W)
        st_p.append(sp)
        st_s.append(ss)
    k_p = jnp.stack([s[0] for s in st_p])
    v_p = jnp.stack([s[1] for s in st_p])
    rc_p = jnp.stack([s[2] for s in st_p])
    h_p = jnp.stack([s[3] for s in st_p])
    fc_p = jnp.stack([s[4] for s in st_p])
    k_s = jnp.stack([s[0] for s in st_s])
    v_s = jnp.stack([s[1] for s in st_s])
    rc_s = jnp.stack([s[2] for s in st_s])
    h_s = jnp.stack([s[3] for s in st_s])
    fc_s = jnp.stack([s[4] for s in st_s])
    return (yp, ys, k_p, v_p, rc_p, h_p, fc_p, k_s, v_s, rc_s, h_s, fc_s)
```

```cpp
#include <hip/hip_runtime.h>
#include <hip/hip_cooperative_groups.h>
#include <cstdio>
#include <cstdint>
#include <cmath>
namespace cg = cooperative_groups;
#ifndef PH_MASK
#define PH_MASK 0x1ff
#endif
namespace pg8 {
#define PG8_LAS __attribute__((address_space(3)))
typedef unsigned short bf16_t;
typedef short bf16x8 __attribute__((ext_vector_type(8)));
typedef float f32x4 __attribute__((ext_vector_type(4)));
typedef unsigned u32x4 __attribute__((ext_vector_type(4)));
constexpr int BM = 256, BK = 64, HALF = 128, HTB = HALF * BK * 2  , STAGE_BYTES = 8 * HTB, NXCD = 8, WGM = 8;

__host__ __device__ __forceinline__ int lds_byte(int r, int c) { const int st = (r >> 4) * 2 + (c >> 5), rr = r & 15, cc = c & 31, ob = rr * 64 + cc * 2; return st * 1024 + (ob ^ (((ob >> 9) & 1) << 5)); }
__host__ __device__ __forceinline__ void stage_rc(int b, int& R, int& C) { const int st = b / 1024, sb = b % 1024, swz = sb ^ (((sb >> 9) & 1) << 5); R = (st >> 1) * 16 + swz / 64; C = (st & 1) * 32 + (swz % 64) / 2; }
__host__ __device__ __forceinline__ int perm32(int rho) { const int n = rho >> 4, i = rho & 15; return 8 * (i >> 2) + 4 * n + (i & 3); }

struct Unit { int pm, pn; };
struct Gemm { const bf16_t* A; const bf16_t* Bt; int M, N, K; };

struct StaticOrder {
    int nM, nN, nwg, G, c;
    __host__ __device__ void init(int M, int N, int G_, int c_) { nM = M / BM; nN = N / BM; nwg = nM * nN; G = G_; c = c_; }
    __host__ __device__ bool next(int i, Unit& u) const {
        const long L = (long)i * G + c; if (L >= nwg) return false;
        int wgid = (int)L; { const int q = nwg / NXCD, r = nwg % NXCD, xcd = wgid % NXCD, off = wgid / NXCD; wgid = (xcd < r ? xcd * (q + 1) : r * (q + 1) + (xcd - r) * q) + off; }
        const int nig = WGM * nN, gid = wgid / nig, fm = gid * WGM, gsz = (nM - fm) < WGM ? (nM - fm) : WGM;
        u.pm = fm + ((wgid % nig) % gsz); u.pn = (wgid % nig) / gsz; return true;
    }
    __device__ __forceinline__ void a_ready(const Unit&) const {}
    __device__ __forceinline__ void done(const Unit&) const {}
};

__device__ __forceinline__ unsigned cvt_pk_bf16(float lo, float hi) { unsigned r; asm volatile("v_cvt_pk_bf16_f32 %0, %1, %2" : "=v"(r) : "v"(lo), "v"(hi)); return r; }
typedef float f32x2 __attribute__((ext_vector_type(2)));
__device__ __forceinline__ f32x2 gelu_pk(f32x2 v) {
    const f32x2 av = __builtin_elementwise_abs(v), d = av * 0.2316418882f + 1.0f;
    f32x2 t; t.x = __builtin_amdgcn_rcpf(d.x); t.y = __builtin_amdgcn_rcpf(d.y);
    f32x2 q = t * 0.5307027145f + (-0.7265760135f); q = q * t + 0.7107068705f; q = q * t + (-0.142248368f); q = q * t + 0.127414796f; q = q * t;
    const f32x2 s = (v * v) * (-0.72134752044f);
    f32x2 e; e.x = __builtin_amdgcn_exp2f(s.x); e.y = __builtin_amdgcn_exp2f(s.y);
    const f32x2 m = v * (q * e), r = v - m;
    f32x2 o; o.x = v.x < 0.f ? m.x : r.x; o.y = v.y < 0.f ? m.y : r.y; return o;
}

template <int ACT  > struct EpiBf16 {
    static constexpr bool PERM = true, AFTER_DRAIN = false; static_assert(ACT == 0 || ACT == 1, "EpiBf16: ACT is 0 (none) or 1 (gelu_pk)");
    bf16_t* O; int ldc; const float* bias; int split_cols; size_t split_stride; float scale0;
    __device__ __forceinline__ void operator()(const f32x4 (&acc)[2][2][4][2], const Unit& u, int wr, int wc, int fr, int fq) const {
        const int row0 = u.pm * BM + wr * 64 + fr; int colt = u.pn * BM; bf16_t* base = O;
        float sc = 1.f; if (split_cols) { const int t = colt / split_cols; base += (size_t)t * split_stride; colt -= t * split_cols; if (t == 0) sc = scale0; }
        const int col0 = colt + wc * 32 + 8 * fq, bcol0 = u.pn * BM + wc * 32 + 8 * fq;
        f32x4 bv[2][2];
#pragma unroll
        for (int bj = 0; bj < 2; ++bj)
#pragma unroll
            for (int n = 0; n < 2; ++n) bv[bj][n] = bias ? *(const f32x4*)(bias + bcol0 + bj * HALF + 4 * n) : (f32x4){0.f, 0.f, 0.f, 0.f};
#pragma unroll
        for (int ai = 0; ai < 2; ++ai)
#pragma unroll
            for (int m = 0; m < 4; ++m) { bf16_t* rowp = base + (size_t)(row0 + ai * HALF + m * 16) * ldc + col0;
#pragma unroll
                for (int bj = 0; bj < 2; ++bj) { f32x4 v0 = acc[ai][bj][m][0] + bv[bj][0], v1 = acc[ai][bj][m][1] + bv[bj][1];
                    if (ACT == 1) { f32x2 a = gelu_pk((f32x2){v0[0], v0[1]}), b = gelu_pk((f32x2){v0[2], v0[3]}), c = gelu_pk((f32x2){v1[0], v1[1]}), d = gelu_pk((f32x2){v1[2], v1[3]});
                        v0 = (f32x4){a.x, a.y, b.x, b.y}; v1 = (f32x4){c.x, c.y, d.x, d.y}; }
                    v0 = v0 * sc; v1 = v1 * sc; u32x4 w; w.x = cvt_pk_bf16(v0[0], v0[1]); w.y = cvt_pk_bf16(v0[2], v0[3]); w.z = cvt_pk_bf16(v1[0], v1[1]); w.w = cvt_pk_bf16(v1[2], v1[3]);
                    *(u32x4*)(rowp + bj * HALF) = w; } }
    }
};
template <class Epi, class Sched, bool ALIGN_EPI = false, bool SP2 = false>
__device__ __forceinline__ void gemm_phase(PG8_LAS unsigned char* lds, const Gemm g, const Sched& S, const Epi& E) {
    int tid_l = threadIdx.x; asm volatile("" : "+v"(tid_l));
    const int tid = tid_l, wid = __builtin_amdgcn_readfirstlane(tid >> 6), lane = tid & 63, wr = wid >> 2, wc = wid & 3, fr = lane & 15, fq = lane >> 4;
    const int K = g.K, nt = K / BK;
    unsigned voffA[2], voffB[2];
#pragma unroll
    for (int i = 0; i < 2; ++i) { int R, C; stage_rc(tid * 16 + i * 8192, R, C); const int Rb = Epi::PERM ? ((R & ~31) + perm32(R & 31)) : R;
        voffA[i] = (unsigned)(R * K + C) * 2u; voffB[i] = (unsigned)(Rb * K + C) * 2u; }
    const size_t kstep = (size_t)(BK * 2);
    const size_t hstep = (size_t)HALF * K * 2;
    const size_t tstep = 2 * hstep;
    const unsigned ldsw = (unsigned)wid * 1024u;
    const int aoff = lds_byte(wr * 64 + fr, fq * 8), boff = lds_byte(wc * 32 + fr, fq * 8);
#define PG8_SA(b, h) (((b) * 2 + (h)) * HTB)
#define PG8_SB(b, h) ((4 + (b) * 2 + (h)) * HTB)
#define PG8_STAGE(bufoff, gbase, voff) do { _Pragma("unroll") for (int _i = 0; _i < 2; ++_i) \
        __builtin_amdgcn_global_load_lds((const unsigned*)((const char*)(gbase) + (voff)[_i]), (PG8_LAS unsigned*)(lds + (bufoff) + ldsw + _i * 8192), 16, 0, 0); } while (0)
#define PG8_LDA(dst, b, h) do { _Pragma("unroll") for (int m = 0; m < 4; ++m) _Pragma("unroll") for (int k = 0; k < 2; ++k) dst[m][k] = *(const PG8_LAS bf16x8*)(lds + PG8_SA(b, h) + aoff + m * 2048 + k * 1024); } while (0)
#define PG8_LDB(dst, b, h) do { _Pragma("unroll") for (int n = 0; n < 2; ++n) _Pragma("unroll") for (int k = 0; k < 2; ++k) dst[n][k] = *(const PG8_LAS bf16x8*)(lds + PG8_SB(b, h) + boff + n * 2048 + k * 1024); } while (0)
#define PG8_MMA(ai, bj, At, Bt) do { __builtin_amdgcn_s_setprio(1); _Pragma("unroll") for (int m = 0; m < 4; ++m) _Pragma("unroll") for (int n = 0; n < 2; ++n) _Pragma("unroll") for (int k = 0; k < 2; ++k) \
        acc[ai][bj][m][n] = __builtin_amdgcn_mfma_f32_16x16x32_bf16(Bt[n][k], At[m][k], acc[ai][bj][m][n], 0, 0, 0); __builtin_amdgcn_s_setprio(0); } while (0)
#define PG8_WAIT_V(n) asm volatile("s_waitcnt vmcnt(" #n ")" ::: "memory")
#define PG8_WAIT_L(n) asm volatile("s_waitcnt lgkmcnt(" #n ")" ::: "memory")
#define PG8_BAR __builtin_amdgcn_s_barrier()
#define PG8_SCHED __builtin_amdgcn_sched_barrier(0)
    Unit cur, nxt; int ui = 0;
    if (!S.next(0, cur)) return;
    f32x4 acc[2][2][4][2];
#pragma unroll
    for (int a = 0; a < 2; ++a)
#pragma unroll
        for (int b = 0; b < 2; ++b)
#pragma unroll
            for (int m = 0; m < 4; ++m)
#pragma unroll
                for (int n = 0; n < 2; ++n) acc[a][b][m][n] = (f32x4){0.f, 0.f, 0.f, 0.f};
    bf16x8 At[4][2], B0[2][2], B1[2][2];
    const char* cA = (const char*)g.A + (size_t)cur.pm * tstep; const char* cB = (const char*)g.Bt + (size_t)cur.pn * tstep;
    S.a_ready(cur);
    if constexpr (SP2) {
        PG8_STAGE(PG8_SB(0, 0), cB, voffB); PG8_STAGE(PG8_SB(0, 1), cB + hstep, voffB); PG8_STAGE(PG8_SA(0, 0), cA, voffA); PG8_STAGE(PG8_SA(0, 1), cA + hstep, voffA);
        if (wr == 1) PG8_BAR;
        PG8_WAIT_V(2); PG8_BAR;
        PG8_STAGE(PG8_SB(1, 0), cB + kstep, voffB); PG8_STAGE(PG8_SA(1, 0), cA + kstep, voffA); PG8_STAGE(PG8_SB(1, 1), cB + hstep + kstep, voffB);
        PG8_WAIT_V(6); PG8_BAR;
    } else {
        PG8_STAGE(PG8_SB(0, 0), cB, voffB); PG8_STAGE(PG8_SA(0, 0), cA, voffA); PG8_STAGE(PG8_SB(0, 1), cB + hstep, voffB); PG8_STAGE(PG8_SA(0, 1), cA + hstep, voffA);
        if (wr == 1) PG8_BAR;
        PG8_WAIT_V(4); PG8_BAR;
        PG8_STAGE(PG8_SB(1, 0), cB + kstep, voffB); PG8_STAGE(PG8_SA(1, 0), cA + kstep, voffA); PG8_STAGE(PG8_SB(1, 1), cB + hstep + kstep, voffB);
        PG8_WAIT_V(6); PG8_BAR;
    }
    for (;;) {
        const bool has_next = S.next(ui + 1, nxt);
        const char* nA = has_next ? (const char*)g.A + (size_t)nxt.pm * tstep : cA; const char* nB = has_next ? (const char*)g.Bt + (size_t)nxt.pn * tstep : cB;
        for (int t = 0; t < nt; t += 2) {
            const bool last = (t == nt - 2);
            const char* a1 = cA + (size_t)(t + 1) * kstep;
            const char* a2 = last ? nA : cA + (size_t)(t + 2) * kstep; const char* b2 = last ? nB : cB + (size_t)(t + 2) * kstep;
            const char* a3 = a2 + kstep; const char* b3 = b2 + kstep;
            if (last && has_next) S.a_ready(nxt);
            if constexpr (SP2) {
            PG8_LDB(B0, 0, 0); PG8_LDB(B1, 0, 1); PG8_SCHED; PG8_LDA(At, 0, 0); PG8_STAGE(PG8_SA(1, 1), a1 + hstep, voffA);
            PG8_WAIT_V(8); PG8_WAIT_L(0); PG8_BAR; PG8_MMA(0, 0, At, B0); PG8_MMA(0, 1, At, B1); PG8_BAR; PG8_SCHED;
            PG8_LDA(At, 0, 1); PG8_STAGE(PG8_SB(0, 0), b2, voffB); PG8_STAGE(PG8_SB(0, 1), b2 + hstep, voffB); PG8_STAGE(PG8_SA(0, 0), a2, voffA);
            PG8_WAIT_V(8); PG8_WAIT_L(0); PG8_BAR; PG8_MMA(1, 0, At, B0); PG8_MMA(1, 1, At, B1); PG8_BAR; PG8_SCHED;
            PG8_LDB(B0, 1, 0); PG8_LDB(B1, 1, 1); PG8_SCHED; PG8_LDA(At, 1, 0); PG8_STAGE(PG8_SA(0, 1), a2 + hstep, voffA);
            PG8_WAIT_V(8); PG8_WAIT_L(0); PG8_BAR; PG8_MMA(0, 0, At, B0); PG8_MMA(0, 1, At, B1); PG8_BAR; PG8_SCHED;
            PG8_LDA(At, 1, 1); PG8_STAGE(PG8_SB(1, 0), b3, voffB); PG8_STAGE(PG8_SB(1, 1), b3 + hstep, voffB); PG8_STAGE(PG8_SA(1, 0), a3, voffA);
            PG8_WAIT_V(8); PG8_WAIT_L(0); PG8_BAR; PG8_MMA(1, 0, At, B0); PG8_MMA(1, 1, At, B1); PG8_BAR; PG8_SCHED;
            } else {
            PG8_LDB(B0, 0, 0); PG8_SCHED; PG8_LDA(At, 0, 0); PG8_STAGE(PG8_SA(1, 1), a1 + hstep, voffA);
            PG8_WAIT_L(8); PG8_BAR; PG8_WAIT_L(0); PG8_MMA(0, 0, At, B0); PG8_BAR; PG8_SCHED;
            PG8_LDB(B1, 0, 1); PG8_STAGE(PG8_SB(0, 0), b2, voffB);
            PG8_BAR; PG8_WAIT_L(0); PG8_MMA(0, 1, At, B1); PG8_BAR;
            PG8_LDA(At, 0, 1); PG8_STAGE(PG8_SA(0, 0), a2, voffA);
            PG8_BAR; PG8_WAIT_L(0); PG8_MMA(1, 0, At, B0); PG8_BAR; PG8_SCHED;
            PG8_STAGE(PG8_SB(0, 1), b2 + hstep, voffB);
            PG8_WAIT_V(6); PG8_BAR; PG8_MMA(1, 1, At, B1); PG8_BAR;
            PG8_LDB(B0, 1, 0); PG8_SCHED; PG8_LDA(At, 1, 0); PG8_STAGE(PG8_SA(0, 1), a2 + hstep, voffA);
            PG8_WAIT_L(8); PG8_BAR; PG8_WAIT_L(0); PG8_MMA(0, 0, At, B0); PG8_BAR; PG8_SCHED;
            PG8_LDB(B1, 1, 1); PG8_STAGE(PG8_SB(1, 0), b3, voffB);
            PG8_BAR; PG8_WAIT_L(0); PG8_MMA(0, 1, At, B1); PG8_BAR;
            PG8_LDA(At, 1, 1); PG8_STAGE(PG8_SA(1, 0), a3, voffA);
            PG8_BAR; PG8_WAIT_L(0); PG8_MMA(1, 0, At, B0); PG8_BAR; PG8_SCHED;
            PG8_STAGE(PG8_SB(1, 1), b3 + hstep, voffB);
            PG8_WAIT_V(6); PG8_BAR; PG8_MMA(1, 1, At, B1); PG8_BAR;
            }
        }
        if constexpr (ALIGN_EPI) { if (wr == 0) PG8_BAR; }
        if constexpr (!Epi::AFTER_DRAIN) { E(acc, cur, wr, wc, fr, fq); S.done(cur); }
        if (!has_next) break;
#pragma unroll
        for (int a = 0; a < 2; ++a)
#pragma unroll
            for (int b = 0; b < 2; ++b)
#pragma unroll
                for (int m = 0; m < 4; ++m)
#pragma unroll
                    for (int n = 0; n < 2; ++n) acc[a][b][m][n] = (f32x4){0.f, 0.f, 0.f, 0.f};
        cur = nxt; cA = nA; cB = nB; ++ui;
        if constexpr (ALIGN_EPI) { if (wr == 1) PG8_BAR; }
    }
    PG8_WAIT_V(0);
    if constexpr (!ALIGN_EPI) { if (wr == 0) PG8_BAR; }
    PG8_BAR;
    if constexpr (Epi::AFTER_DRAIN) { E.fused(acc, cur, wr, wc, fr, fq, lds, wid, lane); S.done(cur); }
#undef PG8_SA
#undef PG8_SB
#undef PG8_STAGE
#undef PG8_LDA
#undef PG8_LDB
#undef PG8_MMA
#undef PG8_WAIT_V
#undef PG8_WAIT_L
#undef PG8_BAR
#undef PG8_SCHED
}
}

#define LAS __attribute__((address_space(3)))
typedef unsigned short bf16;
typedef float f32x4 __attribute__((ext_vector_type(4)));
typedef float f32x2 __attribute__((ext_vector_type(2)));
typedef float f32x16 __attribute__((ext_vector_type(16)));
typedef short bf16x8 __attribute__((ext_vector_type(8)));
typedef unsigned u32x4 __attribute__((ext_vector_type(4)));
typedef unsigned u32x2 __attribute__((ext_vector_type(2)));
typedef __bf16 bf16x2_t __attribute__((ext_vector_type(2)));

constexpr int D = 1024, BP = 4, TP = 4096, MPR = BP * TP, BS = 8, TS = 16, MS = BS * TS, MROWS = MPR + MS, MP = 16640;
constexpr int PAST = 1024, NH = 8, HD = 128, DFF = 3072, DIN = 7168;
constexpr float EPS = 1e-6f;
constexpr int NCHUNK = TP / 64;

constexpr size_t O_YP = 0, O_YS = O_YP + (size_t)MPR * D, O_KP = O_YS + (size_t)MS * D, O_VP = O_KP + (size_t)MPR * D,
                 O_RCP = O_VP + (size_t)MPR * D, O_HP = O_RCP + (size_t)BP * 3 * D, O_FCP = O_HP + (size_t)BP * D,
                 O_KS = O_FCP + (size_t)BP * 2 * DFF, O_VS = O_KS + (size_t)MS * D, O_RCS = O_VS + (size_t)MS * D,
                 O_HS = O_RCS + (size_t)BS * 3 * D, O_FCS = O_HS + (size_t)BS * D, O_END = O_FCS + (size_t)BS * 2 * DFF;

constexpr size_t MiB = 1u << 20;
constexpr size_t SLOT = (size_t)MP * D * 2;
constexpr size_t WS_CTL = 0, CTL_BYTES = 1 * MiB;
constexpr size_t WS_WUP = 1 * MiB, WS_WDN = 13 * MiB, WS_WPR = 19 * MiB, WS_WPA = 21 * MiB, WS_WOUT = 23 * MiB, WS_WAT = 25 * MiB, WS_WXT = WS_WAT + 131072;
constexpr size_t WS_S0 = 25 * MiB + 262144;
constexpr size_t WS_S1 = WS_S0 + SLOT, WS_S2 = WS_S1 + SLOT, WS_S3 = WS_S2 + SLOT, WS_S4 = WS_S3 + SLOT, WS_S5 = WS_S4 + SLOT, WS_S6 = WS_S5 + SLOT;
constexpr size_t WS_VTS = WS_S6 + SLOT, WS_SUMP = WS_VTS + 1 * MiB, WS_SUMH = WS_SUMP + 1 * MiB, WS_END = WS_SUMH + 1 * MiB;
static_assert(WS_END <= 256 * MiB, "workspace map exceeds 256 MiB");

constexpr int LDS_BYTES = 147456;
constexpr int LDS_SCR = 131072;

__device__ __forceinline__ unsigned pk2(float lo, float hi) { f32x2 v = {lo, hi}; bf16x2_t b = __builtin_convertvector(v, bf16x2_t); return __builtin_bit_cast(unsigned, b); }
__device__ __forceinline__ float bf2f(unsigned short x) { return __uint_as_float((unsigned)x << 16); }
__device__ __forceinline__ float bflo(unsigned x) { return __uint_as_float(x << 16); }
__device__ __forceinline__ float bfhi(unsigned x) { return __uint_as_float(x & 0xffff0000u); }
__device__ __forceinline__ float sigmoid_f(float x) { return __builtin_amdgcn_rcpf(1.f + __expf(-x)); }
__device__ __forceinline__ float gelu_f(float x) { const float u = 1.5957691216057308f * (x + 0.044715f * x * x * x); return x * sigmoid_f(u); }
__device__ __forceinline__ float softplus_f(float z) { return fmaxf(z, 0.f) + __logf(1.f + __expf(-fabsf(z))); }
__device__ __forceinline__ float wave_sum(float v) {
#pragma unroll
    for (int o = 1; o < 64; o <<= 1) v += __shfl_xor(v, o);
    return v;
}
__device__ __forceinline__ void unpack8(const u32x4 w, float (&f)[8]) {
    f[0] = bflo(w.x); f[1] = bfhi(w.x); f[2] = bflo(w.y); f[3] = bfhi(w.y); f[4] = bflo(w.z); f[5] = bfhi(w.z); f[6] = bflo(w.w); f[7] = bfhi(w.w);
}

struct Params { const float* in[26]; float* out; unsigned char* ws; };
#define WSB(off) ((bf16*)(p.ws + (off)))
#define D0 ((bf16*)p.out)
#define D1 (((bf16*)p.out) + (size_t)MROWS * D)
#define WUP WSB(WS_WUP)
#define WDN WSB(WS_WDN)
#define WPR WSB(WS_WPR)
#define WPA WSB(WS_WPA)
#define WOUT WSB(WS_WOUT)
#define WAT WSB(WS_WAT)
#define WXT WSB(WS_WXT)
#define S0 WSB(WS_S0)
#define S1 WSB(WS_S1)
#define S2 WSB(WS_S2)
#define S3 WSB(WS_S3)
#define S4 WSB(WS_S4)
#define S5 WSB(WS_S5)
#define S6 WSB(WS_S6)
#define VTs WSB(WS_VTS)
#define SUMP ((float*)(p.ws + WS_SUMP))
#define SUMH ((float*)(p.ws + WS_SUMH))
#define SS2 ((float*)(p.ws + WS_CTL))
#define U1 D0
#define XR D1
#define GG S0
#define QN S1
#define KN S2
#define VT S3
#define SG1 S4
#define SG2 S5
#define WIN S6
#define T1 ((float*)(p.ws + WS_S2))
#define MG S6
#define U2 S0
#define GP S1
#define VAL S4

__device__ __forceinline__ void p0_transpose_item(const float* W, int K, int N, bf16* WT, LAS float* scr, int item, int lane) {
    const int nblk = N / 32, kb = item / nblk, nb = item % nblk, k0 = 64 * kb, n0 = 32 * nb;
#pragma unroll 8
    for (int i = 0; i < 32; ++i) { const int kk = 2 * i + (lane >> 5); scr[kk * 33 + (lane & 31)] = W[(size_t)(k0 + kk) * N + n0 + (lane & 31)]; }
    asm volatile("s_waitcnt lgkmcnt(0)" ::: "memory");
    const int c = lane & 7;
#pragma unroll
    for (int j = 0; j < 4; ++j) { const int n = (lane >> 3) + 8 * j; const LAS float* s = scr + (8 * c) * 33 + n;
        u32x4 o; o.x = pk2(s[0 * 33], s[1 * 33]); o.y = pk2(s[2 * 33], s[3 * 33]); o.z = pk2(s[4 * 33], s[5 * 33]); o.w = pk2(s[6 * 33], s[7 * 33]);
        *(u32x4*)(WT + (size_t)(n0 + n) * K + k0 + 8 * c) = o; }
    asm volatile("s_waitcnt lgkmcnt(0)" ::: "memory");
}
__device__ __forceinline__ void rms_row(const float* xrow, const float* g, bf16* orow, int lane) {
    const f32x4* xr = (const f32x4*)xrow + lane; const f32x4* gr = (const f32x4*)g + lane;
    f32x4 v[4]; float s = 0.f;
#pragma unroll
    for (int j = 0; j < 4; ++j) { v[j] = xr[64 * j]; s += (v[j].x * v[j].x + v[j].y * v[j].y) + (v[j].z * v[j].z + v[j].w * v[j].w); }
    const float rs = rsqrtf(wave_sum(s) * (1.f / D) + EPS);
    u32x2* o8 = (u32x2*)orow + lane;
#pragma unroll
    for (int j = 0; j < 4; ++j) { const f32x4 gv = gr[64 * j]; u32x2 o; o.x = pk2(v[j].x * rs * gv.x, v[j].y * rs * gv.y); o.y = pk2(v[j].z * rs * gv.z, v[j].w * rs * gv.w); o8[64 * j] = o; }
}

#define EPI_ARGS const f32x4 (&acc)[2][2][4][2], const pg8::Unit& u, int wr, int wc, int fr, int fq

struct EpiIn {
    static constexpr bool PERM = true, AFTER_DRAIN = false;
    bf16 *xr_, *gg_, *qn_, *kn_, *vt_, *vts_, *sg1_, *sg2_; float* out; const float *qg, *kg; LAS float* scr;
    __device__ __forceinline__ void operator()(EPI_ARGS) const {
        const int seg = u.pn >> 2, cb = (u.pn & 3) * 256;
        const int rbase = u.pm * 256 + wr * 64 + fr;
        const int cl = wc * 32 + 8 * fq;
        if (seg == 2 || seg == 3) {
#pragma unroll
            for (int ai = 0; ai < 2; ++ai)
#pragma unroll
                for (int m = 0; m < 4; ++m)
#pragma unroll
                    for (int bj = 0; bj < 2; ++bj) {
                        const f32x4 a = acc[ai][bj][m][0], b = acc[ai][bj][m][1];
                        float s = (a.x * a.x + a.y * a.y) + (a.z * a.z + a.w * a.w) + (b.x * b.x + b.y * b.y) + (b.z * b.z + b.w * b.w);
                        s += __shfl_xor(s, 16); s += __shfl_xor(s, 32);
                        if (fq == 0) scr[((ai * 128 + wr * 64 + m * 16 + fr) * 2 + bj) * 4 + wc] = s;
                    }
            asm volatile("s_waitcnt lgkmcnt(0)" ::: "memory"); __builtin_amdgcn_s_barrier(); asm volatile("" ::: "memory");
            const float* gain = (seg == 2) ? qg : kg; const float osc = (seg == 2) ? 0.08838834764831845f : 1.0f;
            const f32x4 g0 = *(const f32x4*)(gain + cl), g1 = *(const f32x4*)(gain + cl + 4);
            bf16* dst = (seg == 2) ? qn_ : kn_;
#pragma unroll
            for (int ai = 0; ai < 2; ++ai)
#pragma unroll
                for (int m = 0; m < 4; ++m) {
                    const int r = rbase + ai * 128 + m * 16;
#pragma unroll
                    for (int bj = 0; bj < 2; ++bj) {
                        const f32x4 pp = *(const LAS f32x4*)(scr + ((ai * 128 + wr * 64 + m * 16 + fr) * 2 + bj) * 4);
                        const float rs = rsqrtf(((pp.x + pp.y) + (pp.z + pp.w)) * (1.f / HD) + EPS);
                        const f32x4 a = acc[ai][bj][m][0] * rs * g0, b = acc[ai][bj][m][1] * rs * g1;
                        const int col = cb + bj * 128 + cl;
                        u32x4 w; w.x = pk2(a.x * osc, a.y * osc); w.y = pk2(a.z * osc, a.w * osc); w.z = pk2(b.x * osc, b.y * osc); w.w = pk2(b.z * osc, b.w * osc);
                        *(u32x4*)(dst + (size_t)r * D + col) = w;
                        if (seg == 3 && r < MROWS) {
                            float* o = out + (r < MPR ? O_KP + (size_t)r * D : O_KS + (size_t)(r - MPR) * D) + col;
                            *(f32x4*)o = a; *(f32x4*)(o + 4) = b;
                        }
                    }
                }
        } else if (seg == 4) {
#pragma unroll
            for (int ai = 0; ai < 2; ++ai)
#pragma unroll
                for (int m = 0; m < 4; ++m) {
                    const int r = rbase + ai * 128 + m * 16;
                    if (r < MROWS) {
#pragma unroll
                        for (int bj = 0; bj < 2; ++bj) {
                            const f32x4 a = acc[ai][bj][m][0], b = acc[ai][bj][m][1];
                            const int col = cb + bj * 128 + cl, hh = (cb + bj * 128) >> 7;
                            float* o = out + (r < MPR ? O_VP + (size_t)r * D : O_VS + (size_t)(r - MPR) * D) + col;
                            *(f32x4*)o = a; *(f32x4*)(o + 4) = b;
                            bf16* vt; size_t rl;
                            if (r < MPR) { const int bb = r >> 12, t = r & (TP - 1); vt = vt_ + ((size_t)(bb * NH + hh) * HD + cl) * TP + t; rl = TP; }
                            else { const int sb = (r - MPR) >> 4, t = (r - MPR) & 15; vt = vts_ + ((size_t)(sb * NH + hh) * HD + cl) * 64 + t; rl = 64; }
                            const unsigned p0 = pk2(a.x, a.y), p1 = pk2(a.z, a.w), p2 = pk2(b.x, b.y), p3 = pk2(b.z, b.w);
                            vt[0 * rl] = (bf16)p0; vt[1 * rl] = (bf16)(p0 >> 16); vt[2 * rl] = (bf16)p1; vt[3 * rl] = (bf16)(p1 >> 16);
                            vt[4 * rl] = (bf16)p2; vt[5 * rl] = (bf16)(p2 >> 16); vt[6 * rl] = (bf16)p3; vt[7 * rl] = (bf16)(p3 >> 16);
                        }
                    }
                }
        } else {
            bf16* dst = (seg == 0) ? xr_ : (seg == 1) ? gg_ : (seg == 5) ? sg1_ : sg2_;
            const int rlim = (seg == 0) ? MROWS : MP;
#pragma unroll
            for (int ai = 0; ai < 2; ++ai)
#pragma unroll
                for (int m = 0; m < 4; ++m) {
                    const int r = rbase + ai * 128 + m * 16;
                    if (r < rlim) {
#pragma unroll
                        for (int bj = 0; bj < 2; ++bj) {
                            f32x4 a = acc[ai][bj][m][0], b = acc[ai][bj][m][1];
                            if (seg == 1) { a.x = gelu_f(a.x); a.y = gelu_f(a.y); a.z = gelu_f(a.z); a.w = gelu_f(a.w); b.x = gelu_f(b.x); b.y = gelu_f(b.y); b.z = gelu_f(b.z); b.w = gelu_f(b.w); }
                            else if (seg >= 5) { a.x = sigmoid_f(a.x); a.y = sigmoid_f(a.y); a.z = sigmoid_f(a.z); a.w = sigmoid_f(a.w); b.x = sigmoid_f(b.x); b.y = sigmoid_f(b.y); b.z = sigmoid_f(b.z); b.w = sigmoid_f(b.w); }
                            u32x4 w; w.x = pk2(a.x, a.y); w.y = pk2(a.z, a.w); w.z = pk2(b.x, b.y); w.w = pk2(b.z, b.w);
                            *(u32x4*)(dst + (size_t)r * D + cb + bj * 128 + cl) = w;
                        }
                    }
                }
        }
    }
};

struct EpiT1 {
    static constexpr bool PERM = true, AFTER_DRAIN = false;
    const bf16* SG; float* t1_;
    __device__ __forceinline__ void operator()(EPI_ARGS) const {
        const int rbase = u.pm * 256 + wr * 64 + fr, c0 = u.pn * 256 + wc * 32 + 8 * fq;
#pragma unroll
        for (int ai = 0; ai < 2; ++ai)
#pragma unroll
            for (int m = 0; m < 4; ++m) {
                const size_t ro = (size_t)(rbase + ai * 128 + m * 16) * D;
#pragma unroll
                for (int bj = 0; bj < 2; ++bj) {
                    const int col = c0 + bj * 128; float g[8]; unpack8(*(const u32x4*)(SG + ro + col), g);
                    const f32x4 a = acc[ai][bj][m][0], b = acc[ai][bj][m][1];
                    *(f32x4*)(t1_ + ro + col) = (f32x4){a.x * g[0], a.y * g[1], a.z * g[2], a.w * g[3]};
                    *(f32x4*)(t1_ + ro + col + 4) = (f32x4){b.x * g[4], b.y * g[5], b.z * g[6], b.w * g[7]};
                }
            }
    }
};
struct EpiMG {
    static constexpr bool PERM = true, AFTER_DRAIN = false;
    const bf16* SG; const float* t1_; bf16* mg_;
    __device__ __forceinline__ void operator()(EPI_ARGS) const {
        const int rbase = u.pm * 256 + wr * 64 + fr, c0 = u.pn * 256 + wc * 32 + 8 * fq;
#pragma unroll
        for (int ai = 0; ai < 2; ++ai)
#pragma unroll
            for (int m = 0; m < 4; ++m) {
                const size_t ro = (size_t)(rbase + ai * 128 + m * 16) * D;
#pragma unroll
                for (int bj = 0; bj < 2; ++bj) {
                    const int col = c0 + bj * 128; float g[8]; unpack8(*(const u32x4*)(SG + ro + col), g);
                    const f32x4 a = acc[ai][bj][m][0], b = acc[ai][bj][m][1];
                    const f32x4 t0 = *(const f32x4*)(t1_ + ro + col), t1 = *(const f32x4*)(t1_ + ro + col + 4);
                    u32x4 w; w.x = pk2(t0.x + a.x * g[0], t0.y + a.y * g[1]); w.y = pk2(t0.z + a.z * g[2], t0.w + a.w * g[3]);
                    w.z = pk2(t1.x + b.x * g[4], t1.y + b.y * g[5]); w.w = pk2(t1.z + b.z * g[6], t1.w + b.w * g[7]);
                    *(u32x4*)(mg_ + ro + col) = w;
                }
            }
    }
};
struct EpiX1 {
    static constexpr bool PERM = true, AFTER_DRAIN = false;
    const float *xp, *xs, *ln2; float* out; bf16* u2_; float* ss2_;
    __device__ __forceinline__ void operator()(EPI_ARGS) const {
        const int rbase = u.pm * 256 + wr * 64 + fr, c0 = u.pn * 256 + wc * 32 + 8 * fq;
#pragma unroll
        for (int ai = 0; ai < 2; ++ai)
#pragma unroll
            for (int m = 0; m < 4; ++m) {
                const int r = rbase + ai * 128 + m * 16;
                float ss = 0.f;
                if (r < MROWS) {
                    const float* xin = (r < MPR) ? xp + (size_t)r * D : xs + (size_t)(r - MPR) * D;
#pragma unroll
                    for (int bj = 0; bj < 2; ++bj) {
                        const int col = c0 + bj * 128;
                        const f32x4 a = acc[ai][bj][m][0] + *(const f32x4*)(xin + col), b = acc[ai][bj][m][1] + *(const f32x4*)(xin + col + 4);
                        const f32x4 l0 = *(const f32x4*)(ln2 + col), l1 = *(const f32x4*)(ln2 + col + 4);
                        *(f32x4*)(out + (size_t)r * D + col) = a; *(f32x4*)(out + (size_t)r * D + col + 4) = b;
                        ss += (a.x * a.x + a.y * a.y) + (a.z * a.z + a.w * a.w) + (b.x * b.x + b.y * b.y) + (b.z * b.z + b.w * b.w);
                        u32x4 w; w.x = pk2(a.x * l0.x, a.y * l0.y); w.y = pk2(a.z * l0.z, a.w * l0.w); w.z = pk2(b.x * l1.x, b.y * l1.y); w.w = pk2(b.z * l1.z, b.w * l1.w);
                        *(u32x4*)(u2_ + (size_t)r * D + col) = w;
                    }
                }
                ss += __shfl_xor(ss, 16); ss += __shfl_xor(ss, 32);
                if (fq == 0 && r < MROWS) atomicAdd(ss2_ + r, ss);
            }
    }
};
struct EpiUp {
    static constexpr bool PERM = true, AFTER_DRAIN = false;
    const float* ss2_; bf16 *gp_, *val_;
    __device__ __forceinline__ void operator()(EPI_ARGS) const {
        const int rbase = u.pm * 256 + wr * 64 + fr;
        bf16* dst = (u.pn < 12) ? gp_ : val_; const int c0 = (u.pn < 12 ? u.pn : u.pn - 12) * 256 + wc * 32 + 8 * fq;
#pragma unroll
        for (int ai = 0; ai < 2; ++ai)
#pragma unroll
            for (int m = 0; m < 4; ++m) {
                const int r = rbase + ai * 128 + m * 16;
                const float rs = rsqrtf(ss2_[r] * (1.f / D) + EPS);
#pragma unroll
                for (int bj = 0; bj < 2; ++bj) {
                    const f32x4 a = acc[ai][bj][m][0] * rs, b = acc[ai][bj][m][1] * rs;
                    u32x4 w; w.x = pk2(a.x, a.y); w.y = pk2(a.z, a.w); w.z = pk2(b.x, b.y); w.w = pk2(b.z, b.w);
                    *(u32x4*)(dst + (size_t)r * DFF + c0 + bj * 128) = w;
                }
            }
    }
};
struct EpiDown {
    static constexpr bool PERM = true, AFTER_DRAIN = false;
    float* out;
    __device__ __forceinline__ void operator()(EPI_ARGS) const {
        const int rbase = u.pm * 256 + wr * 64 + fr, c0 = u.pn * 256 + wc * 32 + 8 * fq;
#pragma unroll
        for (int ai = 0; ai < 2; ++ai)
#pragma unroll
            for (int m = 0; m < 4; ++m) {
                const int r = rbase + ai * 128 + m * 16;
                if (r < MROWS) {
#pragma unroll
                    for (int bj = 0; bj < 2; ++bj) {
                        float* o = out + (size_t)r * D + c0 + bj * 128;
                        const f32x4 a = acc[ai][bj][m][0] + *(const f32x4*)o, b = acc[ai][bj][m][1] + *(const f32x4*)(o + 4);
                        *(f32x4*)o = a; *(f32x4*)(o + 4) = b;
                    }
                }
            }
    }
};

#define MFMA32(a, b, c) __builtin_amdgcn_mfma_f32_32x32x16_bf16((a), (b), (c), 0, 0, 0)
template <bool SAMPLE>
__device__ __forceinline__ void attn_unit(const bf16* qn_, const bf16* kn_, const bf16* vt_, const bf16* vts_, const float* ck, const float* cv, bf16* YA,
                                          int b, int h, int qb, int lane) {
    const int r32 = lane & 31, hi = lane >> 5;
    int qpos0, qrow0, nq, kb;
    if (SAMPLE) { qpos0 = PAST; qrow0 = MPR + b * TS; nq = TS; kb = PAST / 32; }
    else { qpos0 = qb * 32; qrow0 = b * TP + qpos0; nq = 32; kb = (qpos0 + 30) >> 5; }
    const int qr = r32 < nq ? r32 : nq - 1;
    bf16x8 qf[8];
    { const bf16* qp = qn_ + (size_t)(qrow0 + qr) * D + h * HD + 8 * hi;
#pragma unroll
      for (int ks = 0; ks < 8; ++ks) qf[ks] = *(const bf16x8*)(qp + 16 * ks); }
    f32x16 o[4];
#pragma unroll
    for (int d = 0; d < 4; ++d)
#pragma unroll
        for (int i = 0; i < 16; ++i) o[d][i] = 0.f;
    float carry = 0.f;
    const int qpos = qpos0 + qr;
    for (; kb >= 0; --kb) {
        const bool cache = SAMPLE && (kb < PAST / 32);
        f32x16 s;
        {
            const int kk = 32 * kb + r32;
            bf16x8 kf[8];
            if (cache) {
                const float* kp = ck + (((size_t)b * PAST + kk) * NH + h) * HD + 8 * hi;
#pragma unroll
                for (int ks = 0; ks < 8; ++ks) { const f32x4 a = *(const f32x4*)(kp + 16 * ks), c = *(const f32x4*)(kp + 16 * ks + 4);
                    u32x4 w; w.x = pk2(a.x, a.y); w.y = pk2(a.z, a.w); w.z = pk2(c.x, c.y); w.w = pk2(c.z, c.w); kf[ks] = __builtin_bit_cast(bf16x8, w); }
            } else {
                const int krow = SAMPLE ? (MPR + b * TS + (kk - PAST)) : (b * TP + kk);
                const bf16* kp = kn_ + (size_t)krow * D + h * HD + 8 * hi;
#pragma unroll
                for (int ks = 0; ks < 8; ++ks) kf[ks] = *(const bf16x8*)(kp + 16 * ks);
            }
#pragma unroll
            for (int i = 0; i < 16; ++i) s[i] = 0.f;
#pragma unroll
            for (int ks = 0; ks < 8; ++ks) s = MFMA32(kf[ks], qf[ks], s);
        }
        f32x16 Lv; float own[4], oth[4];
#pragma unroll
        for (int i = 0; i < 16; ++i) {
            const float z = s[i];
            const int kpos = 32 * kb + (i & 3) + 8 * (i >> 2) + 4 * hi;
            const float sp = softplus_f(z);
            Lv[i] = (kpos < qpos) ? -sp : 0.f;
            s[i] = z - sp;
        }
#pragma unroll
        for (int g = 0; g < 4; ++g) { own[g] = (Lv[4 * g] + Lv[4 * g + 1]) + (Lv[4 * g + 2] + Lv[4 * g + 3]); oth[g] = __shfl_xor(own[g], 32); }
        float run = 0.f, after[4];
#pragma unroll
        for (int g = 3; g >= 0; --g) { after[g] = run + (hi == 0 ? oth[g] : 0.f); run += own[g] + oth[g]; }
        bf16x8 pa[2];
        {
            float w[16];
#pragma unroll
            for (int g = 0; g < 4; ++g) {
                float sfx = carry + after[g];
#pragma unroll
                for (int e = 3; e >= 0; --e) {
                    const int i = 4 * g + e;
                    const int kpos = 32 * kb + (i & 3) + 8 * (i >> 2) + 4 * hi;
                    w[i] = (kpos < qpos) ? __expf(s[i] + sfx) : 0.f;
                    sfx += Lv[i];
                }
            }
#pragma unroll
            for (int st = 0; st < 2; ++st) { u32x4 pw; pw.x = pk2(w[8 * st], w[8 * st + 1]); pw.y = pk2(w[8 * st + 2], w[8 * st + 3]); pw.z = pk2(w[8 * st + 4], w[8 * st + 5]); pw.w = pk2(w[8 * st + 6], w[8 * st + 7]);
                pa[st] = __builtin_bit_cast(bf16x8, pw); }
        }
        carry += run;
#pragma unroll
        for (int db = 0; db < 4; ++db) {
#pragma unroll
            for (int st = 0; st < 2; ++st) {
                bf16x8 vf;
                if (cache) {
                    const int k0 = 32 * kb + 16 * st + 4 * hi;
                    const float* vp = cv + (((size_t)b * PAST + k0) * NH + h) * HD + db * 32 + r32;
                    float e[8];
#pragma unroll
                    for (int j = 0; j < 8; ++j) e[j] = vp[(size_t)(8 * (j >> 2) + (j & 3)) * (NH * HD)];
                    u32x4 w; w.x = pk2(e[0], e[1]); w.y = pk2(e[2], e[3]); w.z = pk2(e[4], e[5]); w.w = pk2(e[6], e[7]); vf = __builtin_bit_cast(bf16x8, w);
                } else {
                    const bf16* vp = SAMPLE ? vts_ + ((size_t)(b * NH + h) * HD + db * 32 + r32) * 64 + (32 * kb - PAST) + 16 * st + 4 * hi
                                            : vt_ + ((size_t)(b * NH + h) * HD + db * 32 + r32) * TP + 32 * kb + 16 * st + 4 * hi;
                    const u32x2 lo = *(const u32x2*)vp, hi2 = *(const u32x2*)(vp + 8);
                    u32x4 w; w.x = lo.x; w.y = lo.y; w.z = hi2.x; w.w = hi2.y; vf = __builtin_bit_cast(bf16x8, w);
                }
                o[db] = MFMA32(vf, pa[st], o[db]);
            }
        }
        if (__all(carry < -104.0f)) break;
    }
    if (r32 < nq) {
        bf16* op = YA + (size_t)(qrow0 + r32) * D + h * HD + 4 * hi;
#pragma unroll
        for (int db = 0; db < 4; ++db)
#pragma unroll
            for (int g = 0; g < 4; ++g) { u32x2 w; w.x = pk2(o[db][4 * g], o[db][4 * g + 1]); w.y = pk2(o[db][4 * g + 2], o[db][4 * g + 3]); *(u32x2*)(op + db * 32 + 8 * g) = w; }
    }
}

#define MFMA16(a, b, c) __builtin_amdgcn_mfma_f32_16x16x32_bf16((a), (b), (c), 0, 0, 0)
constexpr int XCS = 72;
template <bool FINAL, bool sample>
__device__ __forceinline__ void lru_unit(const Params& p, int b, int j, int n, LAS unsigned char* wl, int lane) {
    const int fr = lane & 15, fq = lane >> 4;
    const int ntok = sample ? TS : 64, nmb = sample ? 1 : 4;
    const int row0 = sample ? MPR + b * TS : b * TP + j * 64;
    LAS bf16* xcs = (LAS bf16*)wl;
    {
        const int c = n * 64 + lane;
        const float* cw = p.in[9]; const float w0 = cw[c], w1 = cw[D + c], w2 = cw[2 * D + c], w3 = cw[3 * D + c], cbias = p.in[10][c];
        float x3 = 0.f, x2 = 0.f, x1 = 0.f;
        if (sample) { const float* hs = p.in[4] + (size_t)b * 3 * D + c; x3 = hs[0]; x2 = hs[D]; x1 = hs[2 * D]; }
        else if (j > 0) { x3 = bf2f(XR[(size_t)(row0 - 3) * D + c]); x2 = bf2f(XR[(size_t)(row0 - 2) * D + c]); x1 = bf2f(XR[(size_t)(row0 - 1) * D + c]); }
#pragma unroll 8
        for (int t = 0; t < ntok; ++t) {
            const float x0 = bf2f(XR[(size_t)(row0 + t) * D + c]);
            const float y = w0 * x3 + w1 * x2 + w2 * x1 + w3 * x0 + cbias;
            xcs[t * XCS + lane] = (bf16)(pk2(y, 0.f) & 0xffffu);
            x3 = x2; x2 = x1; x1 = x0;
        }
        if (FINAL && (sample || j == NCHUNK - 1)) {
            float* o = p.out + (sample ? O_RCS + (size_t)b * 3 * D : O_RCP + (size_t)b * 3 * D) + c;
            o[0] = x3; o[D] = x2; o[2 * D] = x1;
        }
    }
    asm volatile("s_waitcnt lgkmcnt(0)" ::: "memory");
    bf16x8 wa[4][2], wx[4][2];
#pragma unroll
    for (int nb = 0; nb < 4; ++nb)
#pragma unroll
        for (int k = 0; k < 2; ++k) { const size_t off = (size_t)(n * 64 + 16 * nb + fr) * 64 + 8 * fq + 32 * k; wa[nb][k] = *(const bf16x8*)(WAT + off); wx[nb][k] = *(const bf16x8*)(WXT + off); }
    f32x4 c8[4], bav[4], bxv[4], Hc[4], Pc[4];
#pragma unroll
    for (int nb = 0; nb < 4; ++nb) {
        const int d0 = n * 64 + 16 * nb + 4 * fq;
        const f32x4 lam = *(const f32x4*)(p.in[15] + d0);
        c8[nb] = (f32x4){-8.f * log1pf(__expf(-lam.x)), -8.f * log1pf(__expf(-lam.y)), -8.f * log1pf(__expf(-lam.z)), -8.f * log1pf(__expf(-lam.w))};
        bav[nb] = *(const f32x4*)(p.in[12] + d0); bxv[nb] = *(const f32x4*)(p.in[14] + d0);
        Hc[nb] = (f32x4){0.f, 0.f, 0.f, 0.f}; Pc[nb] = (f32x4){1.f, 1.f, 1.f, 1.f};
        if (FINAL) {
            if (sample) Hc[nb] = *(const f32x4*)(p.in[5] + (size_t)b * D + d0);
            else for (int jj = 0; jj < j; ++jj) { const size_t so = ((size_t)b * NCHUNK + jj) * D + d0; Hc[nb] = *(const f32x4*)(SUMP + so) * Hc[nb] + *(const f32x4*)(SUMH + so); }
        }
    }
    for (int mb = 0; mb < nmb; ++mb) {
        const LAS bf16* xrow = xcs + (16 * mb + fr) * XCS;
        const bf16x8 xf0 = *(const LAS bf16x8*)(xrow + 8 * fq), xf1 = *(const LAS bf16x8*)(xrow + 8 * fq + 32);
        f32x4 A[4], B[4];
#pragma unroll
        for (int nb = 0; nb < 4; ++nb) {
            f32x4 aa = (f32x4){0.f, 0.f, 0.f, 0.f}, ax = aa;
            aa = MFMA16(wa[nb][0], xf0, aa); aa = MFMA16(wa[nb][1], xf1, aa);
            ax = MFMA16(wx[nb][0], xf0, ax); ax = MFMA16(wx[nb][1], xf1, ax);
            const u32x2 xw = *(const LAS u32x2*)(xrow + 16 * nb + 4 * fq);
            const float xc[4] = {bflo(xw.x), bfhi(xw.x), bflo(xw.y), bfhi(xw.y)};
#pragma unroll
            for (int i = 0; i < 4; ++i) {
                const float ra = sigmoid_f(aa[i] + bav[nb][i]), ri = sigmoid_f(ax[i] + bxv[nb][i]);
                const float a = __expf(c8[nb][i] * ra);
                A[nb][i] = a; B[nb][i] = sqrtf(fmaxf(1.f - a * a, 0.f)) * (ri * xc[i]);
            }
        }
#pragma unroll
        for (int sft = 1; sft < 16; sft <<= 1) {
#pragma unroll
            for (int nb = 0; nb < 4; ++nb)
#pragma unroll
                for (int i = 0; i < 4; ++i) {
                    const float ap = __shfl_up(A[nb][i], sft, 16), bp = __shfl_up(B[nb][i], sft, 16);
                    if (fr >= sft) { B[nb][i] = A[nb][i] * bp + B[nb][i]; A[nb][i] = A[nb][i] * ap; }
                }
        }
#pragma unroll
        for (int nb = 0; nb < 4; ++nb) {
            f32x4 hv = B[nb] + A[nb] * Hc[nb], pv = A[nb] * Pc[nb];
            if (FINAL) {
                bf16* gp = GG + (size_t)(row0 + 16 * mb + fr) * D + n * 64 + 16 * nb + 4 * fq;
                const u32x2 gw = *(const u32x2*)gp;
                u32x2 yw; yw.x = pk2(hv.x * bflo(gw.x), hv.y * bfhi(gw.x)); yw.y = pk2(hv.z * bflo(gw.y), hv.w * bfhi(gw.y));
                *(u32x2*)gp = yw;
            }
#pragma unroll
            for (int i = 0; i < 4; ++i) { Hc[nb][i] = __shfl(hv[i], 15, 16); Pc[nb][i] = __shfl(pv[i], 15, 16); }
        }
    }
    if (fr == 0) {
#pragma unroll
        for (int nb = 0; nb < 4; ++nb) {
            const int d0 = n * 64 + 16 * nb + 4 * fq;
            if (!FINAL) { const size_t so = ((size_t)b * NCHUNK + j) * D + d0; *(f32x4*)(SUMP + so) = Pc[nb]; *(f32x4*)(SUMH + so) = Hc[nb]; }
            else if (sample || j == NCHUNK - 1) *(f32x4*)(p.out + (sample ? O_HS + (size_t)b * D : O_HP + (size_t)b * D) + d0) = Hc[nb];
        }
    }
    asm volatile("s_waitcnt lgkmcnt(0)" ::: "memory");
}

__global__ void __launch_bounds__(512, 2) hawk_fwd(Params p) {
    extern __shared__ __attribute__((aligned(16))) unsigned char lds_raw[];
    cg::grid_group grid = cg::this_grid();
    LAS unsigned char* lds = (LAS unsigned char*)lds_raw;
    const int G = gridDim.x, NGW = G * 8;
#define PHASE_IDS int tid = threadIdx.x; asm volatile("" : "+v"(tid)); const int lane = tid & 63, wave = __builtin_amdgcn_readfirstlane(tid >> 6), gw = blockIdx.x * 8 + wave; (void)lane; (void)gw;

    if constexpr ((PH_MASK >> 0) & 1) {
        PHASE_IDS
        LAS float* scr = (LAS float*)(lds + wave * 16384);
        constexpr int I_IN = (D / 64) * (DIN / 32), I_SQ = (D / 64) * (D / 32), I_UP = (D / 64) * (2 * DFF / 32), I_DN = (DFF / 64) * (D / 32), I_LB = 2;
        constexpr int NITEMS = I_IN + 3 * I_SQ + I_UP + I_DN + 32 * I_LB;
        for (int it = gw; it < NITEMS; it += NGW) {
            int r = it;
            if (r < I_IN) { p0_transpose_item(p.in[8], D, DIN, WIN, scr, r, lane); continue; } r -= I_IN;
            if (r < I_SQ) { p0_transpose_item(p.in[18], D, D, WPR, scr, r, lane); continue; } r -= I_SQ;
            if (r < I_SQ) { p0_transpose_item(p.in[19], D, D, WPA, scr, r, lane); continue; } r -= I_SQ;
            if (r < I_SQ) { p0_transpose_item(p.in[20], D, D, WOUT, scr, r, lane); continue; } r -= I_SQ;
            if (r < I_UP) { p0_transpose_item(p.in[22], D, 2 * DFF, WUP, scr, r, lane); continue; } r -= I_UP;
            if (r < I_DN) { p0_transpose_item(p.in[25], DFF, D, WDN, scr, r, lane); continue; } r -= I_DN;
            { const int which = r / (16 * I_LB), rr = r % (16 * I_LB), blk = rr / I_LB, item = rr % I_LB;
              p0_transpose_item((which ? p.in[13] : p.in[11]) + (size_t)blk * 4096, 64, 64, (which ? WXT : WAT) + (size_t)blk * 4096, scr, item, lane); }
        }
        for (int m = gw; m < MROWS; m += NGW)
            rms_row(m < MPR ? p.in[0] + (size_t)m * D : p.in[1] + (size_t)(m - MPR) * D, p.in[7], U1 + (size_t)m * D, lane);
    }
    grid.sync();

    if constexpr ((PH_MASK >> 1) & 1) {
        pg8::Gemm g{U1, WIN, MP, DIN, D}; pg8::StaticOrder S; S.init(MP, DIN, G, (int)blockIdx.x);
        EpiIn E{XR, GG, QN, KN, VT, VTs, SG1, SG2, p.out, p.in[16], p.in[17], (LAS float*)(lds + LDS_SCR)};
        pg8::gemm_phase<EpiIn, pg8::StaticOrder, true, true>(lds, g, S, E);
    }
    grid.sync();

    if constexpr ((PH_MASK >> 2) & 1) {
        PHASE_IDS
        constexpr int NA_P = BP * NH * (TP / 32), NA_S = BS * NH, NL = BP * NCHUNK * 16;
        for (int it = gw; it < NA_P + NA_S + NL; it += NGW) {
            if (it < NA_P) { const int qb = (TP / 32 - 1) - (it / (BP * NH)), bh = it % (BP * NH); attn_unit<false>(QN, KN, VT, VTs, p.in[2], p.in[3], QN, bh / NH, bh % NH, qb, lane); }
            else if (it < NA_P + NA_S) { const int bh = it - NA_P; attn_unit<true>(QN, KN, VT, VTs, p.in[2], p.in[3], QN, bh / NH, bh % NH, 0, lane); }
            else { const int r = it - NA_P - NA_S; lru_unit<false, false>(p, r / (NCHUNK * 16), (r / 16) % NCHUNK, r % 16, lds + wave * 16384, lane); }
        }
    }
    grid.sync();

    if constexpr ((PH_MASK >> 3) & 1) {
        PHASE_IDS
        constexpr int NL = BP * NCHUNK * 16, NLS = BS * 16;
        for (int it = gw; it < NL + NLS; it += NGW) {
            if (it < NL) lru_unit<true, false>(p, it / (NCHUNK * 16), (it / 16) % NCHUNK, it % 16, lds + wave * 16384, lane);
            else { const int r = it - NL; lru_unit<true, true>(p, r / 16, 0, r % 16, lds + wave * 16384, lane); }
        }
    }
    grid.sync();

    if constexpr ((PH_MASK >> 4) & 1) {
        pg8::StaticOrder S; S.init(MP, D, G, (int)blockIdx.x);
        { pg8::Gemm g{GG, WPR, MP, D, D}; EpiT1 E{SG1, T1}; pg8::gemm_phase<EpiT1, pg8::StaticOrder, true, true>(lds, g, S, E); }
        { pg8::Gemm g{QN, WPA, MP, D, D}; EpiMG E{SG2, T1, MG}; pg8::gemm_phase<EpiMG, pg8::StaticOrder, true, true>(lds, g, S, E); }
    }
    grid.sync();

    if constexpr ((PH_MASK >> 5) & 1) {
        pg8::Gemm g{MG, WOUT, MP, D, D}; pg8::StaticOrder S; S.init(MP, D, G, (int)blockIdx.x);
        EpiX1 E{p.in[0], p.in[1], p.in[21], p.out, U2, SS2};
        pg8::gemm_phase<EpiX1, pg8::StaticOrder, true, true>(lds, g, S, E);
    }
    grid.sync();

    if constexpr ((PH_MASK >> 6) & 1) {
        pg8::Gemm g{U2, WUP, MP, 2 * DFF, D}; pg8::StaticOrder S; S.init(MP, 2 * DFF, G, (int)blockIdx.x);
        EpiUp E{SS2, GP, VAL};
        pg8::gemm_phase<EpiUp, pg8::StaticOrder, true, true>(lds, g, S, E);
    }
    grid.sync();

    if constexpr ((PH_MASK >> 7) & 1) {
        PHASE_IDS
        constexpr int NCC = DFF / 8, NITEMS = (MROWS / 16) * NCC;
        const float* fw = p.in[23]; const float* fb = p.in[24];
        for (int it = blockIdx.x * 512 + tid; it < NITEMS; it += G * 512) {
            const int rg = it / NCC, c0 = (it % NCC) * 8, r0 = rg * 16;
            float gm2[8], gm1[8], w0[8], w1[8], w2[8], bb[8];
#pragma unroll
            for (int e = 0; e < 8; ++e) { w0[e] = fw[c0 + e]; w1[e] = fw[DFF + c0 + e]; w2[e] = fw[2 * DFF + c0 + e]; bb[e] = fb[c0 + e]; gm2[e] = 0.f; gm1[e] = 0.f; }
            const bool smp = r0 >= MPR;
            if (smp) { const float* hs = p.in[6] + (size_t)((r0 - MPR) >> 4) * 2 * DFF + c0;
#pragma unroll
                for (int e = 0; e < 8; ++e) { gm2[e] = hs[e]; gm1[e] = hs[DFF + e]; } }
            else if ((r0 & (TP - 1)) != 0) { unpack8(*(const u32x4*)(GP + (size_t)(r0 - 2) * DFF + c0), gm2); unpack8(*(const u32x4*)(GP + (size_t)(r0 - 1) * DFF + c0), gm1); }
#pragma unroll 4
            for (int k = 0; k < 16; ++k) {
                float g2[8], vv[8]; const size_t off = (size_t)(r0 + k) * DFF + c0;
                unpack8(*(const u32x4*)(GP + off), g2); unpack8(*(const u32x4*)(VAL + off), vv);
                float hm[8];
#pragma unroll
                for (int e = 0; e < 8; ++e) { hm[e] = gelu_f(w0[e] * gm2[e] + w1[e] * gm1[e] + w2[e] * g2[e] + bb[e]) * vv[e]; gm2[e] = gm1[e]; gm1[e] = g2[e]; }
                u32x4 w; w.x = pk2(hm[0], hm[1]); w.y = pk2(hm[2], hm[3]); w.z = pk2(hm[4], hm[5]); w.w = pk2(hm[6], hm[7]);
                *(u32x4*)(VAL + off) = w;
            }
            if (smp || ((r0 + 16) & (TP - 1)) == 0) {
                float* o = p.out + (smp ? O_FCS + (size_t)((r0 - MPR) >> 4) * 2 * DFF : O_FCP + (size_t)(r0 >> 12) * 2 * DFF) + c0;
#pragma unroll
                for (int e = 0; e < 8; ++e) { o[e] = gm2[e]; o[DFF + e] = gm1[e]; }
            }
        }
    }
    grid.sync();

    if constexpr ((PH_MASK >> 8) & 1) {
        pg8::Gemm g{VAL, WDN, MP, D, DFF}; pg8::StaticOrder S; S.init(MP, D, G, (int)blockIdx.x);
        EpiDown E{p.out};
        pg8::gemm_phase<EpiDown, pg8::StaticOrder, true, true>(lds, g, S, E);
    }
}

extern "C" void kernel_launch(void* const* d_in, const int* in_sizes, int n_in, void* d_out, int out_size, void* d_ws, size_t ws_size, hipStream_t stream) {
    static int grid = 0;
    if (grid == 0) {
        if (n_in != 26 || (size_t)out_size != O_END || ws_size < WS_END) { fprintf(stderr, "kernel_launch: unexpected shapes: n_in %d out %d ws %zu (need %zu)\n", n_in, out_size, ws_size, (size_t)WS_END); grid = -1; return; }
        int dev = 0, cus = 0, per_cu = 0;
        hipGetDevice(&dev); hipDeviceGetAttribute(&cus, hipDeviceAttributeMultiprocessorCount, dev);
        if (hipFuncSetAttribute((const void*)hawk_fwd, hipFuncAttributeMaxDynamicSharedMemorySize, LDS_BYTES) != hipSuccess) { fprintf(stderr, "kernel_launch: hipFuncSetAttribute failed\n"); grid = -1; return; }
        if (hipOccupancyMaxActiveBlocksPerMultiprocessor(&per_cu, (const void*)hawk_fwd, 512, LDS_BYTES) != hipSuccess || per_cu < 1) { fprintf(stderr, "kernel_launch: occupancy query gave %d\n", per_cu); (void)hipGetLastError(); per_cu = 1; }
        grid = cus * per_cu;
    }
    if (grid < 0) return;
    (void)hipMemsetAsync((char*)d_ws + WS_CTL, 0, CTL_BYTES, stream);
    Params prm{};
    for (int i = 0; i < 26; ++i) prm.in[i] = (const float*)d_in[i];
    prm.out = (float*)d_out; prm.ws = (unsigned char*)d_ws;
    void* args[] = {&prm};
    hipError_t e = hipLaunchCooperativeKernel((const void*)hawk_fwd, dim3(grid), dim3(512), args, LDS_BYTES, stream);
    if (e != hipSuccess) fprintf(stderr, "cooperative launch failed: %s (grid %d)\n", hipGetErrorString(e), grid);
}
```

```cpp
#include <hip/hip_runtime.h>
#include <hip/hip_cooperative_groups.h>
#include <cstdio>
#include <cstdint>
#include <cmath>
namespace cg = cooperative_groups;
#ifndef PH_MASK
#define PH_MASK 0x1ff
#endif
#ifndef PROBE_MASK
#define PROBE_MASK 0
#endif
#ifndef PROBE_MULT
#define PROBE_MULT 2
#endif
namespace pg8 {
#define PG8_LAS __attribute__((address_space(3)))
typedef unsigned short bf16_t;
typedef short bf16x8 __attribute__((ext_vector_type(8)));
typedef float f32x4 __attribute__((ext_vector_type(4)));
typedef unsigned u32x4 __attribute__((ext_vector_type(4)));
constexpr int BM = 256, BK = 64, HALF = 128, HTB = HALF * BK * 2  , STAGE_BYTES = 8 * HTB, NXCD = 8, WGM = 8;

__host__ __device__ __forceinline__ int lds_byte(int r, int c) { const int st = (r >> 4) * 2 + (c >> 5), rr = r & 15, cc = c & 31, ob = rr * 64 + cc * 2; return st * 1024 + (ob ^ (((ob >> 9) & 1) << 5)); }
__host__ __device__ __forceinline__ void stage_rc(int b, int& R, int& C) { const int st = b / 1024, sb = b % 1024, swz = sb ^ (((sb >> 9) & 1) << 5); R = (st >> 1) * 16 + swz / 64; C = (st & 1) * 32 + (swz % 64) / 2; }
__host__ __device__ __forceinline__ int perm32(int rho) { const int n = rho >> 4, i = rho & 15; return 8 * (i >> 2) + 4 * n + (i & 3); }

struct Unit { int pm, pn; };
struct Gemm { const bf16_t* A; const bf16_t* Bt; int M, N, K; };

struct StaticOrder {
    int nM, nN, nwg, G, c;
    __host__ __device__ void init(int M, int N, int G_, int c_) { nM = M / BM; nN = N / BM; nwg = nM * nN; G = G_; c = c_; }
    __host__ __device__ bool next(int i, Unit& u) const {
        const long L = (long)i * G + c; if (L >= nwg) return false;
        int wgid = (int)L; { const int q = nwg / NXCD, r = nwg % NXCD, xcd = wgid % NXCD, off = wgid / NXCD; wgid = (xcd < r ? xcd * (q + 1) : r * (q + 1) + (xcd - r) * q) + off; }
        const int nig = WGM * nN, gid = wgid / nig, fm = gid * WGM, gsz = (nM - fm) < WGM ? (nM - fm) : WGM;
        u.pm = fm + ((wgid % nig) % gsz); u.pn = (wgid % nig) / gsz; return true;
    }
    __device__ __forceinline__ void a_ready(const Unit&) const {}
    __device__ __forceinline__ void done(const Unit&) const {}
};

__device__ __forceinline__ unsigned cvt_pk_bf16(float lo, float hi) { unsigned r; asm volatile("v_cvt_pk_bf16_f32 %0, %1, %2" : "=v"(r) : "v"(lo), "v"(hi)); return r; }
typedef float f32x2 __attribute__((ext_vector_type(2)));
__device__ __forceinline__ f32x2 gelu_pk(f32x2 v) {
    const f32x2 av = __builtin_elementwise_abs(v), d = av * 0.2316418882f + 1.0f;
    f32x2 t; t.x = __builtin_amdgcn_rcpf(d.x); t.y = __builtin_amdgcn_rcpf(d.y);
    f32x2 q = t * 0.5307027145f + (-0.7265760135f); q = q * t + 0.7107068705f; q = q * t + (-0.142248368f); q = q * t + 0.127414796f; q = q * t;
    const f32x2 s = (v * v) * (-0.72134752044f);
    f32x2 e; e.x = __builtin_amdgcn_exp2f(s.x); e.y = __builtin_amdgcn_exp2f(s.y);
    const f32x2 m = v * (q * e), r = v - m;
    f32x2 o; o.x = v.x < 0.f ? m.x : r.x; o.y = v.y < 0.f ? m.y : r.y; return o;
}

template <int ACT  > struct EpiBf16 {
    static constexpr bool PERM = true, AFTER_DRAIN = false; static_assert(ACT == 0 || ACT == 1, "EpiBf16: ACT is 0 (none) or 1 (gelu_pk)");
    bf16_t* O; int ldc; const float* bias; int split_cols; size_t split_stride; float scale0;
    __device__ __forceinline__ void operator()(const f32x4 (&acc)[2][2][4][2], const Unit& u, int wr, int wc, int fr, int fq) const {
        const int row0 = u.pm * BM + wr * 64 + fr; int colt = u.pn * BM; bf16_t* base = O;
        float sc = 1.f; if (split_cols) { const int t = colt / split_cols; base += (size_t)t * split_stride; colt -= t * split_cols; if (t == 0) sc = scale0; }
        const int col0 = colt + wc * 32 + 8 * fq, bcol0 = u.pn * BM + wc * 32 + 8 * fq;
        f32x4 bv[2][2];
#pragma unroll
        for (int bj = 0; bj < 2; ++bj)
#pragma unroll
            for (int n = 0; n < 2; ++n) bv[bj][n] = bias ? *(const f32x4*)(bias + bcol0 + bj * HALF + 4 * n) : (f32x4){0.f, 0.f, 0.f, 0.f};
#pragma unroll
        for (int ai = 0; ai < 2; ++ai)
#pragma unroll
            for (int m = 0; m < 4; ++m) { bf16_t* rowp = base + (size_t)(row0 + ai * HALF + m * 16) * ldc + col0;
#pragma unroll
                for (int bj = 0; bj < 2; ++bj) { f32x4 v0 = acc[ai][bj][m][0] + bv[bj][0], v1 = acc[ai][bj][m][1] + bv[bj][1];
                    if (ACT == 1) { f32x2 a = gelu_pk((f32x2){v0[0], v0[1]}), b = gelu_pk((f32x2){v0[2], v0[3]}), c = gelu_pk((f32x2){v1[0], v1[1]}), d = gelu_pk((f32x2){v1[2], v1[3]});
                        v0 = (f32x4){a.x, a.y, b.x, b.y}; v1 = (f32x4){c.x, c.y, d.x, d.y}; }
                    v0 = v0 * sc; v1 = v1 * sc; u32x4 w; w.x = cvt_pk_bf16(v0[0], v0[1]); w.y = cvt_pk_bf16(v0[2], v0[3]); w.z = cvt_pk_bf16(v1[0], v1[1]); w.w = cvt_pk_bf16(v1[2], v1[3]);
                    *(u32x4*)(rowp + bj * HALF) = w; } }
    }
};
template <class Epi, class Sched, bool ALIGN_EPI = false, bool SP2 = false>
__device__ __forceinline__ void gemm_phase(PG8_LAS unsigned char* lds, const Gemm g, const Sched& S, const Epi& E) {
    int tid_l = threadIdx.x; asm volatile("" : "+v"(tid_l));
    const int tid = tid_l, wid = __builtin_amdgcn_readfirstlane(tid >> 6), lane = tid & 63, wr = wid >> 2, wc = wid & 3, fr = lane & 15, fq = lane >> 4;
    const int K = g.K, nt = K / BK;
    unsigned voffA[2], voffB[2];
#pragma unroll
    for (int i = 0; i < 2; ++i) { int R, C; stage_rc(tid * 16 + i * 8192, R, C); const int Rb = Epi::PERM ? ((R & ~31) + perm32(R & 31)) : R;
        voffA[i] = (unsigned)(R * K + C) * 2u; voffB[i] = (unsigned)(Rb * K + C) * 2u; }
    const size_t kstep = (size_t)(BK * 2);
    const size_t hstep = (size_t)HALF * K * 2;
    const size_t tstep = 2 * hstep;
    const unsigned ldsw = (unsigned)wid * 1024u;
    const int aoff = lds_byte(wr * 64 + fr, fq * 8), boff = lds_byte(wc * 32 + fr, fq * 8);
#define PG8_SA(b, h) (((b) * 2 + (h)) * HTB)
#define PG8_SB(b, h) ((4 + (b) * 2 + (h)) * HTB)
#define PG8_STAGE(bufoff, gbase, voff) do { _Pragma("unroll") for (int _i = 0; _i < 2; ++_i) \
        __builtin_amdgcn_global_load_lds((const unsigned*)((const char*)(gbase) + (voff)[_i]), (PG8_LAS unsigned*)(lds + (bufoff) + ldsw + _i * 8192), 16, 0, 0); } while (0)
#define PG8_LDA(dst, b, h) do { _Pragma("unroll") for (int m = 0; m < 4; ++m) _Pragma("unroll") for (int k = 0; k < 2; ++k) dst[m][k] = *(const PG8_LAS bf16x8*)(lds + PG8_SA(b, h) + aoff + m * 2048 + k * 1024); } while (0)
#define PG8_LDB(dst, b, h) do { _Pragma("unroll") for (int n = 0; n < 2; ++n) _Pragma("unroll") for (int k = 0; k < 2; ++k) dst[n][k] = *(const PG8_LAS bf16x8*)(lds + PG8_SB(b, h) + boff + n * 2048 + k * 1024); } while (0)
#define PG8_MMA(ai, bj, At, Bt) do { __builtin_amdgcn_s_setprio(1); _Pragma("unroll") for (int m = 0; m < 4; ++m) _Pragma("unroll") for (int n = 0; n < 2; ++n) _Pragma("unroll") for (int k = 0; k < 2; ++k) \
        acc[ai][bj][m][n] = __builtin_amdgcn_mfma_f32_16x16x32_bf16(Bt[n][k], At[m][k], acc[ai][bj][m][n], 0, 0, 0); __builtin_amdgcn_s_setprio(0); } while (0)
#define PG8_WAIT_V(n) asm volatile("s_waitcnt vmcnt(" #n ")" ::: "memory")
#define PG8_WAIT_L(n) asm volatile("s_waitcnt lgkmcnt(" #n ")" ::: "memory")
#define PG8_BAR __builtin_amdgcn_s_barrier()
#define PG8_SCHED __builtin_amdgcn_sched_barrier(0)
    Unit cur, nxt; int ui = 0;
    if (!S.next(0, cur)) return;
    f32x4 acc[2][2][4][2];
#pragma unroll
    for (int a = 0; a < 2; ++a)
#pragma unroll
        for (int b = 0; b < 2; ++b)
#pragma unroll
            for (int m = 0; m < 4; ++m)
#pragma unroll
                for (int n = 0; n < 2; ++n) acc[a][b][m][n] = (f32x4){0.f, 0.f, 0.f, 0.f};
    bf16x8 At[4][2], B0[2][2], B1[2][2];
    const char* cA = (const char*)g.A + (size_t)cur.pm * tstep; const char* cB = (const char*)g.Bt + (size_t)cur.pn * tstep;
    S.a_ready(cur);
    if constexpr (SP2) {
        PG8_STAGE(PG8_SB(0, 0), cB, voffB); PG8_STAGE(PG8_SB(0, 1), cB + hstep, voffB); PG8_STAGE(PG8_SA(0, 0), cA, voffA); PG8_STAGE(PG8_SA(0, 1), cA + hstep, voffA);
        if (wr == 1) PG8_BAR;
        PG8_WAIT_V(2); PG8_BAR;
        PG8_STAGE(PG8_SB(1, 0), cB + kstep, voffB); PG8_STAGE(PG8_SA(1, 0), cA + kstep, voffA); PG8_STAGE(PG8_SB(1, 1), cB + hstep + kstep, voffB);
        PG8_WAIT_V(6); PG8_BAR;
    } else {
        PG8_STAGE(PG8_SB(0, 0), cB, voffB); PG8_STAGE(PG8_SA(0, 0), cA, voffA); PG8_STAGE(PG8_SB(0, 1), cB + hstep, voffB); PG8_STAGE(PG8_SA(0, 1), cA + hstep, voffA);
        if (wr == 1) PG8_BAR;
        PG8_WAIT_V(4); PG8_BAR;
        PG8_STAGE(PG8_SB(1, 0), cB + kstep, voffB); PG8_STAGE(PG8_SA(1, 0), cA + kstep, voffA); PG8_STAGE(PG8_SB(1, 1), cB + hstep + kstep, voffB);
        PG8_WAIT_V(6); PG8_BAR;
    }
    for (;;) {
        const bool has_next = S.next(ui + 1, nxt);
        const char* nA = has_next ? (const char*)g.A + (size_t)nxt.pm * tstep : cA; const char* nB = has_next ? (const char*)g.Bt + (size_t)nxt.pn * tstep : cB;
        for (int t = 0; t < nt; t += 2) {
            const bool last = (t == nt - 2);
            const char* a1 = cA + (size_t)(t + 1) * kstep;
            const char* a2 = last ? nA : cA + (size_t)(t + 2) * kstep; const char* b2 = last ? nB : cB + (size_t)(t + 2) * kstep;
            const char* a3 = a2 + kstep; const char* b3 = b2 + kstep;
            if (last && has_next) S.a_ready(nxt);
            if constexpr (SP2) {
            PG8_LDB(B0, 0, 0); PG8_LDB(B1, 0, 1); PG8_SCHED; PG8_LDA(At, 0, 0); PG8_STAGE(PG8_SA(1, 1), a1 + hstep, voffA);
            PG8_WAIT_V(8); PG8_WAIT_L(0); PG8_BAR; PG8_MMA(0, 0, At, B0); PG8_MMA(0, 1, At, B1); PG8_BAR; PG8_SCHED;
            PG8_LDA(At, 0, 1); PG8_STAGE(PG8_SB(0, 0), b2, voffB); PG8_STAGE(PG8_SB(0, 1), b2 + hstep, voffB); PG8_STAGE(PG8_SA(0, 0), a2, voffA);
            PG8_WAIT_V(8); PG8_WAIT_L(0); PG8_BAR; PG8_MMA(1, 0, At, B0); PG8_MMA(1, 1, At, B1); PG8_BAR; PG8_SCHED;
            PG8_LDB(B0, 1, 0); PG8_LDB(B1, 1, 1); PG8_SCHED; PG8_LDA(At, 1, 0); PG8_STAGE(PG8_SA(0, 1), a2 + hstep, voffA);
            PG8_WAIT_V(8); PG8_WAIT_L(0); PG8_BAR; PG8_MMA(0, 0, At, B0); PG8_MMA(0, 1, At, B1); PG8_BAR; PG8_SCHED;
            PG8_LDA(At, 1, 1); PG8_STAGE(PG8_SB(1, 0), b3, voffB); PG8_STAGE(PG8_SB(1, 1), b3 + hstep, voffB); PG8_STAGE(PG8_SA(1, 0), a3, voffA);
            PG8_WAIT_V(8); PG8_WAIT_L(0); PG8_BAR; PG8_MMA(1, 0, At, B0); PG8_MMA(1, 1, At, B1); PG8_BAR; PG8_SCHED;
            } else {
            PG8_LDB(B0, 0, 0); PG8_SCHED; PG8_LDA(At, 0, 0); PG8_STAGE(PG8_SA(1, 1), a1 + hstep, voffA);
            PG8_WAIT_L(8); PG8_BAR; PG8_WAIT_L(0); PG8_MMA(0, 0, At, B0); PG8_BAR; PG8_SCHED;
            PG8_LDB(B1, 0, 1); PG8_STAGE(PG8_SB(0, 0), b2, voffB);
            PG8_BAR; PG8_WAIT_L(0); PG8_MMA(0, 1, At, B1); PG8_BAR;
            PG8_LDA(At, 0, 1); PG8_STAGE(PG8_SA(0, 0), a2, voffA);
            PG8_BAR; PG8_WAIT_L(0); PG8_MMA(1, 0, At, B0); PG8_BAR; PG8_SCHED;
            PG8_STAGE(PG8_SB(0, 1), b2 + hstep, voffB);
            PG8_WAIT_V(6); PG8_BAR; PG8_MMA(1, 1, At, B1); PG8_BAR;
            PG8_LDB(B0, 1, 0); PG8_SCHED; PG8_LDA(At, 1, 0); PG8_STAGE(PG8_SA(0, 1), a2 + hstep, voffA);
            PG8_WAIT_L(8); PG8_BAR; PG8_WAIT_L(0); PG8_MMA(0, 0, At, B0); PG8_BAR; PG8_SCHED;
            PG8_LDB(B1, 1, 1); PG8_STAGE(PG8_SB(1, 0), b3, voffB);
            PG8_BAR; PG8_WAIT_L(0); PG8_MMA(0, 1, At, B1); PG8_BAR;
            PG8_LDA(At, 1, 1); PG8_STAGE(PG8_SA(1, 0), a3, voffA);
            PG8_BAR; PG8_WAIT_L(0); PG8_MMA(1, 0, At, B0); PG8_BAR; PG8_SCHED;
            PG8_STAGE(PG8_SB(1, 1), b3 + hstep, voffB);
            PG8_WAIT_V(6); PG8_BAR; PG8_MMA(1, 1, At, B1); PG8_BAR;
            }
        }
        if constexpr (ALIGN_EPI) { if (wr == 0) PG8_BAR; }
        if constexpr (!Epi::AFTER_DRAIN) { E(acc, cur, wr, wc, fr, fq); S.done(cur); }
        if (!has_next) break;
#pragma unroll
        for (int a = 0; a < 2; ++a)
#pragma unroll
            for (int b = 0; b < 2; ++b)
#pragma unroll
                for (int m = 0; m < 4; ++m)
#pragma unroll
                    for (int n = 0; n < 2; ++n) acc[a][b][m][n] = (f32x4){0.f, 0.f, 0.f, 0.f};
        cur = nxt; cA = nA; cB = nB; ++ui;
        if constexpr (ALIGN_EPI) { if (wr == 1) PG8_BAR; }
    }
    PG8_WAIT_V(0);
    if constexpr (!ALIGN_EPI) { if (wr == 0) PG8_BAR; }
    PG8_BAR;
    if constexpr (Epi::AFTER_DRAIN) { E.fused(acc, cur, wr, wc, fr, fq, lds, wid, lane); S.done(cur); }
#undef PG8_SA
#undef PG8_SB
#undef PG8_STAGE
#undef PG8_LDA
#undef PG8_LDB
#undef PG8_MMA
#undef PG8_WAIT_V
#undef PG8_WAIT_L
#undef PG8_BAR
#undef PG8_SCHED
}
}

#define LAS __attribute__((address_space(3)))
typedef unsigned short bf16;
typedef float f32x4 __attribute__((ext_vector_type(4)));
typedef float f32x2 __attribute__((ext_vector_type(2)));
typedef float f32x16 __attribute__((ext_vector_type(16)));
typedef short bf16x8 __attribute__((ext_vector_type(8)));
typedef unsigned u32x4 __attribute__((ext_vector_type(4)));
typedef unsigned u32x2 __attribute__((ext_vector_type(2)));
typedef __bf16 bf16x2_t __attribute__((ext_vector_type(2)));

constexpr int D = 1024, BP = 4, TP = 4096, MPR = BP * TP, BS = 8, TS = 16, MS = BS * TS, MROWS = MPR + MS, MP = 16640;
constexpr int PAST = 1024, NH = 8, HD = 128, DFF = 3072, DIN = 7168;
constexpr float EPS = 1e-6f;
constexpr int NCHUNK = TP / 64;

constexpr size_t O_YP = 0, O_YS = O_YP + (size_t)MPR * D, O_KP = O_YS + (size_t)MS * D, O_VP = O_KP + (size_t)MPR * D,
                 O_RCP = O_VP + (size_t)MPR * D, O_HP = O_RCP + (size_t)BP * 3 * D, O_FCP = O_HP + (size_t)BP * D,
                 O_KS = O_FCP + (size_t)BP * 2 * DFF, O_VS = O_KS + (size_t)MS * D, O_RCS = O_VS + (size_t)MS * D,
                 O_HS = O_RCS + (size_t)BS * 3 * D, O_FCS = O_HS + (size_t)BS * D, O_END = O_FCS + (size_t)BS * 2 * DFF;

constexpr size_t MiB = 1u << 20;
constexpr size_t SLOT = (size_t)MP * D * 2;
constexpr size_t WS_CTL = 0, CTL_BYTES = 1 * MiB;
constexpr size_t WS_WUP = 1 * MiB, WS_WDN = 13 * MiB, WS_WPR = 19 * MiB, WS_WPA = 21 * MiB, WS_WOUT = 23 * MiB, WS_WAT = 25 * MiB, WS_WXT = WS_WAT + 131072;
constexpr size_t WS_S0 = 25 * MiB + 262144;
constexpr size_t WS_S1 = WS_S0 + SLOT, WS_S2 = WS_S1 + SLOT, WS_S3 = WS_S2 + SLOT, WS_S4 = WS_S3 + SLOT, WS_S5 = WS_S4 + SLOT, WS_S6 = WS_S5 + SLOT;
constexpr size_t WS_VTS = WS_S6 + SLOT, WS_SUMP = WS_VTS + 1 * MiB, WS_SUMH = WS_SUMP + 1 * MiB, WS_END = WS_SUMH + 1 * MiB;
static_assert(WS_END <= 256 * MiB, "workspace map exceeds 256 MiB");

constexpr int WLDS = 18816;
constexpr int LDS_BYTES = 8 * WLDS;
constexpr int LDS_SCR = 131072;

__device__ __forceinline__ unsigned pk2(float lo, float hi) { f32x2 v = {lo, hi}; bf16x2_t b = __builtin_convertvector(v, bf16x2_t); return __builtin_bit_cast(unsigned, b); }
__device__ __forceinline__ float bf2f(unsigned short x) { return __uint_as_float((unsigned)x << 16); }
__device__ __forceinline__ float bflo(unsigned x) { return __uint_as_float(x << 16); }
__device__ __forceinline__ float bfhi(unsigned x) { return __uint_as_float(x & 0xffff0000u); }
__device__ __forceinline__ float sigmoid_f(float x) { return __builtin_amdgcn_rcpf(1.f + __expf(-x)); }
__device__ __forceinline__ float gelu_f(float x) { const float u = 1.5957691216057308f * (x + 0.044715f * x * x * x); return x * sigmoid_f(u); }
__device__ __forceinline__ float softplus_f(float z) { return fmaxf(z, 0.f) + __logf(1.f + __expf(-fabsf(z))); }
__device__ __forceinline__ float wave_sum(float v) {
#pragma unroll
    for (int o = 1; o < 64; o <<= 1) v += __shfl_xor(v, o);
    return v;
}
__device__ __forceinline__ void unpack8(const u32x4 w, float (&f)[8]) {
    f[0] = bflo(w.x); f[1] = bfhi(w.x); f[2] = bflo(w.y); f[3] = bfhi(w.y); f[4] = bflo(w.z); f[5] = bfhi(w.z); f[6] = bflo(w.w); f[7] = bfhi(w.w);
}

__device__ __forceinline__ u32x4 pack8(const float (&v)[8]) { u32x4 w; w.x = pk2(v[0], v[1]); w.y = pk2(v[2], v[3]); w.z = pk2(v[4], v[5]); w.w = pk2(v[6], v[7]); return w; }
__device__ __forceinline__ void st8f(float* o, const float (&v)[8]) { *(f32x4*)o = (f32x4){v[0], v[1], v[2], v[3]}; *(f32x4*)(o + 4) = (f32x4){v[4], v[5], v[6], v[7]}; }
__device__ __forceinline__ void ld8f(const float* o, float (&v)[8]) { const f32x4 a = *(const f32x4*)o, b = *(const f32x4*)(o + 4); v[0] = a.x; v[1] = a.y; v[2] = a.z; v[3] = a.w; v[4] = b.x; v[5] = b.y; v[6] = b.z; v[7] = b.w; }
__device__ __forceinline__ float sum16(float s) { s += __shfl_xor(s, 1); s += __shfl_xor(s, 2); s += __shfl_xor(s, 4); s += __shfl_xor(s, 8); return s; }
struct Params { const float* in[26]; float* out; unsigned char* ws; };
#define WSB(off) ((bf16*)(p.ws + (off)))
#define D0 ((bf16*)p.out)
#define D1 (((bf16*)p.out) + (size_t)MROWS * D)
#define WUP WSB(WS_WUP)
#define WDN WSB(WS_WDN)
#define WPR WSB(WS_WPR)
#define WPA WSB(WS_WPA)
#define WOUT WSB(WS_WOUT)
#define WAT WSB(WS_WAT)
#define WXT WSB(WS_WXT)
#define S0 WSB(WS_S0)
#define S1 WSB(WS_S1)
#define S2 WSB(WS_S2)
#define S3 WSB(WS_S3)
#define S4 WSB(WS_S4)
#define S5 WSB(WS_S5)
#define S6 WSB(WS_S6)
#define KFs WSB(WS_VTS)
#define VFs WSB(WS_VTS + 524288)
#define C8T ((float*)(p.ws + WS_CTL + 131072))
#define SUMP ((float*)(p.ws + WS_SUMP))
#define SUMH ((float*)(p.ws + WS_SUMH))
#define SS2 ((float*)(p.ws + WS_CTL))
#define U1 D0
#define XR D1
#define GG S0
#define QN S1
#define KF S2
#define VF S3
#define SG1 S4
#define SG2 S5
#define WIN S6
#define T1 S2
#define MG S6
#define U2 S0
#define GP S1
#define VAL S4
#define HLB S6
#define PCB D0

__device__ __forceinline__ void p0_transpose_item(const float* W, int K, int N, bf16* WT, LAS float* scr, int item, int lane) {
    const int nblk = N / 32, kb = item / nblk, nb = item % nblk, k0 = 64 * kb, n0 = 32 * nb;
#pragma unroll 32
    for (int i = 0; i < 32; ++i) { const int kk = 2 * i + (lane >> 5); scr[kk * 33 + (lane & 31)] = W[(size_t)(k0 + kk) * N + n0 + (lane & 31)]; }
    asm volatile("s_waitcnt lgkmcnt(0)" ::: "memory");
    const int c = lane & 7;
#pragma unroll
    for (int j = 0; j < 4; ++j) { const int n = (lane >> 3) + 8 * j; const LAS float* s = scr + (8 * c) * 33 + n;
        u32x4 o; o.x = pk2(s[0 * 33], s[1 * 33]); o.y = pk2(s[2 * 33], s[3 * 33]); o.z = pk2(s[4 * 33], s[5 * 33]); o.w = pk2(s[6 * 33], s[7 * 33]);
        *(u32x4*)(WT + (size_t)(n0 + n) * K + k0 + 8 * c) = o; }
    asm volatile("s_waitcnt lgkmcnt(0)" ::: "memory");
}
__device__ __forceinline__ void rms_row(const float* xrow, const float* g, bf16* orow, int lane) {
    const f32x4* xr = (const f32x4*)xrow + lane; const f32x4* gr = (const f32x4*)g + lane;
    f32x4 v[4]; float s = 0.f;
#pragma unroll
    for (int j = 0; j < 4; ++j) { v[j] = xr[64 * j]; s += (v[j].x * v[j].x + v[j].y * v[j].y) + (v[j].z * v[j].z + v[j].w * v[j].w); }
    const float rs = rsqrtf(wave_sum(s) * (1.f / D) + EPS);
    u32x2* o8 = (u32x2*)orow + lane;
#pragma unroll
    for (int j = 0; j < 4; ++j) { const f32x4 gv = gr[64 * j]; u32x2 o; o.x = pk2(v[j].x * rs * gv.x, v[j].y * rs * gv.y); o.y = pk2(v[j].z * rs * gv.z, v[j].w * rs * gv.w); o8[64 * j] = o; }
}

#define EPI_ARGS const f32x4 (&acc)[2][2][4][2], const pg8::Unit& u, int wr, int wc, int fr, int fq

struct EpiIn {
    static constexpr bool PERM = true, AFTER_DRAIN = false;
    bf16 *xr_, *gg_, *qn_, *kf_, *vf_, *sg1_, *sg2_; float* out; const float *qg, *kg; LAS float* scr;
    __device__ __forceinline__ void operator()(EPI_ARGS) const {
        const int seg = u.pn >> 2, cb = (u.pn & 3) * 256;
        const int rbase = u.pm * 256 + wr * 64 + fr;
        const int cl = wc * 32 + 8 * fq;
        if (seg == 2 || seg == 3) {
#pragma unroll
            for (int ai = 0; ai < 2; ++ai)
#pragma unroll
                for (int m = 0; m < 4; ++m)
#pragma unroll
                    for (int bj = 0; bj < 2; ++bj) {
                        const f32x4 a = acc[ai][bj][m][0], b = acc[ai][bj][m][1];
                        float s = (a.x * a.x + a.y * a.y) + (a.z * a.z + a.w * a.w) + (b.x * b.x + b.y * b.y) + (b.z * b.z + b.w * b.w);
                        s += __shfl_xor(s, 16); s += __shfl_xor(s, 32);
                        if (fq == 0) scr[((ai * 128 + wr * 64 + m * 16 + fr) * 2 + bj) * 4 + wc] = s;
                    }
            asm volatile("s_waitcnt lgkmcnt(0)" ::: "memory"); __builtin_amdgcn_s_barrier(); asm volatile("" ::: "memory");
            const float* gain = (seg == 2) ? qg : kg; const float osc = (seg == 2) ? 0.08838834764831845f : 1.0f;
            const f32x4 g0 = *(const f32x4*)(gain + cl), g1 = *(const f32x4*)(gain + cl + 4);

#pragma unroll
            for (int ai = 0; ai < 2; ++ai)
#pragma unroll
                for (int m = 0; m < 4; ++m) {
                    const int r = rbase + ai * 128 + m * 16;
#pragma unroll
                    for (int bj = 0; bj < 2; ++bj) {
                        const f32x4 pp = *(const LAS f32x4*)(scr + ((ai * 128 + wr * 64 + m * 16 + fr) * 2 + bj) * 4);
                        const float rs = rsqrtf(((pp.x + pp.y) + (pp.z + pp.w)) * (1.f / HD) + EPS);
                        const f32x4 a = acc[ai][bj][m][0] * rs * g0, b = acc[ai][bj][m][1] * rs * g1;
                        const int col = cb + bj * 128 + cl;
                        u32x4 w; w.x = pk2(a.x * osc, a.y * osc); w.y = pk2(a.z * osc, a.w * osc); w.z = pk2(b.x * osc, b.y * osc); w.w = pk2(b.z * osc, b.w * osc);
                        if (seg == 2) *(u32x4*)(qn_ + (size_t)r * D + col) = w;
                        else {
                            const int bb = r >> 12, t = r & (TP - 1), hh = (cb + bj * 128) >> 7;
                            *(u32x4*)(kf_ + ((((size_t)(bb * NH + hh) * (TP / 32) + (t >> 5)) * 8 + (cl >> 4)) * 512 + ((t & 31) + 32 * ((cl >> 3) & 1)) * 8)) = w;
                            float* o = out + O_KP + (size_t)r * D + col;
                            __builtin_nontemporal_store(a, (f32x4*)o); __builtin_nontemporal_store(b, (f32x4*)(o + 4));
                        }
                    }
                }
        } else if (seg == 4) {
            LAS bf16* wscr = (LAS bf16*)scr + (wr * 4 + wc) * 512;
            const int L = fr + 16 * fq, dl = L & 31, hk = L >> 5;
#pragma unroll
            for (int ai = 0; ai < 2; ++ai)
#pragma unroll
                for (int m = 0; m < 4; ++m) {
                    const int r = rbase + ai * 128 + m * 16, bb = r >> 12, t0 = (r - fr) & (TP - 1);
#pragma unroll
                    for (int bj = 0; bj < 2; ++bj) {
                        const f32x4 a = acc[ai][bj][m][0], b = acc[ai][bj][m][1];
                        const int col = cb + bj * 128 + cl, hh = (cb + bj * 128) >> 7;
                        float* o = out + O_VP + (size_t)r * D + col;
                        __builtin_nontemporal_store(a, (f32x4*)o); __builtin_nontemporal_store(b, (f32x4*)(o + 4));
                        u32x4 w; w.x = pk2(a.x, a.y); w.y = pk2(a.z, a.w); w.z = pk2(b.x, b.y); w.w = pk2(b.z, b.w);
                        *(LAS u32x4*)(wscr + fr * 32 + 8 * fq) = w;
                        asm volatile("s_waitcnt lgkmcnt(0)" ::: "memory");
                        unsigned short e[8];
#pragma unroll
                        for (int j = 0; j < 8; ++j) e[j] = wscr[(8 * (j >> 2) + 4 * hk + (j & 3)) * 32 + dl];
                        asm volatile("s_waitcnt lgkmcnt(0)" ::: "memory");
                        u32x4 g; g.x = (unsigned)e[0] | ((unsigned)e[1] << 16); g.y = (unsigned)e[2] | ((unsigned)e[3] << 16); g.z = (unsigned)e[4] | ((unsigned)e[5] << 16); g.w = (unsigned)e[6] | ((unsigned)e[7] << 16);
                        *(u32x4*)(vf_ + ((((size_t)(bb * NH + hh) * (TP / 32) + (t0 >> 5)) * 4 + wc) * 2 + ((t0 >> 4) & 1)) * 512 + L * 8) = g;
                    }
                }
        } else {
            bf16* dst = (seg == 0) ? xr_ : (seg == 1) ? gg_ : (seg == 5) ? sg1_ : sg2_;
            const int rlim = (seg == 0) ? MROWS : MP;
#pragma unroll
            for (int ai = 0; ai < 2; ++ai)
#pragma unroll
                for (int m = 0; m < 4; ++m) {
                    const int r = rbase + ai * 128 + m * 16;
                    if (r < rlim) {
#pragma unroll
                        for (int bj = 0; bj < 2; ++bj) {
                            f32x4 a = acc[ai][bj][m][0], b = acc[ai][bj][m][1];
                            if (seg == 1) { a.x = gelu_f(a.x); a.y = gelu_f(a.y); a.z = gelu_f(a.z); a.w = gelu_f(a.w); b.x = gelu_f(b.x); b.y = gelu_f(b.y); b.z = gelu_f(b.z); b.w = gelu_f(b.w); }
                            else if (seg >= 5) { a.x = sigmoid_f(a.x); a.y = sigmoid_f(a.y); a.z = sigmoid_f(a.z); a.w = sigmoid_f(a.w); b.x = sigmoid_f(b.x); b.y = sigmoid_f(b.y); b.z = sigmoid_f(b.z); b.w = sigmoid_f(b.w); }
                            u32x4 w; w.x = pk2(a.x, a.y); w.y = pk2(a.z, a.w); w.z = pk2(b.x, b.y); w.w = pk2(b.z, b.w);
                            *(u32x4*)(dst + (size_t)r * D + cb + bj * 128 + cl) = w;
                        }
                    }
                }
        }
    }
};

struct EpiT1 {
    static constexpr bool PERM = true, AFTER_DRAIN = false;
    const bf16* SG; bf16* t1_;
    __device__ __forceinline__ void operator()(EPI_ARGS) const {
        const int rbase = u.pm * 256 + wr * 64 + fr, c0 = u.pn * 256 + wc * 32 + 8 * fq;
        u32x4 sg[2][4][2];
#pragma unroll
        for (int ai = 0; ai < 2; ++ai)
#pragma unroll
            for (int m = 0; m < 4; ++m)
#pragma unroll
                for (int bj = 0; bj < 2; ++bj) sg[ai][m][bj] = *(const u32x4*)(SG + (size_t)(rbase + ai * 128 + m * 16) * D + c0 + bj * 128);
        __builtin_amdgcn_sched_barrier(0);
#pragma unroll
        for (int ai = 0; ai < 2; ++ai)
#pragma unroll
            for (int m = 0; m < 4; ++m)
#pragma unroll
                for (int bj = 0; bj < 2; ++bj) {
                    float g[8]; unpack8(sg[ai][m][bj], g);
                    const f32x4 a = acc[ai][bj][m][0], b = acc[ai][bj][m][1];
                    u32x4 w; w.x = pk2(a.x * g[0], a.y * g[1]); w.y = pk2(a.z * g[2], a.w * g[3]); w.z = pk2(b.x * g[4], b.y * g[5]); w.w = pk2(b.z * g[6], b.w * g[7]);
                    *(u32x4*)(t1_ + (size_t)(rbase + ai * 128 + m * 16) * D + c0 + bj * 128) = w;
                }
    }
};
struct EpiMG {
    static constexpr bool PERM = true, AFTER_DRAIN = false;
    const bf16* SG; const bf16* t1_; bf16* mg_;
    __device__ __forceinline__ void operator()(EPI_ARGS) const {
        const int rbase = u.pm * 256 + wr * 64 + fr, c0 = u.pn * 256 + wc * 32 + 8 * fq;
        u32x4 sg[4][2], tt[4][2], res[4][2];
#define MG_LOAD(AI) _Pragma("unroll") for (int m = 0; m < 4; ++m) _Pragma("unroll") for (int bj = 0; bj < 2; ++bj) { \
            const size_t off = (size_t)(rbase + (AI) * 128 + m * 16) * D + c0 + bj * 128; sg[m][bj] = *(const u32x4*)(SG + off); tt[m][bj] = *(const u32x4*)(t1_ + off); }
#define MG_CALC(AI) _Pragma("unroll") for (int m = 0; m < 4; ++m) _Pragma("unroll") for (int bj = 0; bj < 2; ++bj) { \
            float g[8], t[8]; unpack8(sg[m][bj], g); unpack8(tt[m][bj], t); const f32x4 a = acc[AI][bj][m][0], b = acc[AI][bj][m][1]; \
            u32x4 w; w.x = pk2(t[0] + a.x * g[0], t[1] + a.y * g[1]); w.y = pk2(t[2] + a.z * g[2], t[3] + a.w * g[3]); \
            w.z = pk2(t[4] + b.x * g[4], t[5] + b.y * g[5]); w.w = pk2(t[6] + b.z * g[6], t[7] + b.w * g[7]); res[m][bj] = w; }
#define MG_STORE(AI) _Pragma("unroll") for (int m = 0; m < 4; ++m) _Pragma("unroll") for (int bj = 0; bj < 2; ++bj) \
            *(u32x4*)(mg_ + (size_t)(rbase + (AI) * 128 + m * 16) * D + c0 + bj * 128) = res[m][bj];
        MG_LOAD(0)
        __builtin_amdgcn_sched_barrier(0);
        MG_CALC(0)
        MG_LOAD(1)
        __builtin_amdgcn_sched_barrier(0);
        MG_STORE(0)
        MG_CALC(1)
        MG_STORE(1)
#undef MG_LOAD
#undef MG_CALC
#undef MG_STORE
    }
};
struct EpiX1 {
    static constexpr bool PERM = true, AFTER_DRAIN = false;
    const float *xp, *xs, *ln2; float* out; bf16* u2_; float* ss2_;
    __device__ __forceinline__ void operator()(EPI_ARGS) const {
        const int rbase = u.pm * 256 + wr * 64 + fr, c0 = u.pn * 256 + wc * 32 + 8 * fq;
        f32x4 l[2][2];
#pragma unroll
        for (int bj = 0; bj < 2; ++bj) { l[bj][0] = *(const f32x4*)(ln2 + c0 + bj * 128); l[bj][1] = *(const f32x4*)(ln2 + c0 + bj * 128 + 4); }
        f32x4 xv[2][2][2], res[2][2][2];
#define X1_LOAD(Q) _Pragma("unroll") for (int mm = 0; mm < 2; ++mm) _Pragma("unroll") for (int bj = 0; bj < 2; ++bj) { \
            const float* xin = xp + (size_t)(rbase + ((Q) >> 1) * 128 + (((Q) & 1) * 2 + mm) * 16) * D + c0 + bj * 128; xv[mm][bj][0] = *(const f32x4*)xin; xv[mm][bj][1] = *(const f32x4*)(xin + 4); }
#define X1_ADD(Q) _Pragma("unroll") for (int mm = 0; mm < 2; ++mm) _Pragma("unroll") for (int bj = 0; bj < 2; ++bj) { \
            res[mm][bj][0] = acc[(Q) >> 1][bj][((Q) & 1) * 2 + mm][0] + xv[mm][bj][0]; res[mm][bj][1] = acc[(Q) >> 1][bj][((Q) & 1) * 2 + mm][1] + xv[mm][bj][1]; }
#define X1_STORE(Q) _Pragma("unroll") for (int mm = 0; mm < 2; ++mm) { const int r = rbase + ((Q) >> 1) * 128 + (((Q) & 1) * 2 + mm) * 16; float ss = 0.f; \
            _Pragma("unroll") for (int bj = 0; bj < 2; ++bj) { const f32x4 a = res[mm][bj][0], b = res[mm][bj][1]; const int col = c0 + bj * 128; \
                *(f32x4*)(out + (size_t)r * D + col) = a; *(f32x4*)(out + (size_t)r * D + col + 4) = b; \
                ss += (a.x * a.x + a.y * a.y) + (a.z * a.z + a.w * a.w) + (b.x * b.x + b.y * b.y) + (b.z * b.z + b.w * b.w); \
                u32x4 w; w.x = pk2(a.x * l[bj][0].x, a.y * l[bj][0].y); w.y = pk2(a.z * l[bj][0].z, a.w * l[bj][0].w); w.z = pk2(b.x * l[bj][1].x, b.y * l[bj][1].y); w.w = pk2(b.z * l[bj][1].z, b.w * l[bj][1].w); \
                *(u32x4*)(u2_ + (size_t)r * D + col) = w; } \
            ss += __shfl_xor(ss, 16); ss += __shfl_xor(ss, 32); if (fq == 0) atomicAdd(ss2_ + r, ss); }
        X1_LOAD(0)
        __builtin_amdgcn_sched_barrier(0);
        X1_ADD(0) X1_LOAD(1)
        __builtin_amdgcn_sched_barrier(0);
        X1_STORE(0) X1_ADD(1) X1_LOAD(2)
        __builtin_amdgcn_sched_barrier(0);
        X1_STORE(1) X1_ADD(2) X1_LOAD(3)
        __builtin_amdgcn_sched_barrier(0);
        X1_STORE(2) X1_ADD(3) X1_STORE(3)
#undef X1_LOAD
#undef X1_ADD
#undef X1_STORE
    }
};
struct PairOrder {
    pg8::StaticOrder base;
    __device__ __forceinline__ bool next(int i, pg8::Unit& u) const { pg8::Unit t; if (!base.next(i >> 1, t)) return false; u.pm = t.pm + ((i & 1) ? MP / 256 : 0); u.pn = t.pn + ((i & 1) ? 4 : 0); return true; }
    __device__ __forceinline__ void a_ready(const pg8::Unit&) const {}
    __device__ __forceinline__ void done(const pg8::Unit&) const {}
};
struct EpiP4 {
    static constexpr bool PERM = true, AFTER_DRAIN = false;
    EpiT1 e1; EpiMG e2;
    __device__ __forceinline__ void operator()(EPI_ARGS) const {
        if (u.pm >= MP / 256) { const pg8::Unit v{u.pm - MP / 256, u.pn - 4}; e2(acc, v, wr, wc, fr, fq); }
        else e1(acc, u, wr, wc, fr, fq);
    }
};
struct EpiUp {
    static constexpr bool PERM = true, AFTER_DRAIN = false;
    const float* ss2_; bf16 *gp_, *val_;
    __device__ __forceinline__ void operator()(EPI_ARGS) const {
        const int rbase = u.pm * 256 + wr * 64 + fr;
        bf16* dst = (u.pn < 12) ? gp_ : val_; const int c0 = (u.pn < 12 ? u.pn : u.pn - 12) * 256 + wc * 32 + 8 * fq;
        float ssv[2][4];
#pragma unroll
        for (int ai = 0; ai < 2; ++ai)
#pragma unroll
            for (int m = 0; m < 4; ++m) ssv[ai][m] = ss2_[rbase + ai * 128 + m * 16];
#pragma unroll
        for (int ai = 0; ai < 2; ++ai)
#pragma unroll
            for (int m = 0; m < 4; ++m) {
                const int r = rbase + ai * 128 + m * 16;
                const float rs = rsqrtf(ssv[ai][m] * (1.f / D) + EPS);
#pragma unroll
                for (int bj = 0; bj < 2; ++bj) {
                    const f32x4 a = acc[ai][bj][m][0] * rs, b = acc[ai][bj][m][1] * rs;
                    u32x4 w; w.x = pk2(a.x, a.y); w.y = pk2(a.z, a.w); w.z = pk2(b.x, b.y); w.w = pk2(b.z, b.w);
                    *(u32x4*)(dst + (size_t)r * DFF + c0 + bj * 128) = w;
                }
            }
    }
};
struct EpiDown {
    static constexpr bool PERM = true, AFTER_DRAIN = false;
    float* out;
    __device__ __forceinline__ void operator()(EPI_ARGS) const {
        const int rbase = u.pm * 256 + wr * 64 + fr, c0 = u.pn * 256 + wc * 32 + 8 * fq;
        f32x4 xv[4][2][2], res[4][2][2];
#define DN_LOAD(AI) _Pragma("unroll") for (int m = 0; m < 4; ++m) _Pragma("unroll") for (int bj = 0; bj < 2; ++bj) { \
            const float* o = out + (size_t)(rbase + (AI) * 128 + m * 16) * D + c0 + bj * 128; xv[m][bj][0] = *(const f32x4*)o; xv[m][bj][1] = *(const f32x4*)(o + 4); }
#define DN_ADD(AI) _Pragma("unroll") for (int m = 0; m < 4; ++m) _Pragma("unroll") for (int bj = 0; bj < 2; ++bj) { res[m][bj][0] = acc[AI][bj][m][0] + xv[m][bj][0]; res[m][bj][1] = acc[AI][bj][m][1] + xv[m][bj][1]; }
#define DN_STORE(AI) _Pragma("unroll") for (int m = 0; m < 4; ++m) _Pragma("unroll") for (int bj = 0; bj < 2; ++bj) { \
            float* o = out + (size_t)(rbase + (AI) * 128 + m * 16) * D + c0 + bj * 128; __builtin_nontemporal_store(res[m][bj][0], (f32x4*)o); __builtin_nontemporal_store(res[m][bj][1], (f32x4*)(o + 4)); }
        DN_LOAD(0)
        __builtin_amdgcn_sched_barrier(0);
        DN_ADD(0)
        DN_LOAD(1)
        __builtin_amdgcn_sched_barrier(0);
        DN_STORE(0)
        DN_ADD(1)
        DN_STORE(1)
#undef DN_LOAD
#undef DN_ADD
#undef DN_STORE
    }
};

#define MFMA32(a, b, c) __builtin_amdgcn_mfma_f32_32x32x16_bf16((a), (b), (c), 0, 0, 0)
template <bool SAMPLE>
__device__ __forceinline__ void attn_unit(const bf16* qn_, const bf16* kf_, const bf16* vf_, const bf16* kfs_, const bf16* vfs_, const float* ck, const float* cv, bf16* YA,
                                          int b, int h, int qb, LAS unsigned char* wl, LAS unsigned char* slabs, int lane) {
    const int r32 = lane & 31, hi = lane >> 5;
    int qpos0, qrow0, nq, kb;
    if (SAMPLE) { qpos0 = PAST; qrow0 = MPR + b * TS; nq = TS; kb = PAST / 32; }
    else { qpos0 = qb * 32; qrow0 = b * TP + qpos0; nq = 32; kb = (qpos0 + 30) >> 5; }
    const int qr = r32 < nq ? r32 : nq - 1;
    LAS bf16x8* qst = (LAS bf16x8*)wl + lane;
    { const bf16* qp = qn_ + (size_t)(qrow0 + qr) * D + h * HD + 8 * hi;
      bf16x8 qf[8];
#pragma unroll
      for (int ks = 0; ks < 8; ++ks) qf[ks] = *(const bf16x8*)(qp + 16 * ks);
      __builtin_amdgcn_sched_barrier(0);
#pragma unroll
      for (int ks = 0; ks < 8; ++ks) qst[ks * 64] = qf[ks]; }
    f32x16 o[4];
#pragma unroll
    for (int d = 0; d < 4; ++d)
#pragma unroll
        for (int i = 0; i < 16; ++i) o[d][i] = 0.f;
    float carry = 0.f;
    const int qpos = qpos0 + qr;
    for (; kb >= 0; --kb) {
        const bool cache = SAMPLE && (kb < PAST / 32 - 8);
        const bool inlds = SAMPLE && !cache && (kb < PAST / 32);
        f32x16 s;
        bf16x8 kf[8], vf[8];
        if (inlds) {
            const LAS bf16x8* sl = (const LAS bf16x8*)(slabs + (PAST / 32 - 1 - kb) * 16384) + lane;
#pragma unroll
            for (int ks = 0; ks < 8; ++ks) kf[ks] = sl[ks * 64];
#pragma unroll
            for (int f = 0; f < 8; ++f) vf[f] = sl[512 + f * 64];
        } else if (cache) {
            const int kk = 32 * kb + r32;
            const float* kp = ck + (((size_t)b * PAST + kk) * NH + h) * HD + 8 * hi;
#pragma unroll
            for (int ks = 0; ks < 8; ++ks) { const f32x4 a = *(const f32x4*)(kp + 16 * ks), c = *(const f32x4*)(kp + 16 * ks + 4);
                u32x4 w; w.x = pk2(a.x, a.y); w.y = pk2(a.z, a.w); w.z = pk2(c.x, c.y); w.w = pk2(c.z, c.w); kf[ks] = __builtin_bit_cast(bf16x8, w); }
#pragma unroll
            for (int f = 0; f < 8; ++f) {
                const int k0 = 32 * kb + 16 * (f & 1) + 4 * hi;
                const float* vp = cv + (((size_t)b * PAST + k0) * NH + h) * HD + (f >> 1) * 32 + r32;
                float e[8];
#pragma unroll
                for (int j = 0; j < 8; ++j) e[j] = vp[(size_t)(8 * (j >> 2) + (j & 3)) * (NH * HD)];
                u32x4 w; w.x = pk2(e[0], e[1]); w.y = pk2(e[2], e[3]); w.z = pk2(e[4], e[5]); w.w = pk2(e[6], e[7]); vf[f] = __builtin_bit_cast(bf16x8, w);
            }
        } else {
            const size_t fo = (SAMPLE ? (size_t)(b * NH + h) : ((size_t)(b * NH + h) * (TP / 32) + kb)) * 8 * 512 + lane * 8;
            const bf16* kp = (SAMPLE ? kfs_ : kf_) + fo; const bf16* vp = (SAMPLE ? vfs_ : vf_) + fo;
#pragma unroll
            for (int ks = 0; ks < 8; ++ks) kf[ks] = *(const bf16x8*)(kp + ks * 512);
#pragma unroll
            for (int f = 0; f < 8; ++f) vf[f] = *(const bf16x8*)(vp + f * 512);
        }
        __builtin_amdgcn_sched_barrier(0);
#pragma unroll
        for (int i = 0; i < 16; ++i) s[i] = 0.f;
#pragma unroll
        for (int ks = 0; ks < 8; ++ks) s = MFMA32(kf[ks], qst[ks * 64], s);
        f32x16 Lv; float own[4], oth[4];
#pragma unroll
        for (int i = 0; i < 16; ++i) {
            const float z = s[i];
            const int kpos = 32 * kb + (i & 3) + 8 * (i >> 2) + 4 * hi;
            const float sp = softplus_f(z);
            Lv[i] = (kpos < qpos) ? -sp : 0.f;
            s[i] = z - sp;
        }
#pragma unroll
        for (int g = 0; g < 4; ++g) { own[g] = (Lv[4 * g] + Lv[4 * g + 1]) + (Lv[4 * g + 2] + Lv[4 * g + 3]); oth[g] = __shfl_xor(own[g], 32); }
        float run = 0.f, after[4];
#pragma unroll
        for (int g = 3; g >= 0; --g) { after[g] = run + (hi == 0 ? oth[g] : 0.f); run += own[g] + oth[g]; }
        bf16x8 pa[2];
        {
            float w[16];
#pragma unroll
            for (int g = 0; g < 4; ++g) {
                float sfx = carry + after[g];
#pragma unroll
                for (int e = 3; e >= 0; --e) {
                    const int i = 4 * g + e;
                    const int kpos = 32 * kb + (i & 3) + 8 * (i >> 2) + 4 * hi;
                    w[i] = (kpos < qpos) ? __expf(s[i] + sfx) : 0.f;
                    sfx += Lv[i];
                }
            }
#pragma unroll
            for (int st = 0; st < 2; ++st) { u32x4 pw; pw.x = pk2(w[8 * st], w[8 * st + 1]); pw.y = pk2(w[8 * st + 2], w[8 * st + 3]); pw.z = pk2(w[8 * st + 4], w[8 * st + 5]); pw.w = pk2(w[8 * st + 6], w[8 * st + 7]);
                pa[st] = __builtin_bit_cast(bf16x8, pw); }
        }
        carry += run;
#pragma unroll
        for (int db = 0; db < 4; ++db)
#pragma unroll
            for (int st = 0; st < 2; ++st) o[db] = MFMA32(vf[db * 2 + st], pa[st], o[db]);
        if (__all(carry < -104.0f)) break;
    }
    if (r32 < nq) {
        bf16* op = YA + (size_t)(qrow0 + r32) * D + h * HD + 4 * hi;
#pragma unroll
        for (int db = 0; db < 4; ++db)
#pragma unroll
            for (int g = 0; g < 4; ++g) { u32x2 w; w.x = pk2(o[db][4 * g], o[db][4 * g + 1]); w.y = pk2(o[db][4 * g + 2], o[db][4 * g + 3]); *(u32x2*)(op + db * 32 + 8 * g) = w; }
    }
}

#define MFMA16(a, b, c) __builtin_amdgcn_mfma_f32_16x16x32_bf16((a), (b), (c), 0, 0, 0)
constexpr int XCS = 72;
template <int NB>
__device__ __forceinline__ void scan16(f32x4 (&A)[NB], f32x4 (&B)[NB], int fr) {
#pragma unroll
    for (int sft = 1; sft < 16; sft <<= 1) {
#pragma unroll
        for (int nb = 0; nb < NB; ++nb)
#pragma unroll
            for (int i = 0; i < 4; ++i) {
                const float ap = __shfl_up(A[nb][i], sft, 16), bp = __shfl_up(B[nb][i], sft, 16);
                if (fr >= sft) { B[nb][i] = A[nb][i] * bp + B[nb][i]; A[nb][i] = A[nb][i] * ap; }
            }
    }
}
template <bool FINAL, bool sample>
__device__ __forceinline__ void lru_unit(const Params& p, int b, int j0, int n, LAS unsigned char* wl, int lane) {
    constexpr int NCH = sample ? 1 : 2;
    const int fr = lane & 15, fq = lane >> 4;
    const int ntok = sample ? TS : 64, nmb = sample ? 1 : 4;
    LAS bf16* xcs = (LAS bf16*)wl;
    const int c = n * 64 + lane;
    f32x4 Hc[4], Pc[4];
    LAS float* cst = (LAS float*)(wl + 9648); LAS u32x2* gst = (LAS u32x2*)(wl + 10416) + lane; (void)gst;
    cst[lane] = C8T[c]; cst[64 + lane] = p.in[12][c]; cst[128 + lane] = p.in[14][c];
#pragma unroll
    for (int nb = 0; nb < 4; ++nb) {
        const int d0 = n * 64 + 16 * nb + 4 * fq;
        Hc[nb] = (f32x4){0.f, 0.f, 0.f, 0.f}; Pc[nb] = (f32x4){1.f, 1.f, 1.f, 1.f};
        if (FINAL && sample) Hc[nb] = *(const f32x4*)(p.in[5] + (size_t)b * D + d0);
    }
    const float* cw = p.in[9]; const float w0 = cw[c], w1 = cw[D + c], w2 = cw[2 * D + c], w3 = cw[3 * D + c], cbias = p.in[10][c];
    if (FINAL && !sample) {
        const float* sp = SUMP + (size_t)b * NCHUNK * D + n * 64 + 4 * fq; const float* sh = SUMH + (size_t)b * NCHUNK * D + n * 64 + 4 * fq;
#pragma unroll 1
        for (int g = 0; g < j0; g += 16) {
            const int jj = g + fr; f32x4 A[4], B[4];
#pragma unroll
            for (int nb = 0; nb < 4; ++nb) { A[nb] = (f32x4){1.f, 1.f, 1.f, 1.f}; B[nb] = (f32x4){0.f, 0.f, 0.f, 0.f};
                if (jj < j0) { A[nb] = *(const f32x4*)(sp + (size_t)jj * D + 16 * nb); B[nb] = *(const f32x4*)(sh + (size_t)jj * D + 16 * nb); } }
            scan16<4>(A, B, fr);
#pragma unroll
            for (int nb = 0; nb < 4; ++nb)
#pragma unroll
                for (int i = 0; i < 4; ++i) { const float pt = __shfl(A[nb][i], 15, 16), ht = __shfl(B[nb][i], 15, 16); Hc[nb][i] = pt * Hc[nb][i] + ht; }
        }
    }
    bf16x8 wa[4][2], wx[4][2];
#pragma unroll
    for (int nb = 0; nb < 4; ++nb)
#pragma unroll
        for (int k = 0; k < 2; ++k) { const size_t off = (size_t)(n * 64 + 16 * nb + fr) * 64 + 8 * fq + 32 * k; wa[nb][k] = *(const bf16x8*)(WAT + off); wx[nb][k] = *(const bf16x8*)(WXT + off); }
#pragma unroll 1
    for (int jc = 0; jc < NCH; ++jc) {
        const int j = j0 + jc;
        const int row0 = sample ? MPR + b * TS : b * TP + j * 64;
        if (FINAL) {
            u32x2 gtmp[16];
#pragma unroll
            for (int q = 0; q < 16; ++q) gtmp[q] = ((q >> 2) < nmb) ? *(const u32x2*)(GG + (size_t)(row0 + 16 * (q >> 2) + fr) * D + n * 64 + 16 * (q & 3) + 4 * fq) : (u32x2){0u, 0u};
#pragma unroll
            for (int q = 0; q < 16; ++q) gst[q * 64] = gtmp[q];
        }
        {
            const int rr = lane >> 3, cc = (lane & 7) * 8;
            u32x4 stg[9];
#pragma unroll
            for (int i = 0; i < 9; ++i) {
                const int tr = 8 * i + rr - 3;
                stg[i] = (u32x4){0u, 0u, 0u, 0u};
                if (tr < ntok) {
                    if (tr >= 0 || (!sample && j > 0)) stg[i] = *(const u32x4*)(XR + (size_t)(row0 + tr) * D + n * 64 + cc);
                    else if (sample) { float hv[8]; ld8f(p.in[4] + ((size_t)b * 3 + (tr + 3)) * D + n * 64 + cc, hv); stg[i] = pack8(hv); }
                }
            }
#pragma unroll
            for (int i = 0; i < 9; ++i) { const int tr = 8 * i + rr - 3; if (tr < ntok) *(LAS u32x4*)(xcs + (tr + 3) * XCS + cc) = stg[i]; }
            asm volatile("s_waitcnt lgkmcnt(0)" ::: "memory");
            float x3 = bf2f(xcs[0 * XCS + lane]), x2 = bf2f(xcs[1 * XCS + lane]), x1 = bf2f(xcs[2 * XCS + lane]);
#pragma unroll 8
            for (int t = 0; t < ntok; ++t) {
                const float x0 = bf2f(xcs[(t + 3) * XCS + lane]);
                const float y = w0 * x3 + w1 * x2 + w2 * x1 + w3 * x0 + cbias;
                xcs[t * XCS + lane] = (bf16)(pk2(y, 0.f) & 0xffffu);
                x3 = x2; x2 = x1; x1 = x0;
            }
            if (FINAL && (sample || j == NCHUNK - 1)) {
                float* o = p.out + (sample ? O_RCS + (size_t)b * 3 * D : O_RCP + (size_t)b * 3 * D) + c;
                o[0] = x3; o[D] = x2; o[2 * D] = x1;
            }
        }
        asm volatile("s_waitcnt lgkmcnt(0)" ::: "memory");
        if (!FINAL) {
#pragma unroll
            for (int nb = 0; nb < 4; ++nb) { Hc[nb] = (f32x4){0.f, 0.f, 0.f, 0.f}; Pc[nb] = (f32x4){1.f, 1.f, 1.f, 1.f}; }
        }
#pragma unroll 1
        for (int mb = 0; mb < 4; ++mb) {
            if (mb < nmb) {
                const LAS bf16* xrow = xcs + (16 * mb + fr) * XCS;
                const bf16x8 xf0 = *(const LAS bf16x8*)(xrow + 8 * fq), xf1 = *(const LAS bf16x8*)(xrow + 8 * fq + 32);
#pragma unroll
                for (int hf = 0; hf < 2; ++hf) {
                    f32x4 A[2], B[2];
#pragma unroll
                    for (int q = 0; q < 2; ++q) {
                        const int nb = 2 * hf + q;
                        f32x4 aa = (f32x4){0.f, 0.f, 0.f, 0.f}, ax = aa;
                        aa = MFMA16(wa[nb][0], xf0, aa); aa = MFMA16(wa[nb][1], xf1, aa);
                        ax = MFMA16(wx[nb][0], xf0, ax); ax = MFMA16(wx[nb][1], xf1, ax);
                        const u32x2 xw = *(const LAS u32x2*)(xrow + 16 * nb + 4 * fq);
                        const f32x4 c8v = *(const LAS f32x4*)(cst + 16 * nb + 4 * fq), bav = *(const LAS f32x4*)(cst + 64 + 16 * nb + 4 * fq), bxv = *(const LAS f32x4*)(cst + 128 + 16 * nb + 4 * fq);
                        const float xc[4] = {bflo(xw.x), bfhi(xw.x), bflo(xw.y), bfhi(xw.y)};
#pragma unroll
                        for (int i = 0; i < 4; ++i) {
                            const float ra = sigmoid_f(aa[i] + bav[i]), ri = sigmoid_f(ax[i] + bxv[i]);
                            const float a = __expf(c8v[i] * ra);
                            A[q][i] = a; B[q][i] = __builtin_amdgcn_sqrtf(fmaxf(1.f - a * a, 0.f)) * (ri * xc[i]);
                        }
                    }
                    scan16<2>(A, B, fr);
#pragma unroll
                    for (int q = 0; q < 2; ++q) {
                        const int nb = 2 * hf + q;
                        f32x4 hv = B[q] + A[q] * Hc[nb], pv = A[q] * Pc[nb];
                        if (!FINAL) {
                            const size_t off = (size_t)(row0 + 16 * mb + fr) * D + n * 64 + 16 * nb + 4 * fq;
                            u32x2 hw; hw.x = pk2(hv.x, hv.y); hw.y = pk2(hv.z, hv.w); *(u32x2*)(HLB + off) = hw;
                            u32x2 pw; pw.x = pk2(pv.x, pv.y); pw.y = pk2(pv.z, pv.w); *(u32x2*)(PCB + off) = pw;
                        }
                        if (FINAL) {
                            const u32x2 gw = gst[(mb * 4 + nb) * 64];
                            u32x2 yw; yw.x = pk2(hv.x * bflo(gw.x), hv.y * bfhi(gw.x)); yw.y = pk2(hv.z * bflo(gw.y), hv.w * bfhi(gw.y));
                            *(u32x2*)(GG + (size_t)(row0 + 16 * mb + fr) * D + n * 64 + 16 * nb + 4 * fq) = yw;
                        }
#pragma unroll
                        for (int i = 0; i < 4; ++i) { Hc[nb][i] = __shfl(hv[i], 15, 16); Pc[nb][i] = __shfl(pv[i], 15, 16); }
                    }
                }
            }
        }
        if (fr == 0) {
#pragma unroll
            for (int nb = 0; nb < 4; ++nb) {
                const int d0 = n * 64 + 16 * nb + 4 * fq;
                if (!FINAL) { const size_t so = ((size_t)b * NCHUNK + j) * D + d0; *(f32x4*)(SUMP + so) = Pc[nb]; *(f32x4*)(SUMH + so) = Hc[nb]; }
                else if (sample || j == NCHUNK - 1) *(f32x4*)(p.out + (sample ? O_HS + (size_t)b * D : O_HP + (size_t)b * D) + d0) = Hc[nb];
            }
        }
        asm volatile("s_waitcnt lgkmcnt(0)" ::: "memory");
    }
}


__device__ __forceinline__ void lru_final_light(const Params& p, int b, int j0, int n, int lane) {
    const int fr = lane & 15, fq = lane >> 4;
    f32x4 Hc[4];
#pragma unroll
    for (int nb = 0; nb < 4; ++nb) Hc[nb] = (f32x4){0.f, 0.f, 0.f, 0.f};
    const float* sp = SUMP + (size_t)b * NCHUNK * D + n * 64 + 4 * fq; const float* sh = SUMH + (size_t)b * NCHUNK * D + n * 64 + 4 * fq;
#pragma unroll 1
    for (int g = 0; g < j0; g += 16) {
        const int jj = g + fr; f32x4 A[4], B[4];
#pragma unroll
        for (int nb = 0; nb < 4; ++nb) { A[nb] = (f32x4){1.f, 1.f, 1.f, 1.f}; B[nb] = (f32x4){0.f, 0.f, 0.f, 0.f};
            if (jj < j0) { A[nb] = *(const f32x4*)(sp + (size_t)jj * D + 16 * nb); B[nb] = *(const f32x4*)(sh + (size_t)jj * D + 16 * nb); } }
        scan16<4>(A, B, fr);
#pragma unroll
        for (int nb = 0; nb < 4; ++nb)
#pragma unroll
            for (int i = 0; i < 4; ++i) { const float pt = __shfl(A[nb][i], 15, 16), ht = __shfl(B[nb][i], 15, 16); Hc[nb][i] = pt * Hc[nb][i] + ht; }
    }
#pragma unroll 1
    for (int jc = 0; jc < 2; ++jc) {
        const int j = j0 + jc, row0 = b * TP + j * 64;
        u32x2 hl[4][4], pc[4][4], gg[4][4];
#pragma unroll
        for (int mb = 0; mb < 4; ++mb)
#pragma unroll
            for (int nb = 0; nb < 4; ++nb) { const size_t off = (size_t)(row0 + 16 * mb + fr) * D + n * 64 + 16 * nb + 4 * fq; hl[mb][nb] = *(const u32x2*)(HLB + off); pc[mb][nb] = *(const u32x2*)(PCB + off); gg[mb][nb] = *(const u32x2*)(GG + off); }
        f32x4 pe[4], he[4];
#pragma unroll
        for (int nb = 0; nb < 4; ++nb) { const size_t so = ((size_t)b * NCHUNK + j) * D + n * 64 + 16 * nb + 4 * fq; pe[nb] = *(const f32x4*)(SUMP + so); he[nb] = *(const f32x4*)(SUMH + so); }
#pragma unroll
        for (int mb = 0; mb < 4; ++mb)
#pragma unroll
            for (int nb = 0; nb < 4; ++nb) {
                const u32x2 a = hl[mb][nb], c = pc[mb][nb], g = gg[mb][nb];
                const float h0 = bflo(a.x) + bflo(c.x) * Hc[nb].x, h1 = bfhi(a.x) + bfhi(c.x) * Hc[nb].y, h2 = bflo(a.y) + bflo(c.y) * Hc[nb].z, h3 = bfhi(a.y) + bfhi(c.y) * Hc[nb].w;
                u32x2 yw; yw.x = pk2(h0 * bflo(g.x), h1 * bfhi(g.x)); yw.y = pk2(h2 * bflo(g.y), h3 * bfhi(g.y));
                *(u32x2*)(GG + (size_t)(row0 + 16 * mb + fr) * D + n * 64 + 16 * nb + 4 * fq) = yw;
            }
#pragma unroll
        for (int nb = 0; nb < 4; ++nb) Hc[nb] = pe[nb] * Hc[nb] + he[nb];
        if (j == NCHUNK - 1) {
            if (fr == 0) {
#pragma unroll
                for (int nb = 0; nb < 4; ++nb) *(f32x4*)(p.out + O_HP + (size_t)b * D + n * 64 + 16 * nb + 4 * fq) = Hc[nb];
            }
            const int c = n * 64 + lane;
#pragma unroll
            for (int i = 0; i < 3; ++i) p.out[O_RCP + ((size_t)b * 3 + i) * D + c] = bf2f(XR[(size_t)(b * TP + TP - 3 + i) * D + c]);
        }
    }
}

constexpr int RSTR = 132;
template <int K>
__device__ __forceinline__ void sgemm_tile(const bf16* A, const bf16* Bt, LAS float* red, int tid, float (&v)[8]) {
    const int lane = tid & 63, w = __builtin_amdgcn_readfirstlane(tid >> 6), fr = lane & 15, fq = lane >> 4;
    constexpr int KW = K / 8, NKS = KW / 32;
    f32x4 acc[2][8];
#pragma unroll
    for (int mb = 0; mb < 2; ++mb)
#pragma unroll
        for (int nb = 0; nb < 8; ++nb) acc[mb][nb] = (f32x4){0.f, 0.f, 0.f, 0.f};
    const bf16* ap = A + (size_t)fr * K + w * KW + 8 * fq;
    const bf16* bp = Bt + (size_t)fr * K + w * KW + 8 * fq;
#pragma unroll (NKS == 4 ? 4 : 3)
    for (int ks = 0; ks < NKS; ++ks) {
        bf16x8 af[2], bb[8];
#pragma unroll
        for (int mb = 0; mb < 2; ++mb) af[mb] = *(const bf16x8*)(ap + (size_t)mb * 16 * K + ks * 32);
#pragma unroll
        for (int nb = 0; nb < 8; ++nb) bb[nb] = *(const bf16x8*)(bp + (size_t)nb * 16 * K + ks * 32);
#pragma unroll
        for (int mb = 0; mb < 2; ++mb)
#pragma unroll
            for (int nb = 0; nb < 8; ++nb) acc[mb][nb] = MFMA16(bb[nb], af[mb], acc[mb][nb]);
    }
    LAS float* slab = red + w * (32 * RSTR);
#pragma unroll
    for (int mb = 0; mb < 2; ++mb)
#pragma unroll
        for (int nb = 0; nb < 8; ++nb) *(LAS f32x4*)(slab + (16 * mb + fr) * RSTR + 16 * nb + 4 * fq) = acc[mb][nb];
    __syncthreads();
    const int row = tid >> 4, c8 = (tid & 15) * 8;
    f32x4 s0 = (f32x4){0.f, 0.f, 0.f, 0.f}, s1 = s0;
#pragma unroll
    for (int sl = 0; sl < 8; ++sl) { const LAS float* q = red + sl * (32 * RSTR) + row * RSTR + c8; s0 += *(const LAS f32x4*)q; s1 += *(const LAS f32x4*)(q + 4); }
    v[0] = s0.x; v[1] = s0.y; v[2] = s0.z; v[3] = s0.w; v[4] = s1.x; v[5] = s1.y; v[6] = s1.z; v[7] = s1.w;
    __syncthreads();
}

#define XB_TMO      128
#define XB_XCNT(j)  (256  + 64 * (j))
#define XB_XSUB(j)  (1280 + 64 * (j))
#define XB_XGEN(j)  (2304 + 64 * (j))
#define XB_TOP      3328
#define XB_TOPGEN   3392
#define XCD_BAR_WORDS 3456
#define XB_SPIN_CAP (1u << 18)

__device__ __forceinline__ unsigned xb_ld(unsigned* p)              { return __hip_atomic_load(p, __ATOMIC_RELAXED, __HIP_MEMORY_SCOPE_AGENT); }
__device__ __forceinline__ unsigned xb_add(unsigned* p, unsigned v) { return __hip_atomic_fetch_add(p, v, __ATOMIC_RELAXED, __HIP_MEMORY_SCOPE_AGENT); }
__device__ __forceinline__ unsigned xb_xcc_id() { return (unsigned)__builtin_amdgcn_s_getreg((3 << 11) | 20) & 0xFu; }
#define XB_SPIN(cond, bar) do { unsigned _sp = 0; while (cond) { __builtin_amdgcn_s_sleep(1); \
    if ((++_sp & 255u) == 0u) { if (xb_ld(&(bar)[XB_TMO])) break; if (_sp > XB_SPIN_CAP) { atomicAdd(&(bar)[XB_TMO], 1u); break; } } } } while (0)

struct XcdBarrier {
    unsigned* bar; unsigned x;
    volatile LAS unsigned* st;
};

__device__ __forceinline__ XcdBarrier xcd_barrier_post(unsigned* bar, volatile LAS unsigned* st) {
    XcdBarrier b; b.bar = bar; b.x = xb_xcc_id(); b.st = st;
    if (threadIdx.x == 0) (void)xb_add(&bar[XB_XCNT(b.x)], 1u);
    return b;
}
__device__ __forceinline__ void xcd_barrier_complete(unsigned* bar, unsigned x, unsigned& nloc, unsigned& nx) {
    const unsigned G = gridDim.x * gridDim.y * gridDim.z;
    unsigned sum, cnt, mine, sp = 0u;
    for (;;) {
        sum = 0u; cnt = 0u; mine = 0u;
#pragma unroll
        for (unsigned j = 0; j < 16; ++j) { const unsigned c = xb_ld(&bar[XB_XCNT(j)]); sum += c; cnt += (c > 0u) ? 1u : 0u; mine = (j == x) ? c : mine; }
        if (sum == G) break;
        __builtin_amdgcn_s_sleep(1);
        if ((++sp & 255u) == 0u) { if (xb_ld(&bar[XB_TMO])) break; if (sp > XB_SPIN_CAP) { atomicAdd(&bar[XB_TMO], 1u); break; } }
    }
    nloc = mine > 0u ? mine : 1u; nx = cnt > 0u ? cnt : 1u;
}

__device__ __forceinline__ void xcd_barrier(const XcdBarrier& b) {
    asm volatile("s_waitcnt vmcnt(0)" ::: "memory");
    __syncthreads();
    if (threadIdx.x == 0) {
        unsigned* bar = b.bar;
        __builtin_amdgcn_s_waitcnt(0);
        unsigned nloc = b.st[0], nx = b.st[1];
        if (nloc == 0u) { xcd_barrier_complete(bar, b.x, nloc, nx); b.st[0] = nloc; b.st[1] = nx; }
        const unsigned old = xb_add(&bar[XB_XSUB(b.x)], 1u);
        const unsigned gen = old / nloc;
        if (old + 1u == (gen + 1u) * nloc) {
            __builtin_amdgcn_fence(__ATOMIC_RELEASE, "agent");
            asm volatile("s_waitcnt vmcnt(0)" ::: "memory");
            const unsigned og = xb_add(&bar[XB_TOP], 1u);
            const unsigned tg = og / nx;
            if (og + 1u == (tg + 1u) * nx) xb_add(&bar[XB_TOPGEN], 1u);
            else XB_SPIN(xb_ld(&bar[XB_TOPGEN]) == tg, bar);
            __builtin_amdgcn_fence(__ATOMIC_ACQUIRE, "agent");
            xb_add(&bar[XB_XGEN(b.x)], 1u);
            asm volatile("s_waitcnt vmcnt(0)" ::: "memory");
        } else {
            XB_SPIN(xb_ld(&bar[XB_XGEN(b.x)]) == gen, bar);
            __builtin_amdgcn_fence(__ATOMIC_ACQUIRE, "agent");
            asm volatile("s_waitcnt vmcnt(0)" ::: "memory");
        }
    }
    __syncthreads();
}

__global__ void __launch_bounds__(512, 2) hawk_fwd(Params p) {
    extern __shared__ __attribute__((aligned(16))) unsigned char lds_raw[];
    cg::grid_group grid = cg::this_grid();
    LAS unsigned char* lds = (LAS unsigned char*)lds_raw;
    const int G = gridDim.x, NGW = G * 8;
    { volatile LAS unsigned* xb_st0 = (volatile LAS unsigned*)(lds + (LDS_BYTES - 16)); if (threadIdx.x < 4) xb_st0[threadIdx.x] = 0u; }
    __syncthreads();
    volatile LAS unsigned* xb_st = (volatile LAS unsigned*)(lds + (LDS_BYTES - 16));
    (void)xcd_barrier_post((unsigned*)(p.ws + WS_CTL + 69632), xb_st);
    if (p.ws == nullptr) grid.sync();
#define XBAR() do { XcdBarrier xb_; xb_.bar = (unsigned*)(p.ws + WS_CTL + 69632); xb_.x = xb_xcc_id(); xb_.st = (volatile LAS unsigned*)(lds + (LDS_BYTES - 16)); xcd_barrier(xb_); } while (0)
    unsigned long long pr_acc = 0, pr_t = 0; (void)pr_acc; (void)pr_t;
#define PR_BEGIN(k) do { if constexpr ((PROBE_MASK >> (k)) & 1) pr_t = __builtin_amdgcn_s_memrealtime(); } while (0)
#define PR_END(k) do { if constexpr ((PROBE_MASK >> (k)) & 1) pr_acc += __builtin_amdgcn_s_memrealtime() - pr_t; } while (0)
#define PHASE_IDS int tid = threadIdx.x; asm volatile("" : "+v"(tid)); const int lane = tid & 63, wave = __builtin_amdgcn_readfirstlane(tid >> 6), gw = blockIdx.x * 8 + wave; (void)lane; (void)gw;

    PR_BEGIN(0);
    if constexpr ((PH_MASK >> 0) & 1) {
        PHASE_IDS
        LAS float* scr = (LAS float*)(lds + wave * 16384);
        constexpr int I_IN = (D / 64) * (DIN / 32), I_LB = 2;
        constexpr int NITEMS = I_IN + 32 * I_LB;
        for (int it = gw; it < NITEMS; it += NGW) {
            int r = it;
            if (r < I_IN) { p0_transpose_item(p.in[8], D, DIN, WIN, scr, r, lane); continue; } r -= I_IN;
            { const int which = r / (16 * I_LB), rr = r % (16 * I_LB), blk = rr / I_LB, item = rr % I_LB;
              p0_transpose_item((which ? p.in[13] : p.in[11]) + (size_t)blk * 4096, 64, 64, (which ? WXT : WAT) + (size_t)blk * 4096, scr, item, lane); }
        }
        if (blockIdx.x == 0) for (int d = tid; d < D; d += 512) C8T[d] = -8.f * log1pf(expf(-p.in[15][d]));
        for (int m = gw; m < MROWS; m += NGW)
            rms_row(m < MPR ? p.in[0] + (size_t)m * D : p.in[1] + (size_t)(m - MPR) * D, p.in[7], U1 + (size_t)m * D, lane);
    }
    XBAR();
    PR_END(0);

    PR_BEGIN(1);
    if constexpr ((PH_MASK >> 1) & 1) {
        {
            int tid = threadIdx.x; asm volatile("" : "+v"(tid));
            for (int un = blockIdx.x; un < 4 * (DIN / 128); un += G) {
                const int ru = un & 3, n0 = (un >> 2) * 128; float v[8];
                sgemm_tile<D>(U1 + (size_t)(MPR + 32 * ru) * D, WIN + (size_t)n0 * D, (LAS float*)lds, tid, v);
                const int r = MPR + 32 * ru + (tid >> 4), seg = n0 >> 10, cin = (tid & 15) * 8, c = (n0 & 1023) + cin;
                if (seg == 2 || seg == 3) {
                    float ss = 0.f;
#pragma unroll
                    for (int e = 0; e < 8; ++e) ss += v[e] * v[e];
                    const float rs = rsqrtf(sum16(ss) * (1.f / HD) + EPS);
                    float gn[8]; ld8f((seg == 2 ? p.in[16] : p.in[17]) + cin, gn);
#pragma unroll
                    for (int e = 0; e < 8; ++e) v[e] = v[e] * rs * gn[e];
                    if (seg == 3) { st8f(p.out + O_KS + (size_t)(r - MPR) * D + c, v); const int sb = (r - MPR) >> 4, t = (r - MPR) & 15, hh = (n0 & 1023) >> 7;
                        *(u32x4*)(KFs + (((size_t)(sb * NH + hh) * 8 + (cin >> 4)) * 512 + (t + 32 * ((cin >> 3) & 1)) * 8)) = pack8(v); }
                    else {
#pragma unroll
                        for (int e = 0; e < 8; ++e) v[e] *= 0.08838834764831845f;
                        *(u32x4*)(QN + (size_t)r * D + c) = pack8(v); }
                } else if (seg == 4) {
                    st8f(p.out + O_VS + (size_t)(r - MPR) * D + c, v);
                    const int sb = (r - MPR) >> 4, t = (r - MPR) & 15, hh = (n0 & 1023) >> 7;
                    bf16* vt = VFs + (((size_t)(sb * NH + hh) * 4 + (cin >> 5)) * 2 + 0) * 512 + ((cin & 31) + 32 * ((t >> 2) & 1)) * 8 + 4 * (t >> 3) + (t & 3); const u32x4 w = pack8(v);
                    vt[0] = (bf16)w.x; vt[8] = (bf16)(w.x >> 16); vt[16] = (bf16)w.y; vt[24] = (bf16)(w.y >> 16); vt[32] = (bf16)w.z; vt[40] = (bf16)(w.z >> 16); vt[48] = (bf16)w.w; vt[56] = (bf16)(w.w >> 16);
                } else {
                    if (seg == 1) {
#pragma unroll
                        for (int e = 0; e < 8; ++e) v[e] = gelu_f(v[e]);
                    } else if (seg >= 5) {
#pragma unroll
                        for (int e = 0; e < 8; ++e) v[e] = sigmoid_f(v[e]);
                    }
                    bf16* dst = (seg == 0) ? XR : (seg == 1) ? GG : (seg == 5) ? SG1 : SG2;
                    *(u32x4*)(dst + (size_t)r * D + c) = pack8(v);
                }
            }
        }
        pg8::Gemm g{U1, WIN, MPR, DIN, D}; pg8::StaticOrder S; S.init(MPR, DIN, G, (int)blockIdx.x);
        EpiIn E{XR, GG, QN, KF, VF, SG1, SG2, p.out, p.in[16], p.in[17], (LAS float*)(lds + LDS_SCR)};
        pg8::gemm_phase<EpiIn, pg8::StaticOrder, true, true>(lds, g, S, E);
    }
    XBAR();
    PR_END(1);

    PR_BEGIN(2);
    if constexpr ((PH_MASK >> 2) & 1) {
        PHASE_IDS
        constexpr int NA_P = BP * NH * (TP / 32), NA_S = BS * NH, NL = BP * (NCHUNK / 2) * 16;
        for (int su = blockIdx.x; su < NA_S; su += G) {
            const int b = su / NH, h = su % NH, r32 = lane & 31, hi = lane >> 5, kb = PAST / 32 - 1 - wave;
            LAS bf16x8* sl = (LAS bf16x8*)(lds + wave * 16384) + lane;
            const float* kp = p.in[2] + (((size_t)b * PAST + 32 * kb + r32) * NH + h) * HD + 8 * hi;
#pragma unroll
            for (int ks = 0; ks < 8; ++ks) { const f32x4 a = *(const f32x4*)(kp + 16 * ks), c = *(const f32x4*)(kp + 16 * ks + 4);
                u32x4 w; w.x = pk2(a.x, a.y); w.y = pk2(a.z, a.w); w.z = pk2(c.x, c.y); w.w = pk2(c.z, c.w); sl[ks * 64] = __builtin_bit_cast(bf16x8, w); }
#pragma unroll
            for (int f = 0; f < 8; ++f) {
                const int k0 = 32 * kb + 16 * (f & 1) + 4 * hi;
                const float* vp = p.in[3] + (((size_t)b * PAST + k0) * NH + h) * HD + (f >> 1) * 32 + r32;
                float e[8];
#pragma unroll
                for (int j = 0; j < 8; ++j) e[j] = vp[(size_t)(8 * (j >> 2) + (j & 3)) * (NH * HD)];
                u32x4 w; w.x = pk2(e[0], e[1]); w.y = pk2(e[2], e[3]); w.z = pk2(e[4], e[5]); w.w = pk2(e[6], e[7]); sl[512 + f * 64] = __builtin_bit_cast(bf16x8, w);
            }
            __syncthreads();
            if (wave == 0) { PR_BEGIN(9); attn_unit<true>(QN, KF, VF, KFs, VFs, p.in[2], p.in[3], QN, b, h, 0, lds + LDS_SCR, lds, lane); PR_END(9); }
            __syncthreads();
        }
        for (int it = gw; it < NA_P; it += NGW) {
            const int grp = it >> 3, bh = grp & (BP * NH - 1), qb = (TP / 32 - 1) - ((grp / (BP * NH)) * 8 + (it & 7)); attn_unit<false>(QN, KF, VF, KFs, VFs, p.in[2], p.in[3], QN, bh / NH, bh % NH, qb, lds + wave * WLDS, lds, lane); }
        PR_BEGIN(10);
        for (int r = gw; r < NL; r += NGW) lru_unit<false, false>(p, r / ((NCHUNK / 2) * 16), 2 * ((r / 16) % (NCHUNK / 2)), r % 16, lds + wave * WLDS, lane);
        PR_END(10);
    }
    XBAR();
    PR_END(2);

    PR_BEGIN(3);
    if constexpr ((PH_MASK >> 3) & 1) {
        PHASE_IDS
        constexpr int NL = BP * (NCHUNK / 2) * 16, NLS = BS * 16;
        if (NGW == 2048) {
            const int q = (gw >> 4) & 31;
            if (q >= 30) { const int r = (q - 30) * 64 + (gw >> 9) * 16 + (gw & 15); lru_unit<true, true>(p, r / 16, 0, r % 16, lds + wave * WLDS, lane); }
            lru_final_light(p, gw / ((NCHUNK / 2) * 16), 2 * ((NCHUNK / 2 - 1) - q), gw % 16, lane);
        } else {
            for (int it = gw; it < NL + NLS; it += NGW) {
                if (it < NL) lru_final_light(p, it / ((NCHUNK / 2) * 16), 2 * ((NCHUNK / 2 - 1) - ((it / 16) % (NCHUNK / 2))), it % 16, lane);
                else { const int r = it - NL; lru_unit<true, true>(p, r / 16, 0, r % 16, lds + wave * WLDS, lane); }
            }
        }
        {
            LAS float* scr = (LAS float*)(lds + wave * WLDS);
            constexpr int I_SQ = (D / 64) * (D / 32), I_UP = (D / 64) * (2 * DFF / 32), I_DN = (DFF / 64) * (D / 32);
            for (int it = gw; it < 3 * I_SQ + I_UP + I_DN; it += NGW) {
                int r = it;
                if (r < I_SQ) { p0_transpose_item(p.in[18], D, D, WPR, scr, r, lane); continue; } r -= I_SQ;
                if (r < I_SQ) { p0_transpose_item(p.in[19], D, D, WPA, scr, r, lane); continue; } r -= I_SQ;
                if (r < I_SQ) { p0_transpose_item(p.in[20], D, D, WOUT, scr, r, lane); continue; } r -= I_SQ;
                if (r < I_UP) { p0_transpose_item(p.in[22], D, 2 * DFF, WUP, scr, r, lane); continue; } r -= I_UP;
                p0_transpose_item(p.in[25], DFF, D, WDN, scr, r, lane);
            }
        }
    }
    XBAR();
    PR_END(3);

    PR_BEGIN(4);
    if constexpr ((PH_MASK >> 4) & 1) {
        {
            int tid = threadIdx.x; asm volatile("" : "+v"(tid));
            for (int un = blockIdx.x; un < 4 * (D / 128); un += G) {
                const int ru = un & 3, n0 = (un >> 2) * 128; float a[8], b2[8];
                sgemm_tile<D>(GG + (size_t)(MPR + 32 * ru) * D, WPR + (size_t)n0 * D, (LAS float*)lds, tid, a);
                sgemm_tile<D>(QN + (size_t)(MPR + 32 * ru) * D, WPA + (size_t)n0 * D, (LAS float*)lds, tid, b2);
                const size_t off = (size_t)(MPR + 32 * ru + (tid >> 4)) * D + n0 + (tid & 15) * 8;
                float g1[8], g2[8]; unpack8(*(const u32x4*)(SG1 + off), g1); unpack8(*(const u32x4*)(SG2 + off), g2);
#pragma unroll
                for (int e = 0; e < 8; ++e) a[e] = a[e] * g1[e] + b2[e] * g2[e];
                *(u32x4*)(MG + off) = pack8(a);
            }
        }
        static_assert(WS_S1 - WS_S0 == (size_t)(MP / 256) * 256 * D * 2 && WS_WPA - WS_WPR == (size_t)4 * 256 * D * 2, "operand adjacency the paired units rely on");
        PairOrder S; S.base.init(MPR, D, G, (int)blockIdx.x);
        pg8::Gemm g{GG, WPR, MPR, D, D}; EpiP4 E{EpiT1{SG1, T1}, EpiMG{SG2, T1, MG}};
        pg8::gemm_phase<EpiP4, PairOrder, true, true>(lds, g, S, E);
    }
    XBAR();
    PR_END(4);

    PR_BEGIN(5);
    if constexpr ((PH_MASK >> 5) & 1) {
        {
            int tid = threadIdx.x; asm volatile("" : "+v"(tid));
            for (int un = blockIdx.x; un < 4 * (D / 128); un += G) {
                const int ru = un & 3, n0 = (un >> 2) * 128; float v[8], xv[8], lv[8];
                sgemm_tile<D>(MG + (size_t)(MPR + 32 * ru) * D, WOUT + (size_t)n0 * D, (LAS float*)lds, tid, v);
                const int r = MPR + 32 * ru + (tid >> 4), col = n0 + (tid & 15) * 8;
                ld8f(p.in[1] + (size_t)(r - MPR) * D + col, xv); ld8f(p.in[21] + col, lv);
                float ss = 0.f;
#pragma unroll
                for (int e = 0; e < 8; ++e) { v[e] += xv[e]; ss += v[e] * v[e]; }
                st8f(p.out + (size_t)r * D + col, v);
#pragma unroll
                for (int e = 0; e < 8; ++e) v[e] *= lv[e];
                *(u32x4*)(U2 + (size_t)r * D + col) = pack8(v);
                ss = sum16(ss);
                if ((tid & 15) == 0) atomicAdd(SS2 + r, ss);
            }
        }
        pg8::Gemm g{MG, WOUT, MPR, D, D}; pg8::StaticOrder S; S.init(MPR, D, G, (int)blockIdx.x);
        EpiX1 E{p.in[0], p.in[1], p.in[21], p.out, U2, SS2};
        pg8::gemm_phase<EpiX1, pg8::StaticOrder, true, true>(lds, g, S, E);
    }
    XBAR();
    PR_END(5);

    PR_BEGIN(6);
    if constexpr ((PH_MASK >> 6) & 1) {
        {
            int tid = threadIdx.x; asm volatile("" : "+v"(tid));
            for (int un = blockIdx.x; un < 4 * (2 * DFF / 128); un += G) {
                const int ru = un & 3, n0 = (un >> 2) * 128; float v[8];
                sgemm_tile<D>(U2 + (size_t)(MPR + 32 * ru) * D, WUP + (size_t)n0 * D, (LAS float*)lds, tid, v);
                const int r = MPR + 32 * ru + (tid >> 4), col = n0 + (tid & 15) * 8;
                const float rs = rsqrtf(SS2[r] * (1.f / D) + EPS);
#pragma unroll
                for (int e = 0; e < 8; ++e) v[e] *= rs;
                bf16* dst = (col < DFF) ? GP + (size_t)r * DFF + col : VAL + (size_t)r * DFF + (col - DFF);
                *(u32x4*)dst = pack8(v);
            }
        }
        pg8::Gemm g{U2, WUP, MPR, 2 * DFF, D}; pg8::StaticOrder S; S.init(MPR, 2 * DFF, G, (int)blockIdx.x);
        EpiUp E{SS2, GP, VAL};
        pg8::gemm_phase<EpiUp, pg8::StaticOrder, true, true>(lds, g, S, E);
    }
    XBAR();
    PR_END(6);

    PR_BEGIN(7);
    if constexpr ((PH_MASK >> 7) & 1) {
        PHASE_IDS
        constexpr int NCC = DFF / 8, NITEMS = (MROWS / 16) * NCC;
        const float* fw = p.in[23]; const float* fb = p.in[24];
        for (int it = blockIdx.x * 512 + tid; it < NITEMS; it += G * 512) {
            const int rg = it / NCC, c0 = (it % NCC) * 8, r0 = rg * 16;
            float gm2[8], gm1[8], w0[8], w1[8], w2[8], bb[8];
#pragma unroll
            for (int e = 0; e < 8; ++e) { w0[e] = fw[c0 + e]; w1[e] = fw[DFF + c0 + e]; w2[e] = fw[2 * DFF + c0 + e]; bb[e] = fb[c0 + e]; gm2[e] = 0.f; gm1[e] = 0.f; }
            const bool smp = r0 >= MPR;
            if (smp) { const float* hs = p.in[6] + (size_t)((r0 - MPR) >> 4) * 2 * DFF + c0;
#pragma unroll
                for (int e = 0; e < 8; ++e) { gm2[e] = hs[e]; gm1[e] = hs[DFF + e]; } }
            else if ((r0 & (TP - 1)) != 0) { unpack8(*(const u32x4*)(GP + (size_t)(r0 - 2) * DFF + c0), gm2); unpack8(*(const u32x4*)(GP + (size_t)(r0 - 1) * DFF + c0), gm1); }
#pragma unroll 4
            for (int k = 0; k < 16; ++k) {
                float g2[8], vv[8]; const size_t off = (size_t)(r0 + k) * DFF + c0;
                unpack8(*(const u32x4*)(GP + off), g2); unpack8(*(const u32x4*)(VAL + off), vv);
                float hm[8];
#pragma unroll
                for (int e = 0; e < 8; ++e) { hm[e] = gelu_f(w0[e] * gm2[e] + w1[e] * gm1[e] + w2[e] * g2[e] + bb[e]) * vv[e]; gm2[e] = gm1[e]; gm1[e] = g2[e]; }
                u32x4 w; w.x = pk2(hm[0], hm[1]); w.y = pk2(hm[2], hm[3]); w.z = pk2(hm[4], hm[5]); w.w = pk2(hm[6], hm[7]);
                *(u32x4*)(VAL + off) = w;
            }
            if (smp || ((r0 + 16) & (TP - 1)) == 0) {
                float* o = p.out + (smp ? O_FCS + (size_t)((r0 - MPR) >> 4) * 2 * DFF : O_FCP + (size_t)(r0 >> 12) * 2 * DFF) + c0;
#pragma unroll
                for (int e = 0; e < 8; ++e) { o[e] = gm2[e]; o[DFF + e] = gm1[e]; }
            }
        }
    }
    XBAR();
    PR_END(7);

    PR_BEGIN(8);
    if constexpr ((PH_MASK >> 8) & 1) {
        {
            int tid = threadIdx.x; asm volatile("" : "+v"(tid));
            for (int un = blockIdx.x; un < 4 * (D / 128); un += G) {
                const int ru = un & 3, n0 = (un >> 2) * 128; float v[8], xv[8];
                sgemm_tile<DFF>(VAL + (size_t)(MPR + 32 * ru) * DFF, WDN + (size_t)n0 * DFF, (LAS float*)lds, tid, v);
                float* o = p.out + (size_t)(MPR + 32 * ru + (tid >> 4)) * D + n0 + (tid & 15) * 8;
                ld8f(o, xv);
#pragma unroll
                for (int e = 0; e < 8; ++e) v[e] += xv[e];
                st8f(o, v);
            }
        }
        pg8::Gemm g{VAL, WDN, MPR, D, DFF}; pg8::StaticOrder S; S.init(MPR, D, G, (int)blockIdx.x);
        EpiDown E{p.out};
        pg8::gemm_phase<EpiDown, pg8::StaticOrder, true, true>(lds, g, S, E);
    }
    PR_END(8);
    if constexpr (PROBE_MASK != 0) { const unsigned long long te = __builtin_amdgcn_s_memrealtime(); while (__builtin_amdgcn_s_memrealtime() - te < PROBE_MULT * pr_acc) __builtin_amdgcn_s_sleep(8); }
}

extern "C" void kernel_launch(void* const* d_in, const int* in_sizes, int n_in, void* d_out, int out_size, void* d_ws, size_t ws_size, hipStream_t stream) {
    static int grid = 0;
    if (grid == 0) {
        if (n_in != 26 || (size_t)out_size != O_END || ws_size < WS_END) { fprintf(stderr, "kernel_launch: unexpected shapes: n_in %d out %d ws %zu (need %zu)\n", n_in, out_size, ws_size, (size_t)WS_END); grid = -1; return; }
        int dev = 0, cus = 0, per_cu = 0;
        hipGetDevice(&dev); hipDeviceGetAttribute(&cus, hipDeviceAttributeMultiprocessorCount, dev);
        if (hipFuncSetAttribute((const void*)hawk_fwd, hipFuncAttributeMaxDynamicSharedMemorySize, LDS_BYTES) != hipSuccess) { fprintf(stderr, "kernel_launch: hipFuncSetAttribute failed\n"); grid = -1; return; }
        if (hipOccupancyMaxActiveBlocksPerMultiprocessor(&per_cu, (const void*)hawk_fwd, 512, LDS_BYTES) != hipSuccess || per_cu < 1) { fprintf(stderr, "kernel_launch: occupancy query gave %d\n", per_cu); (void)hipGetLastError(); per_cu = 1; }
        grid = cus * per_cu;
    }
    if (grid < 0) return;
    (void)hipMemsetAsync((char*)d_ws + WS_CTL, 0, 131072, stream);
    Params prm{};
    for (int i = 0; i < 26; ++i) prm.in[i] = (const float*)d_in[i];
    prm.out = (float*)d_out; prm.ws = (unsigned char*)d_ws;
    void* args[] = {&prm};
    hipError_t e = hipLaunchCooperativeKernel((const void*)hawk_fwd, dim3(grid), dim3(512), args, LDS_BYTES, stream);
    if (e != hipSuccess) fprintf(stderr, "cooperative launch failed: %s (grid %d)\n", hipGetErrorString(e), grid);
}
```

```cpp
#include <hip/hip_runtime.h>
#include <hip/hip_cooperative_groups.h>
#include <cstdio>
#include <cstdint>
#include <cmath>
namespace cg = cooperative_groups;
#ifndef PH_MASK
#define PH_MASK 0x1ff
#endif
#ifndef PROBE_MASK
#define PROBE_MASK 0
#endif
#ifndef PROBE_MULT
#define PROBE_MULT 2
#endif
namespace pg8 {
#define PG8_LAS __attribute__((address_space(3)))
typedef unsigned short bf16_t;
typedef short bf16x8 __attribute__((ext_vector_type(8)));
typedef float f32x4 __attribute__((ext_vector_type(4)));
typedef unsigned u32x4 __attribute__((ext_vector_type(4)));
constexpr int BM = 256, BK = 64, HALF = 128, HTB = HALF * BK * 2  , STAGE_BYTES = 8 * HTB, NXCD = 8, WGM = 8;

__host__ __device__ __forceinline__ int lds_byte(int r, int c) { const int st = (r >> 4) * 2 + (c >> 5), rr = r & 15, cc = c & 31, ob = rr * 64 + cc * 2; return st * 1024 + (ob ^ (((ob >> 9) & 1) << 5)); }
__host__ __device__ __forceinline__ void stage_rc(int b, int& R, int& C) { const int st = b / 1024, sb = b % 1024, swz = sb ^ (((sb >> 9) & 1) << 5); R = (st >> 1) * 16 + swz / 64; C = (st & 1) * 32 + (swz % 64) / 2; }
__host__ __device__ __forceinline__ int perm32(int rho) { const int n = rho >> 4, i = rho & 15; return 8 * (i >> 2) + 4 * n + (i & 3); }

struct Unit { int pm, pn; };
struct Gemm { const bf16_t* A; const bf16_t* Bt; int M, N, K; };

struct StaticOrder {
    int nM, nN, nwg, G, c;
    __host__ __device__ void init(int M, int N, int G_, int c_) { nM = M / BM; nN = N / BM; nwg = nM * nN; G = G_; c = c_; }
    __host__ __device__ bool next(int i, Unit& u) const {
        const long L = (long)i * G + c; if (L >= nwg) return false;
        int wgid = (int)L; { const int q = nwg / NXCD, r = nwg % NXCD, xcd = wgid % NXCD, off = wgid / NXCD; wgid = (xcd < r ? xcd * (q + 1) : r * (q + 1) + (xcd - r) * q) + off; }
        const int nig = WGM * nN, gid = wgid / nig, fm = gid * WGM, gsz = (nM - fm) < WGM ? (nM - fm) : WGM;
        u.pm = fm + ((wgid % nig) % gsz); u.pn = (wgid % nig) / gsz; return true;
    }
    __device__ __forceinline__ void a_ready(const Unit&) const {}
    __device__ __forceinline__ void done(const Unit&) const {}
};

__device__ __forceinline__ unsigned cvt_pk_bf16(float lo, float hi) { unsigned r; asm volatile("v_cvt_pk_bf16_f32 %0, %1, %2" : "=v"(r) : "v"(lo), "v"(hi)); return r; }
typedef float f32x2 __attribute__((ext_vector_type(2)));
__device__ __forceinline__ f32x2 gelu_pk(f32x2 v) {
    const f32x2 av = __builtin_elementwise_abs(v), d = av * 0.2316418882f + 1.0f;
    f32x2 t; t.x = __builtin_amdgcn_rcpf(d.x); t.y = __builtin_amdgcn_rcpf(d.y);
    f32x2 q = t * 0.5307027145f + (-0.7265760135f); q = q * t + 0.7107068705f; q = q * t + (-0.142248368f); q = q * t + 0.127414796f; q = q * t;
    const f32x2 s = (v * v) * (-0.72134752044f);
    f32x2 e; e.x = __builtin_amdgcn_exp2f(s.x); e.y = __builtin_amdgcn_exp2f(s.y);
    const f32x2 m = v * (q * e), r = v - m;
    f32x2 o; o.x = v.x < 0.f ? m.x : r.x; o.y = v.y < 0.f ? m.y : r.y; return o;
}

template <int ACT  > struct EpiBf16 {
    static constexpr bool PERM = true, AFTER_DRAIN = false; static_assert(ACT == 0 || ACT == 1, "EpiBf16: ACT is 0 (none) or 1 (gelu_pk)");
    bf16_t* O; int ldc; const float* bias; int split_cols; size_t split_stride; float scale0;
    __device__ __forceinline__ void operator()(const f32x4 (&acc)[2][2][4][2], const Unit& u, int wr, int wc, int fr, int fq) const {
        const int row0 = u.pm * BM + wr * 64 + fr; int colt = u.pn * BM; bf16_t* base = O;
        float sc = 1.f; if (split_cols) { const int t = colt / split_cols; base += (size_t)t * split_stride; colt -= t * split_cols; if (t == 0) sc = scale0; }
        const int col0 = colt + wc * 32 + 8 * fq, bcol0 = u.pn * BM + wc * 32 + 8 * fq;
        f32x4 bv[2][2];
#pragma unroll
        for (int bj = 0; bj < 2; ++bj)
#pragma unroll
            for (int n = 0; n < 2; ++n) bv[bj][n] = bias ? *(const f32x4*)(bias + bcol0 + bj * HALF + 4 * n) : (f32x4){0.f, 0.f, 0.f, 0.f};
#pragma unroll
        for (int ai = 0; ai < 2; ++ai)
#pragma unroll
            for (int m = 0; m < 4; ++m) { bf16_t* rowp = base + (size_t)(row0 + ai * HALF + m * 16) * ldc + col0;
#pragma unroll
                for (int bj = 0; bj < 2; ++bj) { f32x4 v0 = acc[ai][bj][m][0] + bv[bj][0], v1 = acc[ai][bj][m][1] + bv[bj][1];
                    if (ACT == 1) { f32x2 a = gelu_pk((f32x2){v0[0], v0[1]}), b = gelu_pk((f32x2){v0[2], v0[3]}), c = gelu_pk((f32x2){v1[0], v1[1]}), d = gelu_pk((f32x2){v1[2], v1[3]});
                        v0 = (f32x4){a.x, a.y, b.x, b.y}; v1 = (f32x4){c.x, c.y, d.x, d.y}; }
                    v0 = v0 * sc; v1 = v1 * sc; u32x4 w; w.x = cvt_pk_bf16(v0[0], v0[1]); w.y = cvt_pk_bf16(v0[2], v0[3]); w.z = cvt_pk_bf16(v1[0], v1[1]); w.w = cvt_pk_bf16(v1[2], v1[3]);
                    *(u32x4*)(rowp + bj * HALF) = w; } }
    }
};
template <class Epi, class Sched, bool ALIGN_EPI = false, bool SP2 = false>
__device__ __forceinline__ void gemm_phase(PG8_LAS unsigned char* lds, const Gemm g, const Sched& S, const Epi& E) {
    int tid_l = threadIdx.x; asm volatile("" : "+v"(tid_l));
    const int tid = tid_l, wid = __builtin_amdgcn_readfirstlane(tid >> 6), lane = tid & 63, wr = wid >> 2, wc = wid & 3, fr = lane & 15, fq = lane >> 4;
    const int K = g.K, nt = K / BK;
    unsigned voffA[2], voffB[2];
#pragma unroll
    for (int i = 0; i < 2; ++i) { int R, C; stage_rc(tid * 16 + i * 8192, R, C); const int Rb = Epi::PERM ? ((R & ~31) + perm32(R & 31)) : R;
        voffA[i] = (unsigned)(R * K + C) * 2u; voffB[i] = (unsigned)(Rb * K + C) * 2u; }
    const size_t kstep = (size_t)(BK * 2);
    const size_t hstep = (size_t)HALF * K * 2;
    const size_t tstep = 2 * hstep;
    const unsigned ldsw = (unsigned)wid * 1024u;
    const int aoff = lds_byte(wr * 64 + fr, fq * 8), boff = lds_byte(wc * 32 + fr, fq * 8);
#define PG8_SA(b, h) (((b) * 2 + (h)) * HTB)
#define PG8_SB(b, h) ((4 + (b) * 2 + (h)) * HTB)
#define PG8_STAGE(bufoff, gbase, voff) do { _Pragma("unroll") for (int _i = 0; _i < 2; ++_i) \
        __builtin_amdgcn_global_load_lds((const unsigned*)((const char*)(gbase) + (voff)[_i]), (PG8_LAS unsigned*)(lds + (bufoff) + ldsw + _i * 8192), 16, 0, 0); } while (0)
#define PG8_LDA(dst, b, h) do { _Pragma("unroll") for (int m = 0; m < 4; ++m) _Pragma("unroll") for (int k = 0; k < 2; ++k) dst[m][k] = *(const PG8_LAS bf16x8*)(lds + PG8_SA(b, h) + aoff + m * 2048 + k * 1024); } while (0)
#define PG8_LDB(dst, b, h) do { _Pragma("unroll") for (int n = 0; n < 2; ++n) _Pragma("unroll") for (int k = 0; k < 2; ++k) dst[n][k] = *(const PG8_LAS bf16x8*)(lds + PG8_SB(b, h) + boff + n * 2048 + k * 1024); } while (0)
#define PG8_MMA(ai, bj, At, Bt) do { __builtin_amdgcn_s_setprio(1); _Pragma("unroll") for (int m = 0; m < 4; ++m) _Pragma("unroll") for (int n = 0; n < 2; ++n) _Pragma("unroll") for (int k = 0; k < 2; ++k) \
        acc[ai][bj][m][n] = __builtin_amdgcn_mfma_f32_16x16x32_bf16(Bt[n][k], At[m][k], acc[ai][bj][m][n], 0, 0, 0); __builtin_amdgcn_s_setprio(0); } while (0)
#define PG8_WAIT_V(n) asm volatile("s_waitcnt vmcnt(" #n ")" ::: "memory")
#define PG8_WAIT_L(n) asm volatile("s_waitcnt lgkmcnt(" #n ")" ::: "memory")
#define PG8_BAR __builtin_amdgcn_s_barrier()
#define PG8_SCHED __builtin_amdgcn_sched_barrier(0)
    Unit cur, nxt; int ui = 0;
    if (!S.next(0, cur)) return;
    f32x4 acc[2][2][4][2];
#pragma unroll
    for (int a = 0; a < 2; ++a)
#pragma unroll
        for (int b = 0; b < 2; ++b)
#pragma unroll
            for (int m = 0; m < 4; ++m)
#pragma unroll
                for (int n = 0; n < 2; ++n) acc[a][b][m][n] = (f32x4){0.f, 0.f, 0.f, 0.f};
    bf16x8 At[4][2], B0[2][2], B1[2][2];
    const char* cA = (const char*)g.A + (size_t)cur.pm * tstep; const char* cB = (const char*)g.Bt + (size_t)cur.pn * tstep;
    S.a_ready(cur);
    if constexpr (SP2) {
        PG8_STAGE(PG8_SB(0, 0), cB, voffB); PG8_STAGE(PG8_SB(0, 1), cB + hstep, voffB); PG8_STAGE(PG8_SA(0, 0), cA, voffA); PG8_STAGE(PG8_SA(0, 1), cA + hstep, voffA);
        if (wr == 1) PG8_BAR;
        PG8_WAIT_V(2); PG8_BAR;
        PG8_STAGE(PG8_SB(1, 0), cB + kstep, voffB); PG8_STAGE(PG8_SA(1, 0), cA + kstep, voffA); PG8_STAGE(PG8_SB(1, 1), cB + hstep + kstep, voffB);
        PG8_WAIT_V(6); PG8_BAR;
    } else {
        PG8_STAGE(PG8_SB(0, 0), cB, voffB); PG8_STAGE(PG8_SA(0, 0), cA, voffA); PG8_STAGE(PG8_SB(0, 1), cB + hstep, voffB); PG8_STAGE(PG8_SA(0, 1), cA + hstep, voffA);
        if (wr == 1) PG8_BAR;
        PG8_WAIT_V(4); PG8_BAR;
        PG8_STAGE(PG8_SB(1, 0), cB + kstep, voffB); PG8_STAGE(PG8_SA(1, 0), cA + kstep, voffA); PG8_STAGE(PG8_SB(1, 1), cB + hstep + kstep, voffB);
        PG8_WAIT_V(6); PG8_BAR;
    }
    for (;;) {
        const bool has_next = S.next(ui + 1, nxt);
        const char* nA = has_next ? (const char*)g.A + (size_t)nxt.pm * tstep : cA; const char* nB = has_next ? (const char*)g.Bt + (size_t)nxt.pn * tstep : cB;
        for (int t = 0; t < nt; t += 2) {
            const bool last = (t == nt - 2);
            const char* a1 = cA + (size_t)(t + 1) * kstep;
            const char* a2 = last ? nA : cA + (size_t)(t + 2) * kstep; const char* b2 = last ? nB : cB + (size_t)(t + 2) * kstep;
            const char* a3 = a2 + kstep; const char* b3 = b2 + kstep;
            if (last && has_next) S.a_ready(nxt);
            if constexpr (SP2) {
            PG8_LDB(B0, 0, 0); PG8_LDB(B1, 0, 1); PG8_SCHED; PG8_LDA(At, 0, 0); PG8_STAGE(PG8_SA(1, 1), a1 + hstep, voffA);
            PG8_WAIT_V(8); PG8_WAIT_L(0); PG8_BAR; PG8_MMA(0, 0, At, B0); PG8_MMA(0, 1, At, B1); PG8_BAR; PG8_SCHED;
            PG8_LDA(At, 0, 1); PG8_STAGE(PG8_SB(0, 0), b2, voffB); PG8_STAGE(PG8_SB(0, 1), b2 + hstep, voffB); PG8_STAGE(PG8_SA(0, 0), a2, voffA);
            PG8_WAIT_V(8); PG8_WAIT_L(0); PG8_BAR; PG8_MMA(1, 0, At, B0); PG8_MMA(1, 1, At, B1); PG8_BAR; PG8_SCHED;
            PG8_LDB(B0, 1, 0); PG8_LDB(B1, 1, 1); PG8_SCHED; PG8_LDA(At, 1, 0); PG8_STAGE(PG8_SA(0, 1), a2 + hstep, voffA);
            PG8_WAIT_V(8); PG8_WAIT_L(0); PG8_BAR; PG8_MMA(0, 0, At, B0); PG8_MMA(0, 1, At, B1); PG8_BAR; PG8_SCHED;
            PG8_LDA(At, 1, 1); PG8_STAGE(PG8_SB(1, 0), b3, voffB); PG8_STAGE(PG8_SB(1, 1), b3 + hstep, voffB); PG8_STAGE(PG8_SA(1, 0), a3, voffA);
            PG8_WAIT_V(8); PG8_WAIT_L(0); PG8_BAR; PG8_MMA(1, 0, At, B0); PG8_MMA(1, 1, At, B1); PG8_BAR; PG8_SCHED;
            } else {
            PG8_LDB(B0, 0, 0); PG8_SCHED; PG8_LDA(At, 0, 0); PG8_STAGE(PG8_SA(1, 1), a1 + hstep, voffA);
            PG8_WAIT_L(8); PG8_BAR; PG8_WAIT_L(0); PG8_MMA(0, 0, At, B0); PG8_BAR; PG8_SCHED;
            PG8_LDB(B1, 0, 1); PG8_STAGE(PG8_SB(0, 0), b2, voffB);
            PG8_BAR; PG8_WAIT_L(0); PG8_MMA(0, 1, At, B1); PG8_BAR;
            PG8_LDA(At, 0, 1); PG8_STAGE(PG8_SA(0, 0), a2, voffA);
            PG8_BAR; PG8_WAIT_L(0); PG8_MMA(1, 0, At, B0); PG8_BAR; PG8_SCHED;
            PG8_STAGE(PG8_SB(0, 1), b2 + hstep, voffB);
            PG8_WAIT_V(6); PG8_BAR; PG8_MMA(1, 1, At, B1); PG8_BAR;
            PG8_LDB(B0, 1, 0); PG8_SCHED; PG8_LDA(At, 1, 0); PG8_STAGE(PG8_SA(0, 1), a2 + hstep, voffA);
            PG8_WAIT_L(8); PG8_BAR; PG8_WAIT_L(0); PG8_MMA(0, 0, At, B0); PG8_BAR; PG8_SCHED;
            PG8_LDB(B1, 1, 1); PG8_STAGE(PG8_SB(1, 0), b3, voffB);
            PG8_BAR; PG8_WAIT_L(0); PG8_MMA(0, 1, At, B1); PG8_BAR;
            PG8_LDA(At, 1, 1); PG8_STAGE(PG8_SA(1, 0), a3, voffA);
            PG8_BAR; PG8_WAIT_L(0); PG8_MMA(1, 0, At, B0); PG8_BAR; PG8_SCHED;
            PG8_STAGE(PG8_SB(1, 1), b3 + hstep, voffB);
            PG8_WAIT_V(6); PG8_BAR; PG8_MMA(1, 1, At, B1); PG8_BAR;
            }
        }
        if constexpr (ALIGN_EPI) { if (wr == 0) PG8_BAR; }
        if constexpr (!Epi::AFTER_DRAIN) { E(acc, cur, wr, wc, fr, fq); S.done(cur); }
        if (!has_next) break;
#pragma unroll
        for (int a = 0; a < 2; ++a)
#pragma unroll
            for (int b = 0; b < 2; ++b)
#pragma unroll
                for (int m = 0; m < 4; ++m)
#pragma unroll
                    for (int n = 0; n < 2; ++n) acc[a][b][m][n] = (f32x4){0.f, 0.f, 0.f, 0.f};
        cur = nxt; cA = nA; cB = nB; ++ui;
        if constexpr (ALIGN_EPI) { if (wr == 1) PG8_BAR; }
    }
    PG8_WAIT_V(0);
    if constexpr (!ALIGN_EPI) { if (wr == 0) PG8_BAR; }
    PG8_BAR;
    if constexpr (Epi::AFTER_DRAIN) { E.fused(acc, cur, wr, wc, fr, fq, lds, wid, lane); S.done(cur); }
#undef PG8_SA
#undef PG8_SB
#undef PG8_STAGE
#undef PG8_LDA
#undef PG8_LDB
#undef PG8_MMA
#undef PG8_WAIT_V
#undef PG8_WAIT_L
#undef PG8_BAR
#undef PG8_SCHED
}
}

#define LAS __attribute__((address_space(3)))
typedef unsigned short bf16;
typedef float f32x4 __attribute__((ext_vector_type(4)));
typedef float f32x2 __attribute__((ext_vector_type(2)));
typedef float f32x16 __attribute__((ext_vector_type(16)));
typedef short bf16x8 __attribute__((ext_vector_type(8)));
typedef unsigned u32x4 __attribute__((ext_vector_type(4)));
typedef unsigned u32x2 __attribute__((ext_vector_type(2)));
typedef __bf16 bf16x2_t __attribute__((ext_vector_type(2)));

constexpr int D = 1024, BP = 4, TP = 4096, MPR = BP * TP, BS = 8, TS = 16, MS = BS * TS, MROWS = MPR + MS, MP = 16640;
constexpr int PAST = 1024, NH = 8, HD = 128, DFF = 3072, DIN = 7168;
constexpr float EPS = 1e-6f;
constexpr int NCHUNK = TP / 64;

constexpr size_t O_YP = 0, O_YS = O_YP + (size_t)MPR * D, O_KP = O_YS + (size_t)MS * D, O_VP = O_KP + (size_t)MPR * D,
                 O_RCP = O_VP + (size_t)MPR * D, O_HP = O_RCP + (size_t)BP * 3 * D, O_FCP = O_HP + (size_t)BP * D,
                 O_KS = O_FCP + (size_t)BP * 2 * DFF, O_VS = O_KS + (size_t)MS * D, O_RCS = O_VS + (size_t)MS * D,
                 O_HS = O_RCS + (size_t)BS * 3 * D, O_FCS = O_HS + (size_t)BS * D, O_END = O_FCS + (size_t)BS * 2 * DFF;

constexpr size_t MiB = 1u << 20;
constexpr size_t SLOT = (size_t)MP * D * 2;
constexpr size_t WS_CTL = 0, CTL_BYTES = 1 * MiB;
constexpr size_t WS_WUP = 1 * MiB, WS_WDN = 13 * MiB, WS_WPR = 19 * MiB, WS_WPA = 21 * MiB, WS_WOUT = 23 * MiB, WS_WAT = 25 * MiB, WS_WXT = WS_WAT + 131072;
constexpr size_t WS_S0 = 25 * MiB + 262144;
constexpr size_t WS_S1 = WS_S0 + SLOT, WS_S2 = WS_S1 + SLOT, WS_S3 = WS_S2 + SLOT, WS_S4 = WS_S3 + SLOT, WS_S5 = WS_S4 + SLOT, WS_S6 = WS_S5 + SLOT;
constexpr size_t WS_VTS = WS_S6 + SLOT, WS_SUMP = WS_VTS + 1 * MiB, WS_SUMH = WS_SUMP + 1 * MiB, WS_END = WS_SUMH + 1 * MiB;
static_assert(WS_END <= 256 * MiB, "workspace map exceeds 256 MiB");

constexpr int WLDS = 18816;
constexpr int LDS_BYTES = 8 * WLDS;
constexpr int LDS_SCR = 131072;

__device__ __forceinline__ unsigned pk2(float lo, float hi) { f32x2 v = {lo, hi}; bf16x2_t b = __builtin_convertvector(v, bf16x2_t); return __builtin_bit_cast(unsigned, b); }
__device__ __forceinline__ float bf2f(unsigned short x) { return __uint_as_float((unsigned)x << 16); }
__device__ __forceinline__ float bflo(unsigned x) { return __uint_as_float(x << 16); }
__device__ __forceinline__ float bfhi(unsigned x) { return __uint_as_float(x & 0xffff0000u); }
__device__ __forceinline__ float sigmoid_f(float x) { return __builtin_amdgcn_rcpf(1.f + __expf(-x)); }
__device__ __forceinline__ float gelu_f(float x) { const float u = 1.5957691216057308f * (x + 0.044715f * x * x * x); return x * sigmoid_f(u); }
__device__ __forceinline__ float softplus_f(float z) { return fmaxf(z, 0.f) + __logf(1.f + __expf(-fabsf(z))); }
__device__ __forceinline__ float wave_sum(float v) {
#pragma unroll
    for (int o = 1; o < 64; o <<= 1) v += __shfl_xor(v, o);
    return v;
}
__device__ __forceinline__ void unpack8(const u32x4 w, float (&f)[8]) {
    f[0] = bflo(w.x); f[1] = bfhi(w.x); f[2] = bflo(w.y); f[3] = bfhi(w.y); f[4] = bflo(w.z); f[5] = bfhi(w.z); f[6] = bflo(w.w); f[7] = bfhi(w.w);
}

__device__ __forceinline__ u32x4 pack8(const float (&v)[8]) { u32x4 w; w.x = pk2(v[0], v[1]); w.y = pk2(v[2], v[3]); w.z = pk2(v[4], v[5]); w.w = pk2(v[6], v[7]); return w; }
__device__ __forceinline__ void st8f(float* o, const float (&v)[8]) { *(f32x4*)o = (f32x4){v[0], v[1], v[2], v[3]}; *(f32x4*)(o + 4) = (f32x4){v[4], v[5], v[6], v[7]}; }
__device__ __forceinline__ void ld8f(const float* o, float (&v)[8]) { const f32x4 a = *(const f32x4*)o, b = *(const f32x4*)(o + 4); v[0] = a.x; v[1] = a.y; v[2] = a.z; v[3] = a.w; v[4] = b.x; v[5] = b.y; v[6] = b.z; v[7] = b.w; }
__device__ __forceinline__ float sum16(float s) { s += __shfl_xor(s, 1); s += __shfl_xor(s, 2); s += __shfl_xor(s, 4); s += __shfl_xor(s, 8); return s; }
struct Params { const float* in[26]; float* out; unsigned char* ws; };
#define WSB(off) ((bf16*)(p.ws + (off)))
#define D0 ((bf16*)p.out)
#define D1 (((bf16*)p.out) + (size_t)MROWS * D)
#define WUP WSB(WS_WUP)
#define WDN WSB(WS_WDN)
#define WPR WSB(WS_WPR)
#define WPA WSB(WS_WPA)
#define WOUT WSB(WS_WOUT)
#define WAT WSB(WS_WAT)
#define WXT WSB(WS_WXT)
#define S0 WSB(WS_S0)
#define S1 WSB(WS_S1)
#define S2 WSB(WS_S2)
#define S3 WSB(WS_S3)
#define S4 WSB(WS_S4)
#define S5 WSB(WS_S5)
#define S6 WSB(WS_S6)
#define KFs WSB(WS_VTS)
#define VFs WSB(WS_VTS + 524288)
#define C8T ((float*)(p.ws + WS_CTL + 131072))
#define SUMP ((float*)(p.ws + WS_SUMP))
#define SUMH ((float*)(p.ws + WS_SUMH))
#define SS2 ((float*)(p.ws + WS_CTL))
#define U1 D0
#define XR D1
#define GG S0
#define QN S1
#define KF S2
#define VF S3
#define SG1 S4
#define SG2 S5
#define WIN S6
#define T1 S2
#define MG S6
#define U2 S0
#define GP S1
#define VAL S4
#define HLB S6
#define PCB D0

__device__ __forceinline__ void p0_transpose_item(const float* W, int K, int N, bf16* WT, LAS float* scr, int item, int lane) {
    const int nblk = N / 32, kb = item / nblk, nb = item % nblk, k0 = 64 * kb, n0 = 32 * nb;
#pragma unroll 32
    for (int i = 0; i < 32; ++i) { const int kk = 2 * i + (lane >> 5); scr[kk * 33 + (lane & 31)] = W[(size_t)(k0 + kk) * N + n0 + (lane & 31)]; }
    asm volatile("s_waitcnt lgkmcnt(0)" ::: "memory");
    const int c = lane & 7;
#pragma unroll
    for (int j = 0; j < 4; ++j) { const int n = (lane >> 3) + 8 * j; const LAS float* s = scr + (8 * c) * 33 + n;
        u32x4 o; o.x = pk2(s[0 * 33], s[1 * 33]); o.y = pk2(s[2 * 33], s[3 * 33]); o.z = pk2(s[4 * 33], s[5 * 33]); o.w = pk2(s[6 * 33], s[7 * 33]);
        *(u32x4*)(WT + (size_t)(n0 + n) * K + k0 + 8 * c) = o; }
    asm volatile("s_waitcnt lgkmcnt(0)" ::: "memory");
}
__device__ __forceinline__ void rms_row(const float* xrow, const float* g, bf16* orow, int lane) {
    const f32x4* xr = (const f32x4*)xrow + lane; const f32x4* gr = (const f32x4*)g + lane;
    f32x4 v[4]; float s = 0.f;
#pragma unroll
    for (int j = 0; j < 4; ++j) { v[j] = xr[64 * j]; s += (v[j].x * v[j].x + v[j].y * v[j].y) + (v[j].z * v[j].z + v[j].w * v[j].w); }
    const float rs = rsqrtf(wave_sum(s) * (1.f / D) + EPS);
    u32x2* o8 = (u32x2*)orow + lane;
#pragma unroll
    for (int j = 0; j < 4; ++j) { const f32x4 gv = gr[64 * j]; u32x2 o; o.x = pk2(v[j].x * rs * gv.x, v[j].y * rs * gv.y); o.y = pk2(v[j].z * rs * gv.z, v[j].w * rs * gv.w); o8[64 * j] = o; }
}

#define EPI_ARGS const f32x4 (&acc)[2][2][4][2], const pg8::Unit& u, int wr, int wc, int fr, int fq

struct EpiIn {
    static constexpr bool PERM = true, AFTER_DRAIN = false;
    bf16 *xr_, *gg_, *qn_, *kf_, *vf_, *sg1_, *sg2_; float* out; const float *qg, *kg; LAS float* scr;
    __device__ __forceinline__ void operator()(EPI_ARGS) const {
        const int seg = u.pn >> 2, cb = (u.pn & 3) * 256;
        const int rbase = u.pm * 256 + wr * 64 + fr;
        const int cl = wc * 32 + 8 * fq;
        if (seg == 2 || seg == 3) {
#pragma unroll
            for (int ai = 0; ai < 2; ++ai)
#pragma unroll
                for (int m = 0; m < 4; ++m)
#pragma unroll
                    for (int bj = 0; bj < 2; ++bj) {
                        const f32x4 a = acc[ai][bj][m][0], b = acc[ai][bj][m][1];
                        float s = (a.x * a.x + a.y * a.y) + (a.z * a.z + a.w * a.w) + (b.x * b.x + b.y * b.y) + (b.z * b.z + b.w * b.w);
                        s += __shfl_xor(s, 16); s += __shfl_xor(s, 32);
                        if (fq == 0) scr[((ai * 128 + wr * 64 + m * 16 + fr) * 2 + bj) * 4 + wc] = s;
                    }
            asm volatile("s_waitcnt lgkmcnt(0)" ::: "memory"); __builtin_amdgcn_s_barrier(); asm volatile("" ::: "memory");
            const float* gain = (seg == 2) ? qg : kg; const float osc = (seg == 2) ? 0.08838834764831845f : 1.0f;
            const f32x4 g0 = *(const f32x4*)(gain + cl), g1 = *(const f32x4*)(gain + cl + 4);

#pragma unroll
            for (int ai = 0; ai < 2; ++ai)
#pragma unroll
                for (int m = 0; m < 4; ++m) {
                    const int r = rbase + ai * 128 + m * 16;
#pragma unroll
                    for (int bj = 0; bj < 2; ++bj) {
                        const f32x4 pp = *(const LAS f32x4*)(scr + ((ai * 128 + wr * 64 + m * 16 + fr) * 2 + bj) * 4);
                        const float rs = rsqrtf(((pp.x + pp.y) + (pp.z + pp.w)) * (1.f / HD) + EPS);
                        const f32x4 a = acc[ai][bj][m][0] * rs * g0, b = acc[ai][bj][m][1] * rs * g1;
                        const int col = cb + bj * 128 + cl;
                        u32x4 w; w.x = pk2(a.x * osc, a.y * osc); w.y = pk2(a.z * osc, a.w * osc); w.z = pk2(b.x * osc, b.y * osc); w.w = pk2(b.z * osc, b.w * osc);
                        if (seg == 2) *(u32x4*)(qn_ + (size_t)r * D + col) = w;
                        else {
                            const int bb = r >> 12, t = r & (TP - 1), hh = (cb + bj * 128) >> 7;
                            *(u32x4*)(kf_ + ((((size_t)(bb * NH + hh) * (TP / 32) + (t >> 5)) * 8 + (cl >> 4)) * 512 + ((t & 31) + 32 * ((cl >> 3) & 1)) * 8)) = w;
                            float* o = out + O_KP + (size_t)r * D + col;
                            *(f32x4*)o = a; *(f32x4*)(o + 4) = b;
                        }
                    }
                }
        } else if (seg == 4) {
            LAS bf16* wscr = (LAS bf16*)scr + (wr * 4 + wc) * 512;
            const int L = fr + 16 * fq, dl = L & 31, hk = L >> 5;
#pragma unroll
            for (int ai = 0; ai < 2; ++ai)
#pragma unroll
                for (int m = 0; m < 4; ++m) {
                    const int r = rbase + ai * 128 + m * 16, bb = r >> 12, t0 = (r - fr) & (TP - 1);
#pragma unroll
                    for (int bj = 0; bj < 2; ++bj) {
                        const f32x4 a = acc[ai][bj][m][0], b = acc[ai][bj][m][1];
                        const int col = cb + bj * 128 + cl, hh = (cb + bj * 128) >> 7;
                        float* o = out + O_VP + (size_t)r * D + col;
                        *(f32x4*)o = a; *(f32x4*)(o + 4) = b;
                        u32x4 w; w.x = pk2(a.x, a.y); w.y = pk2(a.z, a.w); w.z = pk2(b.x, b.y); w.w = pk2(b.z, b.w);
                        *(LAS u32x4*)(wscr + fr * 32 + 8 * fq) = w;
                        asm volatile("s_waitcnt lgkmcnt(0)" ::: "memory");
                        unsigned short e[8];
#pragma unroll
                        for (int j = 0; j < 8; ++j) e[j] = wscr[(8 * (j >> 2) + 4 * hk + (j & 3)) * 32 + dl];
                        asm volatile("s_waitcnt lgkmcnt(0)" ::: "memory");
                        u32x4 g; g.x = (unsigned)e[0] | ((unsigned)e[1] << 16); g.y = (unsigned)e[2] | ((unsigned)e[3] << 16); g.z = (unsigned)e[4] | ((unsigned)e[5] << 16); g.w = (unsigned)e[6] | ((unsigned)e[7] << 16);
                        *(u32x4*)(vf_ + ((((size_t)(bb * NH + hh) * (TP / 32) + (t0 >> 5)) * 4 + wc) * 2 + ((t0 >> 4) & 1)) * 512 + L * 8) = g;
                    }
                }
        } else {
            bf16* dst = (seg == 0) ? xr_ : (seg == 1) ? gg_ : (seg == 5) ? sg1_ : sg2_;
            const int rlim = (seg == 0) ? MROWS : MP;
#pragma unroll
            for (int ai = 0; ai < 2; ++ai)
#pragma unroll
                for (int m = 0; m < 4; ++m) {
                    const int r = rbase + ai * 128 + m * 16;
                    if (r < rlim) {
#pragma unroll
                        for (int bj = 0; bj < 2; ++bj) {
                            f32x4 a = acc[ai][bj][m][0], b = acc[ai][bj][m][1];
                            if (seg == 1) { a.x = gelu_f(a.x); a.y = gelu_f(a.y); a.z = gelu_f(a.z); a.w = gelu_f(a.w); b.x = gelu_f(b.x); b.y = gelu_f(b.y); b.z = gelu_f(b.z); b.w = gelu_f(b.w); }
                            else if (seg >= 5) { a.x = sigmoid_f(a.x); a.y = sigmoid_f(a.y); a.z = sigmoid_f(a.z); a.w = sigmoid_f(a.w); b.x = sigmoid_f(b.x); b.y = sigmoid_f(b.y); b.z = sigmoid_f(b.z); b.w = sigmoid_f(b.w); }
                            u32x4 w; w.x = pk2(a.x, a.y); w.y = pk2(a.z, a.w); w.z = pk2(b.x, b.y); w.w = pk2(b.z, b.w);
                            *(u32x4*)(dst + (size_t)r * D + cb + bj * 128 + cl) = w;
                        }
                    }
                }
        }
    }
};

struct EpiT1 {
    static constexpr bool PERM = true, AFTER_DRAIN = false;
    const bf16* SG; bf16* t1_;
    __device__ __forceinline__ void operator()(EPI_ARGS) const {
        const int rbase = u.pm * 256 + wr * 64 + fr, c0 = u.pn * 256 + wc * 32 + 8 * fq;
        u32x4 sg[2][4][2];
#pragma unroll
        for (int ai = 0; ai < 2; ++ai)
#pragma unroll
            for (int m = 0; m < 4; ++m)
#pragma unroll
                for (int bj = 0; bj < 2; ++bj) sg[ai][m][bj] = *(const u32x4*)(SG + (size_t)(rbase + ai * 128 + m * 16) * D + c0 + bj * 128);
        __builtin_amdgcn_sched_barrier(0);
#pragma unroll
        for (int ai = 0; ai < 2; ++ai)
#pragma unroll
            for (int m = 0; m < 4; ++m)
#pragma unroll
                for (int bj = 0; bj < 2; ++bj) {
                    float g[8]; unpack8(sg[ai][m][bj], g);
                    const f32x4 a = acc[ai][bj][m][0], b = acc[ai][bj][m][1];
                    u32x4 w; w.x = pk2(a.x * g[0], a.y * g[1]); w.y = pk2(a.z * g[2], a.w * g[3]); w.z = pk2(b.x * g[4], b.y * g[5]); w.w = pk2(b.z * g[6], b.w * g[7]);
                    *(u32x4*)(t1_ + (size_t)(rbase + ai * 128 + m * 16) * D + c0 + bj * 128) = w;
                }
    }
};
struct EpiMG {
    static constexpr bool PERM = true, AFTER_DRAIN = false;
    const bf16* SG; const bf16* t1_; bf16* mg_;
    __device__ __forceinline__ void operator()(EPI_ARGS) const {
        const int rbase = u.pm * 256 + wr * 64 + fr, c0 = u.pn * 256 + wc * 32 + 8 * fq;
        u32x4 sg[4][2], tt[4][2], res[4][2];
#define MG_LOAD(AI) _Pragma("unroll") for (int m = 0; m < 4; ++m) _Pragma("unroll") for (int bj = 0; bj < 2; ++bj) { \
            const size_t off = (size_t)(rbase + (AI) * 128 + m * 16) * D + c0 + bj * 128; sg[m][bj] = *(const u32x4*)(SG + off); tt[m][bj] = *(const u32x4*)(t1_ + off); }
#define MG_CALC(AI) _Pragma("unroll") for (int m = 0; m < 4; ++m) _Pragma("unroll") for (int bj = 0; bj < 2; ++bj) { \
            float g[8], t[8]; unpack8(sg[m][bj], g); unpack8(tt[m][bj], t); const f32x4 a = acc[AI][bj][m][0], b = acc[AI][bj][m][1]; \
            u32x4 w; w.x = pk2(t[0] + a.x * g[0], t[1] + a.y * g[1]); w.y = pk2(t[2] + a.z * g[2], t[3] + a.w * g[3]); \
            w.z = pk2(t[4] + b.x * g[4], t[5] + b.y * g[5]); w.w = pk2(t[6] + b.z * g[6], t[7] + b.w * g[7]); res[m][bj] = w; }
#define MG_STORE(AI) _Pragma("unroll") for (int m = 0; m < 4; ++m) _Pragma("unroll") for (int bj = 0; bj < 2; ++bj) \
            *(u32x4*)(mg_ + (size_t)(rbase + (AI) * 128 + m * 16) * D + c0 + bj * 128) = res[m][bj];
        MG_LOAD(0)
        __builtin_amdgcn_sched_barrier(0);
        MG_CALC(0)
        MG_LOAD(1)
        __builtin_amdgcn_sched_barrier(0);
        MG_STORE(0)
        MG_CALC(1)
        MG_STORE(1)
#undef MG_LOAD
#undef MG_CALC
#undef MG_STORE
    }
};
struct EpiX1 {
    static constexpr bool PERM = true, AFTER_DRAIN = false;
    const float *xp, *xs, *ln2; float* out; bf16* u2_; float* ss2_;
    __device__ __forceinline__ void operator()(EPI_ARGS) const {
        const int rbase = u.pm * 256 + wr * 64 + fr, c0 = u.pn * 256 + wc * 32 + 8 * fq;
        f32x4 l[2][2];
#pragma unroll
        for (int bj = 0; bj < 2; ++bj) { l[bj][0] = *(const f32x4*)(ln2 + c0 + bj * 128); l[bj][1] = *(const f32x4*)(ln2 + c0 + bj * 128 + 4); }
        f32x4 xv[2][2][2], res[2][2][2];
#define X1_LOAD(Q) _Pragma("unroll") for (int mm = 0; mm < 2; ++mm) _Pragma("unroll") for (int bj = 0; bj < 2; ++bj) { \
            const float* xin = xp + (size_t)(rbase + ((Q) >> 1) * 128 + (((Q) & 1) * 2 + mm) * 16) * D + c0 + bj * 128; xv[mm][bj][0] = *(const f32x4*)xin; xv[mm][bj][1] = *(const f32x4*)(xin + 4); }
#define X1_ADD(Q) _Pragma("unroll") for (int mm = 0; mm < 2; ++mm) _Pragma("unroll") for (int bj = 0; bj < 2; ++bj) { \
            res[mm][bj][0] = acc[(Q) >> 1][bj][((Q) & 1) * 2 + mm][0] + xv[mm][bj][0]; res[mm][bj][1] = acc[(Q) >> 1][bj][((Q) & 1) * 2 + mm][1] + xv[mm][bj][1]; }
#define X1_STORE(Q) _Pragma("unroll") for (int mm = 0; mm < 2; ++mm) { const int r = rbase + ((Q) >> 1) * 128 + (((Q) & 1) * 2 + mm) * 16; float ss = 0.f; \
            _Pragma("unroll") for (int bj = 0; bj < 2; ++bj) { const f32x4 a = res[mm][bj][0], b = res[mm][bj][1]; const int col = c0 + bj * 128; \
                *(f32x4*)(out + (size_t)r * D + col) = a; *(f32x4*)(out + (size_t)r * D + col + 4) = b; \
                ss += (a.x * a.x + a.y * a.y) + (a.z * a.z + a.w * a.w) + (b.x * b.x + b.y * b.y) + (b.z * b.z + b.w * b.w); \
                u32x4 w; w.x = pk2(a.x * l[bj][0].x, a.y * l[bj][0].y); w.y = pk2(a.z * l[bj][0].z, a.w * l[bj][0].w); w.z = pk2(b.x * l[bj][1].x, b.y * l[bj][1].y); w.w = pk2(b.z * l[bj][1].z, b.w * l[bj][1].w); \
                *(u32x4*)(u2_ + (size_t)r * D + col) = w; } \
            ss += __shfl_xor(ss, 16); ss += __shfl_xor(ss, 32); if (fq == 0) atomicAdd(ss2_ + r, ss); }
        X1_LOAD(0)
        __builtin_amdgcn_sched_barrier(0);
        X1_ADD(0) X1_LOAD(1)
        __builtin_amdgcn_sched_barrier(0);
        X1_STORE(0) X1_ADD(1) X1_LOAD(2)
        __builtin_amdgcn_sched_barrier(0);
        X1_STORE(1) X1_ADD(2) X1_LOAD(3)
        __builtin_amdgcn_sched_barrier(0);
        X1_STORE(2) X1_ADD(3) X1_STORE(3)
#undef X1_LOAD
#undef X1_ADD
#undef X1_STORE
    }
};
struct PairOrder {
    pg8::StaticOrder base;
    __device__ __forceinline__ bool next(int i, pg8::Unit& u) const { pg8::Unit t; if (!base.next(i >> 1, t)) return false; u.pm = t.pm + ((i & 1) ? MP / 256 : 0); u.pn = t.pn + ((i & 1) ? 4 : 0); return true; }
    __device__ __forceinline__ void a_ready(const pg8::Unit&) const {}
    __device__ __forceinline__ void done(const pg8::Unit&) const {}
};
struct EpiP4 {
    static constexpr bool PERM = true, AFTER_DRAIN = false;
    EpiT1 e1; EpiMG e2;
    __device__ __forceinline__ void operator()(EPI_ARGS) const {
        if (u.pm >= MP / 256) { const pg8::Unit v{u.pm - MP / 256, u.pn - 4}; e2(acc, v, wr, wc, fr, fq); }
        else e1(acc, u, wr, wc, fr, fq);
    }
};
struct EpiUp {
    static constexpr bool PERM = true, AFTER_DRAIN = false;
    const float* ss2_; bf16 *gp_, *val_;
    __device__ __forceinline__ void operator()(EPI_ARGS) const {
        const int rbase = u.pm * 256 + wr * 64 + fr;
        bf16* dst = (u.pn < 12) ? gp_ : val_; const int c0 = (u.pn < 12 ? u.pn : u.pn - 12) * 256 + wc * 32 + 8 * fq;
        float ssv[2][4];
#pragma unroll
        for (int ai = 0; ai < 2; ++ai)
#pragma unroll
            for (int m = 0; m < 4; ++m) ssv[ai][m] = ss2_[rbase + ai * 128 + m * 16];
#pragma unroll
        for (int ai = 0; ai < 2; ++ai)
#pragma unroll
            for (int m = 0; m < 4; ++m) {
                const int r = rbase + ai * 128 + m * 16;
                const float rs = rsqrtf(ssv[ai][m] * (1.f / D) + EPS);
#pragma unroll
                for (int bj = 0; bj < 2; ++bj) {
                    const f32x4 a = acc[ai][bj][m][0] * rs, b = acc[ai][bj][m][1] * rs;
                    u32x4 w; w.x = pk2(a.x, a.y); w.y = pk2(a.z, a.w); w.z = pk2(b.x, b.y); w.w = pk2(b.z, b.w);
                    *(u32x4*)(dst + (size_t)r * DFF + c0 + bj * 128) = w;
                }
            }
    }
};
struct EpiDown {
    static constexpr bool PERM = true, AFTER_DRAIN = false;
    float* out;
    __device__ __forceinline__ void operator()(EPI_ARGS) const {
        const int rbase = u.pm * 256 + wr * 64 + fr, c0 = u.pn * 256 + wc * 32 + 8 * fq;
        f32x4 xv[4][2][2], res[4][2][2];
#define DN_LOAD(AI) _Pragma("unroll") for (int m = 0; m < 4; ++m) _Pragma("unroll") for (int bj = 0; bj < 2; ++bj) { \
            const float* o = out + (size_t)(rbase + (AI) * 128 + m * 16) * D + c0 + bj * 128; xv[m][bj][0] = *(const f32x4*)o; xv[m][bj][1] = *(const f32x4*)(o + 4); }
#define DN_ADD(AI) _Pragma("unroll") for (int m = 0; m < 4; ++m) _Pragma("unroll") for (int bj = 0; bj < 2; ++bj) { res[m][bj][0] = acc[AI][bj][m][0] + xv[m][bj][0]; res[m][bj][1] = acc[AI][bj][m][1] + xv[m][bj][1]; }
#define DN_STORE(AI) _Pragma("unroll") for (int m = 0; m < 4; ++m) _Pragma("unroll") for (int bj = 0; bj < 2; ++bj) { \
            float* o = out + (size_t)(rbase + (AI) * 128 + m * 16) * D + c0 + bj * 128; *(f32x4*)o = res[m][bj][0]; *(f32x4*)(o + 4) = res[m][bj][1]; }
        DN_LOAD(0)
        __builtin_amdgcn_sched_barrier(0);
        DN_ADD(0)
        DN_LOAD(1)
        __builtin_amdgcn_sched_barrier(0);
        DN_STORE(0)
        DN_ADD(1)
        DN_STORE(1)
#undef DN_LOAD
#undef DN_ADD
#undef DN_STORE
    }
};

#define MFMA32(a, b, c) __builtin_amdgcn_mfma_f32_32x32x16_bf16((a), (b), (c), 0, 0, 0)
template <bool SAMPLE>
__device__ __forceinline__ void attn_unit(const bf16* qn_, const bf16* kf_, const bf16* vf_, const bf16* kfs_, const bf16* vfs_, const float* ck, const float* cv, bf16* YA,
                                          int b, int h, int qb, LAS unsigned char* wl, LAS unsigned char* slabs, int lane) {
    const int r32 = lane & 31, hi = lane >> 5;
    int qpos0, qrow0, nq, kb;
    if (SAMPLE) { qpos0 = PAST; qrow0 = MPR + b * TS; nq = TS; kb = PAST / 32; }
    else { qpos0 = qb * 32; qrow0 = b * TP + qpos0; nq = 32; kb = (qpos0 + 30) >> 5; }
    const int qr = r32 < nq ? r32 : nq - 1;
    LAS bf16x8* qst = (LAS bf16x8*)wl + lane;
    { const bf16* qp = qn_ + (size_t)(qrow0 + qr) * D + h * HD + 8 * hi;
      bf16x8 qf[8];
#pragma unroll
      for (int ks = 0; ks < 8; ++ks) qf[ks] = *(const bf16x8*)(qp + 16 * ks);
      __builtin_amdgcn_sched_barrier(0);
#pragma unroll
      for (int ks = 0; ks < 8; ++ks) qst[ks * 64] = qf[ks]; }
    f32x16 o[4];
#pragma unroll
    for (int d = 0; d < 4; ++d)
#pragma unroll
        for (int i = 0; i < 16; ++i) o[d][i] = 0.f;
    float carry = 0.f;
    const int qpos = qpos0 + qr;
    for (; kb >= 0; --kb) {
        const bool cache = SAMPLE && (kb < PAST / 32 - 8);
        const bool inlds = SAMPLE && !cache && (kb < PAST / 32);
        f32x16 s;
        bf16x8 kf[8], vf[8];
        if (inlds) {
            const LAS bf16x8* sl = (const LAS bf16x8*)(slabs + (PAST / 32 - 1 - kb) * 16384) + lane;
#pragma unroll
            for (int ks = 0; ks < 8; ++ks) kf[ks] = sl[ks * 64];
#pragma unroll
            for (int f = 0; f < 8; ++f) vf[f] = sl[512 + f * 64];
        } else if (cache) {
            const int kk = 32 * kb + r32;
            const float* kp = ck + (((size_t)b * PAST + kk) * NH + h) * HD + 8 * hi;
#pragma unroll
            for (int ks = 0; ks < 8; ++ks) { const f32x4 a = *(const f32x4*)(kp + 16 * ks), c = *(const f32x4*)(kp + 16 * ks + 4);
                u32x4 w; w.x = pk2(a.x, a.y); w.y = pk2(a.z, a.w); w.z = pk2(c.x, c.y); w.w = pk2(c.z, c.w); kf[ks] = __builtin_bit_cast(bf16x8, w); }
#pragma unroll
            for (int f = 0; f < 8; ++f) {
                const int k0 = 32 * kb + 16 * (f & 1) + 4 * hi;
                const float* vp = cv + (((size_t)b * PAST + k0) * NH + h) * HD + (f >> 1) * 32 + r32;
                float e[8];
#pragma unroll
                for (int j = 0; j < 8; ++j) e[j] = vp[(size_t)(8 * (j >> 2) + (j & 3)) * (NH * HD)];
                u32x4 w; w.x = pk2(e[0], e[1]); w.y = pk2(e[2], e[3]); w.z = pk2(e[4], e[5]); w.w = pk2(e[6], e[7]); vf[f] = __builtin_bit_cast(bf16x8, w);
            }
        } else {
            const size_t fo = (SAMPLE ? (size_t)(b * NH + h) : ((size_t)(b * NH + h) * (TP / 32) + kb)) * 8 * 512 + lane * 8;
            const bf16* kp = (SAMPLE ? kfs_ : kf_) + fo; const bf16* vp = (SAMPLE ? vfs_ : vf_) + fo;
#pragma unroll
            for (int ks = 0; ks < 8; ++ks) kf[ks] = *(const bf16x8*)(kp + ks * 512);
#pragma unroll
            for (int f = 0; f < 8; ++f) vf[f] = *(const bf16x8*)(vp + f * 512);
        }
        bf16x8 qf[8];
#pragma unroll
        for (int ks = 0; ks < 8; ++ks) qf[ks] = qst[ks * 64];
        __builtin_amdgcn_sched_barrier(0);
#pragma unroll
        for (int i = 0; i < 16; ++i) s[i] = 0.f;
#pragma unroll
        for (int ks = 0; ks < 8; ++ks) s = MFMA32(kf[ks], qf[ks], s);
        f32x16 Lv; float own[4], oth[4];
#pragma unroll
        for (int i = 0; i < 16; ++i) {
            const float z = s[i];
            const int kpos = 32 * kb + (i & 3) + 8 * (i >> 2) + 4 * hi;
            const float sp = softplus_f(z);
            Lv[i] = (kpos < qpos) ? -sp : 0.f;
            s[i] = z - sp;
        }
#pragma unroll
        for (int g = 0; g < 4; ++g) { own[g] = (Lv[4 * g] + Lv[4 * g + 1]) + (Lv[4 * g + 2] + Lv[4 * g + 3]); oth[g] = __shfl_xor(own[g], 32); }
        float run = 0.f, after[4];
#pragma unroll
        for (int g = 3; g >= 0; --g) { after[g] = run + (hi == 0 ? oth[g] : 0.f); run += own[g] + oth[g]; }
        bf16x8 pa[2];
        {
            float w[16];
#pragma unroll
            for (int g = 0; g < 4; ++g) {
                float sfx = carry + after[g];
#pragma unroll
                for (int e = 3; e >= 0; --e) {
                    const int i = 4 * g + e;
                    const int kpos = 32 * kb + (i & 3) + 8 * (i >> 2) + 4 * hi;
                    w[i] = (kpos < qpos) ? __expf(s[i] + sfx) : 0.f;
                    sfx += Lv[i];
                }
            }
#pragma unroll
            for (int st = 0; st < 2; ++st) { u32x4 pw; pw.x = pk2(w[8 * st], w[8 * st + 1]); pw.y = pk2(w[8 * st + 2], w[8 * st + 3]); pw.z = pk2(w[8 * st + 4], w[8 * st + 5]); pw.w = pk2(w[8 * st + 6], w[8 * st + 7]);
                pa[st] = __builtin_bit_cast(bf16x8, pw); }
        }
        carry += run;
#pragma unroll
        for (int db = 0; db < 4; ++db)
#pragma unroll
            for (int st = 0; st < 2; ++st) o[db] = MFMA32(vf[db * 2 + st], pa[st], o[db]);
        if (__all(carry < -104.0f)) break;
    }
    if (r32 < nq) {
        bf16* op = YA + (size_t)(qrow0 + r32) * D + h * HD + 4 * hi;
#pragma unroll
        for (int db = 0; db < 4; ++db)
#pragma unroll
            for (int g = 0; g < 4; ++g) { u32x2 w; w.x = pk2(o[db][4 * g], o[db][4 * g + 1]); w.y = pk2(o[db][4 * g + 2], o[db][4 * g + 3]); *(u32x2*)(op + db * 32 + 8 * g) = w; }
    }
}

#define MFMA16(a, b, c) __builtin_amdgcn_mfma_f32_16x16x32_bf16((a), (b), (c), 0, 0, 0)
constexpr int XCS = 72;
template <int NB>
__device__ __forceinline__ void scan16(f32x4 (&A)[NB], f32x4 (&B)[NB], int fr) {
#pragma unroll
    for (int sft = 1; sft < 16; sft <<= 1) {
#pragma unroll
        for (int nb = 0; nb < NB; ++nb)
#pragma unroll
            for (int i = 0; i < 4; ++i) {
                const float ap = __shfl_up(A[nb][i], sft, 16), bp = __shfl_up(B[nb][i], sft, 16);
                if (fr >= sft) { B[nb][i] = A[nb][i] * bp + B[nb][i]; A[nb][i] = A[nb][i] * ap; }
            }
    }
}
template <bool FINAL, bool sample>
__device__ __forceinline__ void lru_unit(const Params& p, int b, int j0, int n, LAS unsigned char* wl, int lane) {
    constexpr int NCH = sample ? 1 : 2;
    const int fr = lane & 15, fq = lane >> 4;
    const int ntok = sample ? TS : 64, nmb = sample ? 1 : 4;
    LAS bf16* xcs = (LAS bf16*)wl;
    const int c = n * 64 + lane;
    f32x4 Hc[4], Pc[4];
    LAS float* cst = (LAS float*)(wl + 9648); LAS u32x2* gst = (LAS u32x2*)(wl + 10416) + lane; (void)gst;
    cst[lane] = C8T[c]; cst[64 + lane] = p.in[12][c]; cst[128 + lane] = p.in[14][c];
#pragma unroll
    for (int nb = 0; nb < 4; ++nb) {
        const int d0 = n * 64 + 16 * nb + 4 * fq;
        Hc[nb] = (f32x4){0.f, 0.f, 0.f, 0.f}; Pc[nb] = (f32x4){1.f, 1.f, 1.f, 1.f};
        if (FINAL && sample) Hc[nb] = *(const f32x4*)(p.in[5] + (size_t)b * D + d0);
    }
    const float* cw = p.in[9]; const float w0 = cw[c], w1 = cw[D + c], w2 = cw[2 * D + c], w3 = cw[3 * D + c], cbias = p.in[10][c];
    if (FINAL && !sample) {
        const float* sp = SUMP + (size_t)b * NCHUNK * D + n * 64 + 4 * fq; const float* sh = SUMH + (size_t)b * NCHUNK * D + n * 64 + 4 * fq;
#pragma unroll 1
        for (int g = 0; g < j0; g += 16) {
            const int jj = g + fr; f32x4 A[4], B[4];
#pragma unroll
            for (int nb = 0; nb < 4; ++nb) { A[nb] = (f32x4){1.f, 1.f, 1.f, 1.f}; B[nb] = (f32x4){0.f, 0.f, 0.f, 0.f};
                if (jj < j0) { A[nb] = *(const f32x4*)(sp + (size_t)jj * D + 16 * nb); B[nb] = *(const f32x4*)(sh + (size_t)jj * D + 16 * nb); } }
            scan16<4>(A, B, fr);
#pragma unroll
            for (int nb = 0; nb < 4; ++nb)
#pragma unroll
                for (int i = 0; i < 4; ++i) { const float pt = __shfl(A[nb][i], 15, 16), ht = __shfl(B[nb][i], 15, 16); Hc[nb][i] = pt * Hc[nb][i] + ht; }
        }
    }
    bf16x8 wa[4][2], wx[4][2];
#pragma unroll
    for (int nb = 0; nb < 4; ++nb)
#pragma unroll
        for (int k = 0; k < 2; ++k) { const size_t off = (size_t)(n * 64 + 16 * nb + fr) * 64 + 8 * fq + 32 * k; wa[nb][k] = *(const bf16x8*)(WAT + off); wx[nb][k] = *(const bf16x8*)(WXT + off); }
#pragma unroll 1
    for (int jc = 0; jc < NCH; ++jc) {
        const int j = j0 + jc;
        const int row0 = sample ? MPR + b * TS : b * TP + j * 64;
        if (FINAL) {
            u32x2 gtmp[16];
#pragma unroll
            for (int q = 0; q < 16; ++q) gtmp[q] = ((q >> 2) < nmb) ? *(const u32x2*)(GG + (size_t)(row0 + 16 * (q >> 2) + fr) * D + n * 64 + 16 * (q & 3) + 4 * fq) : (u32x2){0u, 0u};
#pragma unroll
            for (int q = 0; q < 16; ++q) gst[q * 64] = gtmp[q];
        }
        {
            const int rr = lane >> 3, cc = (lane & 7) * 8;
            u32x4 stg[9];
#pragma unroll
            for (int i = 0; i < 9; ++i) {
                const int tr = 8 * i + rr - 3;
                stg[i] = (u32x4){0u, 0u, 0u, 0u};
                if (tr < ntok) {
                    if (tr >= 0 || (!sample && j > 0)) stg[i] = *(const u32x4*)(XR + (size_t)(row0 + tr) * D + n * 64 + cc);
                    else if (sample) { float hv[8]; ld8f(p.in[4] + ((size_t)b * 3 + (tr + 3)) * D + n * 64 + cc, hv); stg[i] = pack8(hv); }
                }
            }
#pragma unroll
            for (int i = 0; i < 9; ++i) { const int tr = 8 * i + rr - 3; if (tr < ntok) *(LAS u32x4*)(xcs + (tr + 3) * XCS + cc) = stg[i]; }
            asm volatile("s_waitcnt lgkmcnt(0)" ::: "memory");
            float x3 = bf2f(xcs[0 * XCS + lane]), x2 = bf2f(xcs[1 * XCS + lane]), x1 = bf2f(xcs[2 * XCS + lane]);
#pragma unroll 8
            for (int t = 0; t < ntok; ++t) {
                const float x0 = bf2f(xcs[(t + 3) * XCS + lane]);
                const float y = w0 * x3 + w1 * x2 + w2 * x1 + w3 * x0 + cbias;
                xcs[t * XCS + lane] = (bf16)(pk2(y, 0.f) & 0xffffu);
                x3 = x2; x2 = x1; x1 = x0;
            }
            if (FINAL && (sample || j == NCHUNK - 1)) {
                float* o = p.out + (sample ? O_RCS + (size_t)b * 3 * D : O_RCP + (size_t)b * 3 * D) + c;
                o[0] = x3; o[D] = x2; o[2 * D] = x1;
            }
        }
        asm volatile("s_waitcnt lgkmcnt(0)" ::: "memory");
        if (!FINAL) {
#pragma unroll
            for (int nb = 0; nb < 4; ++nb) { Hc[nb] = (f32x4){0.f, 0.f, 0.f, 0.f}; Pc[nb] = (f32x4){1.f, 1.f, 1.f, 1.f}; }
        }
#pragma unroll 1
        for (int mb = 0; mb < 4; ++mb) {
            if (mb < nmb) {
                const LAS bf16* xrow = xcs + (16 * mb + fr) * XCS;
                const bf16x8 xf0 = *(const LAS bf16x8*)(xrow + 8 * fq), xf1 = *(const LAS bf16x8*)(xrow + 8 * fq + 32);
#pragma unroll
                for (int hf = 0; hf < 2; ++hf) {
                    f32x4 A[2], B[2];
#pragma unroll
                    for (int q = 0; q < 2; ++q) {
                        const int nb = 2 * hf + q;
                        f32x4 aa = (f32x4){0.f, 0.f, 0.f, 0.f}, ax = aa;
                        aa = MFMA16(wa[nb][0], xf0, aa); aa = MFMA16(wa[nb][1], xf1, aa);
                        ax = MFMA16(wx[nb][0], xf0, ax); ax = MFMA16(wx[nb][1], xf1, ax);
                        const u32x2 xw = *(const LAS u32x2*)(xrow + 16 * nb + 4 * fq);
                        const f32x4 c8v = *(const LAS f32x4*)(cst + 16 * nb + 4 * fq), bav = *(const LAS f32x4*)(cst + 64 + 16 * nb + 4 * fq), bxv = *(const LAS f32x4*)(cst + 128 + 16 * nb + 4 * fq);
                        const float xc[4] = {bflo(xw.x), bfhi(xw.x), bflo(xw.y), bfhi(xw.y)};
#pragma unroll
                        for (int i = 0; i < 4; ++i) {
                            const float ra = sigmoid_f(aa[i] + bav[i]), ri = sigmoid_f(ax[i] + bxv[i]);
                            const float a = __expf(c8v[i] * ra);
                            A[q][i] = a; B[q][i] = __builtin_amdgcn_sqrtf(fmaxf(1.f - a * a, 0.f)) * (ri * xc[i]);
                        }
                    }
                    scan16<2>(A, B, fr);
#pragma unroll
                    for (int q = 0; q < 2; ++q) {
                        const int nb = 2 * hf + q;
                        f32x4 hv = B[q] + A[q] * Hc[nb], pv = A[q] * Pc[nb];
                        if (!FINAL) {
                            const size_t off = (size_t)(row0 + 16 * mb + fr) * D + n * 64 + 16 * nb + 4 * fq;
                            u32x2 hw; hw.x = pk2(hv.x, hv.y); hw.y = pk2(hv.z, hv.w); *(u32x2*)(HLB + off) = hw;
                            u32x2 pw; pw.x = pk2(pv.x, pv.y); pw.y = pk2(pv.z, pv.w); *(u32x2*)(PCB + off) = pw;
                        }
                        if (FINAL) {
                            const u32x2 gw = gst[(mb * 4 + nb) * 64];
                            u32x2 yw; yw.x = pk2(hv.x * bflo(gw.x), hv.y * bfhi(gw.x)); yw.y = pk2(hv.z * bflo(gw.y), hv.w * bfhi(gw.y));
                            *(u32x2*)(GG + (size_t)(row0 + 16 * mb + fr) * D + n * 64 + 16 * nb + 4 * fq) = yw;
                        }
#pragma unroll
                        for (int i = 0; i < 4; ++i) { Hc[nb][i] = __shfl(hv[i], 15, 16); Pc[nb][i] = __shfl(pv[i], 15, 16); }
                    }
                }
            }
        }
        if (fr == 0) {
#pragma unroll
            for (int nb = 0; nb < 4; ++nb) {
                const int d0 = n * 64 + 16 * nb + 4 * fq;
                if (!FINAL) { const size_t so = ((size_t)b * NCHUNK + j) * D + d0; *(f32x4*)(SUMP + so) = Pc[nb]; *(f32x4*)(SUMH + so) = Hc[nb]; }
                else if (sample || j == NCHUNK - 1) *(f32x4*)(p.out + (sample ? O_HS + (size_t)b * D : O_HP + (size_t)b * D) + d0) = Hc[nb];
            }
        }
        asm volatile("s_waitcnt lgkmcnt(0)" ::: "memory");
    }
}


__device__ __forceinline__ void lru_final_light(const Params& p, int b, int j0, int n, int lane) {
    const int fr = lane & 15, fq = lane >> 4;
    f32x4 Hc[4];
#pragma unroll
    for (int nb = 0; nb < 4; ++nb) Hc[nb] = (f32x4){0.f, 0.f, 0.f, 0.f};
    const float* sp = SUMP + (size_t)b * NCHUNK * D + n * 64 + 4 * fq; const float* sh = SUMH + (size_t)b * NCHUNK * D + n * 64 + 4 * fq;
#pragma unroll 1
    for (int g = 0; g < j0; g += 16) {
        const int jj = g + fr; f32x4 A[4], B[4];
#pragma unroll
        for (int nb = 0; nb < 4; ++nb) { A[nb] = (f32x4){1.f, 1.f, 1.f, 1.f}; B[nb] = (f32x4){0.f, 0.f, 0.f, 0.f};
            if (jj < j0) { A[nb] = *(const f32x4*)(sp + (size_t)jj * D + 16 * nb); B[nb] = *(const f32x4*)(sh + (size_t)jj * D + 16 * nb); } }
        scan16<4>(A, B, fr);
#pragma unroll
        for (int nb = 0; nb < 4; ++nb)
#pragma unroll
            for (int i = 0; i < 4; ++i) { const float pt = __shfl(A[nb][i], 15, 16), ht = __shfl(B[nb][i], 15, 16); Hc[nb][i] = pt * Hc[nb][i] + ht; }
    }
#pragma unroll 1
    for (int jc = 0; jc < 2; ++jc) {
        const int j = j0 + jc, row0 = b * TP + j * 64;
        u32x2 hl[4][4], pc[4][4], gg[4][4];
#pragma unroll
        for (int mb = 0; mb < 4; ++mb)
#pragma unroll
            for (int nb = 0; nb < 4; ++nb) { const size_t off = (size_t)(row0 + 16 * mb + fr) * D + n * 64 + 16 * nb + 4 * fq; hl[mb][nb] = *(const u32x2*)(HLB + off); pc[mb][nb] = *(const u32x2*)(PCB + off); gg[mb][nb] = *(const u32x2*)(GG + off); }
        f32x4 pe[4], he[4];
#pragma unroll
        for (int nb = 0; nb < 4; ++nb) { const size_t so = ((size_t)b * NCHUNK + j) * D + n * 64 + 16 * nb + 4 * fq; pe[nb] = *(const f32x4*)(SUMP + so); he[nb] = *(const f32x4*)(SUMH + so); }
#pragma unroll
        for (int mb = 0; mb < 4; ++mb)
#pragma unroll
            for (int nb = 0; nb < 4; ++nb) {
                const u32x2 a = hl[mb][nb], c = pc[mb][nb], g = gg[mb][nb];
                const float h0 = bflo(a.x) + bflo(c.x) * Hc[nb].x, h1 = bfhi(a.x) + bfhi(c.x) * Hc[nb].y, h2 = bflo(a.y) + bflo(c.y) * Hc[nb].z, h3 = bfhi(a.y) + bfhi(c.y) * Hc[nb].w;
                u32x2 yw; yw.x = pk2(h0 * bflo(g.x), h1 * bfhi(g.x)); yw.y = pk2(h2 * bflo(g.y), h3 * bfhi(g.y));
                *(u32x2*)(GG + (size_t)(row0 + 16 * mb + fr) * D + n * 64 + 16 * nb + 4 * fq) = yw;
            }
#pragma unroll
        for (int nb = 0; nb < 4; ++nb) Hc[nb] = pe[nb] * Hc[nb] + he[nb];
        if (j == NCHUNK - 1) {
            if (fr == 0) {
#pragma unroll
                for (int nb = 0; nb < 4; ++nb) *(f32x4*)(p.out + O_HP + (size_t)b * D + n * 64 + 16 * nb + 4 * fq) = Hc[nb];
            }
            const int c = n * 64 + lane;
#pragma unroll
            for (int i = 0; i < 3; ++i) p.out[O_RCP + ((size_t)b * 3 + i) * D + c] = bf2f(XR[(size_t)(b * TP + TP - 3 + i) * D + c]);
        }
    }
}

constexpr int RSTR = 132;
template <int K>
__device__ __forceinline__ void sgemm_tile(const bf16* A, const bf16* Bt, LAS float* red, int tid, float (&v)[8]) {
    const int lane = tid & 63, w = __builtin_amdgcn_readfirstlane(tid >> 6), fr = lane & 15, fq = lane >> 4;
    constexpr int KW = K / 8, NKS = KW / 32;
    f32x4 acc[2][8];
#pragma unroll
    for (int mb = 0; mb < 2; ++mb)
#pragma unroll
        for (int nb = 0; nb < 8; ++nb) acc[mb][nb] = (f32x4){0.f, 0.f, 0.f, 0.f};
    const bf16* ap = A + (size_t)fr * K + w * KW + 8 * fq;
    const bf16* bp = Bt + (size_t)fr * K + w * KW + 8 * fq;
#pragma unroll (NKS == 4 ? 4 : 3)
    for (int ks = 0; ks < NKS; ++ks) {
        bf16x8 af[2], bb[8];
#pragma unroll
        for (int mb = 0; mb < 2; ++mb) af[mb] = *(const bf16x8*)(ap + (size_t)mb * 16 * K + ks * 32);
#pragma unroll
        for (int nb = 0; nb < 8; ++nb) bb[nb] = *(const bf16x8*)(bp + (size_t)nb * 16 * K + ks * 32);
#pragma unroll
        for (int mb = 0; mb < 2; ++mb)
#pragma unroll
            for (int nb = 0; nb < 8; ++nb) acc[mb][nb] = MFMA16(bb[nb], af[mb], acc[mb][nb]);
    }
    LAS float* slab = red + w * (32 * RSTR);
#pragma unroll
    for (int mb = 0; mb < 2; ++mb)
#pragma unroll
        for (int nb = 0; nb < 8; ++nb) *(LAS f32x4*)(slab + (16 * mb + fr) * RSTR + 16 * nb + 4 * fq) = acc[mb][nb];
    __syncthreads();
    const int row = tid >> 4, c8 = (tid & 15) * 8;
    f32x4 s0 = (f32x4){0.f, 0.f, 0.f, 0.f}, s1 = s0;
#pragma unroll
    for (int sl = 0; sl < 8; ++sl) { const LAS float* q = red + sl * (32 * RSTR) + row * RSTR + c8; s0 += *(const LAS f32x4*)q; s1 += *(const LAS f32x4*)(q + 4); }
    v[0] = s0.x; v[1] = s0.y; v[2] = s0.z; v[3] = s0.w; v[4] = s1.x; v[5] = s1.y; v[6] = s1.z; v[7] = s1.w;
    __syncthreads();
}

#define XB_TMO      128
#define XB_XCNT(j)  (256  + 64 * (j))
#define XB_XSUB(j)  (1280 + 64 * (j))
#define XB_XGEN(j)  (2304 + 64 * (j))
#define XB_TOP      3328
#define XB_TOPGEN   3392
#define XCD_BAR_WORDS 3456
#define XB_SPIN_CAP (1u << 18)

__device__ __forceinline__ unsigned xb_ld(unsigned* p)              { return __hip_atomic_load(p, __ATOMIC_RELAXED, __HIP_MEMORY_SCOPE_AGENT); }
__device__ __forceinline__ unsigned xb_add(unsigned* p, unsigned v) { return __hip_atomic_fetch_add(p, v, __ATOMIC_RELAXED, __HIP_MEMORY_SCOPE_AGENT); }
__device__ __forceinline__ unsigned xb_xcc_id() { return (unsigned)__builtin_amdgcn_s_getreg((3 << 11) | 20) & 0xFu; }
#define XB_SPIN(cond, bar) do { unsigned _sp = 0; while (cond) { __builtin_amdgcn_s_sleep(1); \
    if ((++_sp & 255u) == 0u) { if (xb_ld(&(bar)[XB_TMO])) break; if (_sp > XB_SPIN_CAP) { atomicAdd(&(bar)[XB_TMO], 1u); break; } } } } while (0)

struct XcdBarrier {
    unsigned* bar; unsigned x;
    volatile LAS unsigned* st;
};

__device__ __forceinline__ XcdBarrier xcd_barrier_post(unsigned* bar, volatile LAS unsigned* st) {
    XcdBarrier b; b.bar = bar; b.x = xb_xcc_id(); b.st = st;
    if (threadIdx.x == 0) (void)xb_add(&bar[XB_XCNT(b.x)], 1u);
    return b;
}
__device__ __forceinline__ void xcd_barrier_complete(unsigned* bar, unsigned x, unsigned& nloc, unsigned& nx) {
    const unsigned G = gridDim.x * gridDim.y * gridDim.z;
    unsigned sum, cnt, mine, sp = 0u;
    for (;;) {
        sum = 0u; cnt = 0u; mine = 0u;
#pragma unroll
        for (unsigned j = 0; j < 16; ++j) { const unsigned c = xb_ld(&bar[XB_XCNT(j)]); sum += c; cnt += (c > 0u) ? 1u : 0u; mine = (j == x) ? c : mine; }
        if (sum == G) break;
        __builtin_amdgcn_s_sleep(1);
        if ((++sp & 255u) == 0u) { if (xb_ld(&bar[XB_TMO])) break; if (sp > XB_SPIN_CAP) { atomicAdd(&bar[XB_TMO], 1u); break; } }
    }
    nloc = mine > 0u ? mine : 1u; nx = cnt > 0u ? cnt : 1u;
}

__device__ __forceinline__ void xcd_barrier(const XcdBarrier& b) {
    asm volatile("s_waitcnt vmcnt(0)" ::: "memory");
    __syncthreads();
    if (threadIdx.x == 0) {
        unsigned* bar = b.bar;
        __builtin_amdgcn_s_waitcnt(0);
        unsigned nloc = b.st[0], nx = b.st[1];
        if (nloc == 0u) { xcd_barrier_complete(bar, b.x, nloc, nx); b.st[0] = nloc; b.st[1] = nx; }
        const unsigned old = xb_add(&bar[XB_XSUB(b.x)], 1u);
        const unsigned gen = old / nloc;
        if (old + 1u == (gen + 1u) * nloc) {
            __builtin_amdgcn_fence(__ATOMIC_RELEASE, "agent");
            asm volatile("s_waitcnt vmcnt(0)" ::: "memory");
            const unsigned og = xb_add(&bar[XB_TOP], 1u);
            const unsigned tg = og / nx;
            if (og + 1u == (tg + 1u) * nx) xb_add(&bar[XB_TOPGEN], 1u);
            else XB_SPIN(xb_ld(&bar[XB_TOPGEN]) == tg, bar);
            __builtin_amdgcn_fence(__ATOMIC_ACQUIRE, "agent");
            xb_add(&bar[XB_XGEN(b.x)], 1u);
            asm volatile("s_waitcnt vmcnt(0)" ::: "memory");
        } else {
            XB_SPIN(xb_ld(&bar[XB_XGEN(b.x)]) == gen, bar);
            __builtin_amdgcn_fence(__ATOMIC_ACQUIRE, "agent");
            asm volatile("s_waitcnt vmcnt(0)" ::: "memory");
        }
    }
    __syncthreads();
}

__global__ void __launch_bounds__(512, 2) hawk_fwd(Params p) {
    extern __shared__ __attribute__((aligned(16))) unsigned char lds_raw[];
    cg::grid_group grid = cg::this_grid();
    LAS unsigned char* lds = (LAS unsigned char*)lds_raw;
    const int G = gridDim.x, NGW = G * 8;
    { volatile LAS unsigned* xb_st0 = (volatile LAS unsigned*)(lds + (LDS_BYTES - 16)); if (threadIdx.x < 4) xb_st0[threadIdx.x] = 0u; }
    __syncthreads();
    volatile LAS unsigned* xb_st = (volatile LAS unsigned*)(lds + (LDS_BYTES - 16));
    (void)xcd_barrier_post((unsigned*)(p.ws + WS_CTL + 69632), xb_st);
    if (p.ws == nullptr) grid.sync();
#define XBAR() do { XcdBarrier xb_; xb_.bar = (unsigned*)(p.ws + WS_CTL + 69632); xb_.x = xb_xcc_id(); xb_.st = (volatile LAS unsigned*)(lds + (LDS_BYTES - 16)); xcd_barrier(xb_); } while (0)
    unsigned long long pr_acc = 0, pr_t = 0; (void)pr_acc; (void)pr_t;
#define PR_BEGIN(k) do { if constexpr ((PROBE_MASK >> (k)) & 1) pr_t = __builtin_amdgcn_s_memrealtime(); } while (0)
#define PR_END(k) do { if constexpr ((PROBE_MASK >> (k)) & 1) pr_acc += __builtin_amdgcn_s_memrealtime() - pr_t; } while (0)
#define PHASE_IDS int tid = threadIdx.x; asm volatile("" : "+v"(tid)); const int lane = tid & 63, wave = __builtin_amdgcn_readfirstlane(tid >> 6), gw = blockIdx.x * 8 + wave; (void)lane; (void)gw;

    PR_BEGIN(0);
    if constexpr ((PH_MASK >> 0) & 1) {
        PHASE_IDS
        LAS float* scr = (LAS float*)(lds + wave * 16384);
        constexpr int I_IN = (D / 64) * (DIN / 32), I_LB = 2;
        constexpr int NITEMS = I_IN + 32 * I_LB;
        for (int it = gw; it < NITEMS; it += NGW) {
            int r = it;
            if (r < I_IN) { p0_transpose_item(p.in[8], D, DIN, WIN, scr, r, lane); continue; } r -= I_IN;
            { const int which = r / (16 * I_LB), rr = r % (16 * I_LB), blk = rr / I_LB, item = rr % I_LB;
              p0_transpose_item((which ? p.in[13] : p.in[11]) + (size_t)blk * 4096, 64, 64, (which ? WXT : WAT) + (size_t)blk * 4096, scr, item, lane); }
        }
        if (blockIdx.x == 0) for (int d = tid; d < D; d += 512) C8T[d] = -8.f * log1pf(expf(-p.in[15][d]));
        for (int m = gw; m < MROWS; m += NGW)
            rms_row(m < MPR ? p.in[0] + (size_t)m * D : p.in[1] + (size_t)(m - MPR) * D, p.in[7], U1 + (size_t)m * D, lane);
    }
    XBAR();
    PR_END(0);

    PR_BEGIN(1);
    if constexpr ((PH_MASK >> 1) & 1) {
        {
            int tid = threadIdx.x; asm volatile("" : "+v"(tid));
            for (int un = blockIdx.x; un < 4 * (DIN / 128); un += G) {
                const int ru = un & 3, n0 = (un >> 2) * 128; float v[8];
                sgemm_tile<D>(U1 + (size_t)(MPR + 32 * ru) * D, WIN + (size_t)n0 * D, (LAS float*)lds, tid, v);
                const int r = MPR + 32 * ru + (tid >> 4), seg = n0 >> 10, cin = (tid & 15) * 8, c = (n0 & 1023) + cin;
                if (seg == 2 || seg == 3) {
                    float ss = 0.f;
#pragma unroll
                    for (int e = 0; e < 8; ++e) ss += v[e] * v[e];
                    const float rs = rsqrtf(sum16(ss) * (1.f / HD) + EPS);
                    float gn[8]; ld8f((seg == 2 ? p.in[16] : p.in[17]) + cin, gn);
#pragma unroll
                    for (int e = 0; e < 8; ++e) v[e] = v[e] * rs * gn[e];
                    if (seg == 3) { st8f(p.out + O_KS + (size_t)(r - MPR) * D + c, v); const int sb = (r - MPR) >> 4, t = (r - MPR) & 15, hh = (n0 & 1023) >> 7;
                        *(u32x4*)(KFs + (((size_t)(sb * NH + hh) * 8 + (cin >> 4)) * 512 + (t + 32 * ((cin >> 3) & 1)) * 8)) = pack8(v); }
                    else {
#pragma unroll
                        for (int e = 0; e < 8; ++e) v[e] *= 0.08838834764831845f;
                        *(u32x4*)(QN + (size_t)r * D + c) = pack8(v); }
                } else if (seg == 4) {
                    st8f(p.out + O_VS + (size_t)(r - MPR) * D + c, v);
                    const int sb = (r - MPR) >> 4, t = (r - MPR) & 15, hh = (n0 & 1023) >> 7;
                    bf16* vt = VFs + (((size_t)(sb * NH + hh) * 4 + (cin >> 5)) * 2 + 0) * 512 + ((cin & 31) + 32 * ((t >> 2) & 1)) * 8 + 4 * (t >> 3) + (t & 3); const u32x4 w = pack8(v);
                    vt[0] = (bf16)w.x; vt[8] = (bf16)(w.x >> 16); vt[16] = (bf16)w.y; vt[24] = (bf16)(w.y >> 16); vt[32] = (bf16)w.z; vt[40] = (bf16)(w.z >> 16); vt[48] = (bf16)w.w; vt[56] = (bf16)(w.w >> 16);
                } else {
                    if (seg == 1) {
#pragma unroll
                        for (int e = 0; e < 8; ++e) v[e] = gelu_f(v[e]);
                    } else if (seg >= 5) {
#pragma unroll
                        for (int e = 0; e < 8; ++e) v[e] = sigmoid_f(v[e]);
                    }
                    bf16* dst = (seg == 0) ? XR : (seg == 1) ? GG : (seg == 5) ? SG1 : SG2;
                    *(u32x4*)(dst + (size_t)r * D + c) = pack8(v);
                }
            }
        }
        pg8::Gemm g{U1, WIN, MPR, DIN, D}; pg8::StaticOrder S; S.init(MPR, DIN, G, (int)blockIdx.x);
        EpiIn E{XR, GG, QN, KF, VF, SG1, SG2, p.out, p.in[16], p.in[17], (LAS float*)(lds + LDS_SCR)};
        pg8::gemm_phase<EpiIn, pg8::StaticOrder, true, true>(lds, g, S, E);
    }
    XBAR();
    PR_END(1);

    PR_BEGIN(2);
    if constexpr ((PH_MASK >> 2) & 1) {
        PHASE_IDS
        constexpr int NA_P = BP * NH * (TP / 32), NA_S = BS * NH, NL = BP * (NCHUNK / 2) * 16;
        for (int su = blockIdx.x; su < NA_S; su += G) {
            const int b = su / NH, h = su % NH, r32 = lane & 31, hi = lane >> 5, kb = PAST / 32 - 1 - wave;
            LAS bf16x8* sl = (LAS bf16x8*)(lds + wave * 16384) + lane;
            const float* kp = p.in[2] + (((size_t)b * PAST + 32 * kb + r32) * NH + h) * HD + 8 * hi;
#pragma unroll
            for (int ks = 0; ks < 8; ++ks) { const f32x4 a = *(const f32x4*)(kp + 16 * ks), c = *(const f32x4*)(kp + 16 * ks + 4);
                u32x4 w; w.x = pk2(a.x, a.y); w.y = pk2(a.z, a.w); w.z = pk2(c.x, c.y); w.w = pk2(c.z, c.w); sl[ks * 64] = __builtin_bit_cast(bf16x8, w); }
#pragma unroll
            for (int f = 0; f < 8; ++f) {
                const int k0 = 32 * kb + 16 * (f & 1) + 4 * hi;
                const float* vp = p.in[3] + (((size_t)b * PAST + k0) * NH + h) * HD + (f >> 1) * 32 + r32;
                float e[8];
#pragma unroll
                for (int j = 0; j < 8; ++j) e[j] = vp[(size_t)(8 * (j >> 2) + (j & 3)) * (NH * HD)];
                u32x4 w; w.x = pk2(e[0], e[1]); w.y = pk2(e[2], e[3]); w.z = pk2(e[4], e[5]); w.w = pk2(e[6], e[7]); sl[512 + f * 64] = __builtin_bit_cast(bf16x8, w);
            }
            __syncthreads();
            if (wave == 0) { PR_BEGIN(9); attn_unit<true>(QN, KF, VF, KFs, VFs, p.in[2], p.in[3], QN, b, h, 0, lds + LDS_SCR, lds, lane); PR_END(9); }
            __syncthreads();
        }
        for (int it = gw; it < NA_P; it += NGW) {
            const int grp = it >> 3, bh = grp & (BP * NH - 1), qb = (TP / 32 - 1) - ((grp / (BP * NH)) * 8 + (it & 7)); attn_unit<false>(QN, KF, VF, KFs, VFs, p.in[2], p.in[3], QN, bh / NH, bh % NH, qb, lds + wave * WLDS, lds, lane); }
        PR_BEGIN(10);
        for (int r = gw; r < NL; r += NGW) lru_unit<false, false>(p, r / ((NCHUNK / 2) * 16), 2 * ((r / 16) % (NCHUNK / 2)), r % 16, lds + wave * WLDS, lane);
        PR_END(10);
    }
    XBAR();
    PR_END(2);

    PR_BEGIN(3);
    if constexpr ((PH_MASK >> 3) & 1) {
        PHASE_IDS
        constexpr int NL = BP * (NCHUNK / 2) * 16, NLS = BS * 16;
        if (NGW == 2048) {
            const int q = (gw >> 4) & 31;
            if (q >= 30) { const int r = (q - 30) * 64 + (gw >> 9) * 16 + (gw & 15); lru_unit<true, true>(p, r / 16, 0, r % 16, lds + wave * WLDS, lane); }
            lru_final_light(p, gw / ((NCHUNK / 2) * 16), 2 * ((NCHUNK / 2 - 1) - q), gw % 16, lane);
        } else {
            for (int it = gw; it < NL + NLS; it += NGW) {
                if (it < NL) lru_final_light(p, it / ((NCHUNK / 2) * 16), 2 * ((NCHUNK / 2 - 1) - ((it / 16) % (NCHUNK / 2))), it % 16, lane);
                else { const int r = it - NL; lru_unit<true, true>(p, r / 16, 0, r % 16, lds + wave * WLDS, lane); }
            }
        }
        {
            LAS float* scr = (LAS float*)(lds + wave * WLDS);
            constexpr int I_SQ = (D / 64) * (D / 32), I_UP = (D / 64) * (2 * DFF / 32), I_DN = (DFF / 64) * (D / 32);
            for (int it = gw; it < 3 * I_SQ + I_UP + I_DN; it += NGW) {
                int r = it;
                if (r < I_SQ) { p0_transpose_item(p.in[18], D, D, WPR, scr, r, lane); continue; } r -= I_SQ;
                if (r < I_SQ) { p0_transpose_item(p.in[19], D, D, WPA, scr, r, lane); continue; } r -= I_SQ;
                if (r < I_SQ) { p0_transpose_item(p.in[20], D, D, WOUT, scr, r, lane); continue; } r -= I_SQ;
                if (r < I_UP) { p0_transpose_item(p.in[22], D, 2 * DFF, WUP, scr, r, lane); continue; } r -= I_UP;
                p0_transpose_item(p.in[25], DFF, D, WDN, scr, r, lane);
            }
        }
    }
    XBAR();
    PR_END(3);

    PR_BEGIN(4);
    if constexpr ((PH_MASK >> 4) & 1) {
        {
            int tid = threadIdx.x; asm volatile("" : "+v"(tid));
            for (int un = blockIdx.x; un < 4 * (D / 128); un += G) {
                const int ru = un & 3, n0 = (un >> 2) * 128; float a[8], b2[8];
                sgemm_tile<D>(GG + (size_t)(MPR + 32 * ru) * D, WPR + (size_t)n0 * D, (LAS float*)lds, tid, a);
                sgemm_tile<D>(QN + (size_t)(MPR + 32 * ru) * D, WPA + (size_t)n0 * D, (LAS float*)lds, tid, b2);
                const size_t off = (size_t)(MPR + 32 * ru + (tid >> 4)) * D + n0 + (tid & 15) * 8;
                float g1[8], g2[8]; unpack8(*(const u32x4*)(SG1 + off), g1); unpack8(*(const u32x4*)(SG2 + off), g2);
#pragma unroll
                for (int e = 0; e < 8; ++e) a[e] = a[e] * g1[e] + b2[e] * g2[e];
                *(u32x4*)(MG + off) = pack8(a);
            }
        }
        static_assert(WS_S1 - WS_S0 == (size_t)(MP / 256) * 256 * D * 2 && WS_WPA - WS_WPR == (size_t)4 * 256 * D * 2, "operand adjacency the paired units rely on");
        PairOrder S; S.base.init(MPR, D, G, (int)blockIdx.x);
        pg8::Gemm g{GG, WPR, MPR, D, D}; EpiP4 E{EpiT1{SG1, T1}, EpiMG{SG2, T1, MG}};
        pg8::gemm_phase<EpiP4, PairOrder, true, true>(lds, g, S, E);
    }
    XBAR();
    PR_END(4);

    PR_BEGIN(5);
    if constexpr ((PH_MASK >> 5) & 1) {
        {
            int tid = threadIdx.x; asm volatile("" : "+v"(tid));
            for (int un = blockIdx.x; un < 4 * (D / 128); un += G) {
                const int ru = un & 3, n0 = (un >> 2) * 128; float v[8], xv[8], lv[8];
                sgemm_tile<D>(MG + (size_t)(MPR + 32 * ru) * D, WOUT + (size_t)n0 * D, (LAS float*)lds, tid, v);
                const int r = MPR + 32 * ru + (tid >> 4), col = n0 + (tid & 15) * 8;
                ld8f(p.in[1] + (size_t)(r - MPR) * D + col, xv); ld8f(p.in[21] + col, lv);
                float ss = 0.f;
#pragma unroll
                for (int e = 0; e < 8; ++e) { v[e] += xv[e]; ss += v[e] * v[e]; }
                st8f(p.out + (size_t)r * D + col, v);
#pragma unroll
                for (int e = 0; e < 8; ++e) v[e] *= lv[e];
                *(u32x4*)(U2 + (size_t)r * D + col) = pack8(v);
                ss = sum16(ss);
                if ((tid & 15) == 0) atomicAdd(SS2 + r, ss);
            }
        }
        pg8::Gemm g{MG, WOUT, MPR, D, D}; pg8::StaticOrder S; S.init(MPR, D, G, (int)blockIdx.x);
        EpiX1 E{p.in[0], p.in[1], p.in[21], p.out, U2, SS2};
        pg8::gemm_phase<EpiX1, pg8::StaticOrder, true, true>(lds, g, S, E);
    }
    XBAR();
    PR_END(5);

    PR_BEGIN(6);
    if constexpr ((PH_MASK >> 6) & 1) {
        {
            int tid = threadIdx.x; asm volatile("" : "+v"(tid));
            for (int un = blockIdx.x; un < 4 * (2 * DFF / 128); un += G) {
                const int ru = un & 3, n0 = (un >> 2) * 128; float v[8];
                sgemm_tile<D>(U2 + (size_t)(MPR + 32 * ru) * D, WUP + (size_t)n0 * D, (LAS float*)lds, tid, v);
                const int r = MPR + 32 * ru + (tid >> 4), col = n0 + (tid & 15) * 8;
                const float rs = rsqrtf(SS2[r] * (1.f / D) + EPS);
#pragma unroll
                for (int e = 0; e < 8; ++e) v[e] *= rs;
                bf16* dst = (col < DFF) ? GP + (size_t)r * DFF + col : VAL + (size_t)r * DFF + (col - DFF);
                *(u32x4*)dst = pack8(v);
            }
        }
        pg8::Gemm g{U2, WUP, MPR, 2 * DFF, D}; pg8::StaticOrder S; S.init(MPR, 2 * DFF, G, (int)blockIdx.x);
        EpiUp E{SS2, GP, VAL};
        pg8::gemm_phase<EpiUp, pg8::StaticOrder, true, true>(lds, g, S, E);
    }
    XBAR();
    PR_END(6);

    PR_BEGIN(7);
    if constexpr ((PH_MASK >> 7) & 1) {
        PHASE_IDS
        constexpr int NCC = DFF / 8, NITEMS = (MROWS / 16) * NCC;
        const float* fw = p.in[23]; const float* fb = p.in[24];
        for (int it = blockIdx.x * 512 + tid; it < NITEMS; it += G * 512) {
            const int rg = it / NCC, c0 = (it % NCC) * 8, r0 = rg * 16;
            float gm2[8], gm1[8], w0[8], w1[8], w2[8], bb[8];
#pragma unroll
            for (int e = 0; e < 8; ++e) { w0[e] = fw[c0 + e]; w1[e] = fw[DFF + c0 + e]; w2[e] = fw[2 * DFF + c0 + e]; bb[e] = fb[c0 + e]; gm2[e] = 0.f; gm1[e] = 0.f; }
            const bool smp = r0 >= MPR;
            if (smp) { const float* hs = p.in[6] + (size_t)((r0 - MPR) >> 4) * 2 * DFF + c0;
#pragma unroll
                for (int e = 0; e < 8; ++e) { gm2[e] = hs[e]; gm1[e] = hs[DFF + e]; } }
            else if ((r0 & (TP - 1)) != 0) { unpack8(*(const u32x4*)(GP + (size_t)(r0 - 2) * DFF + c0), gm2); unpack8(*(const u32x4*)(GP + (size_t)(r0 - 1) * DFF + c0), gm1); }
#pragma unroll 4
            for (int k = 0; k < 16; ++k) {
                float g2[8], vv[8]; const size_t off = (size_t)(r0 + k) * DFF + c0;
                unpack8(*(const u32x4*)(GP + off), g2); unpack8(*(const u32x4*)(VAL + off), vv);
                float hm[8];
#pragma unroll
                for (int e = 0; e < 8; ++e) { hm[e] = gelu_f(w0[e] * gm2[e] + w1[e] * gm1[e] + w2[e] * g2[e] + bb[e]) * vv[e]; gm2[e] = gm1[e]; gm1[e] = g2[e]; }
                u32x4 w; w.x = pk2(hm[0], hm[1]); w.y = pk2(hm[2], hm[3]); w.z = pk2(hm[4], hm[5]); w.w = pk2(hm[6], hm[7]);
                *(u32x4*)(VAL + off) = w;
            }
            if (smp || ((r0 + 16) & (TP - 1)) == 0) {
                float* o = p.out + (smp ? O_FCS + (size_t)((r0 - MPR) >> 4) * 2 * DFF : O_FCP + (size_t)(r0 >> 12) * 2 * DFF) + c0;
#pragma unroll
                for (int e = 0; e < 8; ++e) { o[e] = gm2[e]; o[DFF + e] = gm1[e]; }
            }
        }
    }
    XBAR();
    PR_END(7);

    PR_BEGIN(8);
    if constexpr ((PH_MASK >> 8) & 1) {
        {
            int tid = threadIdx.x; asm volatile("" : "+v"(tid));
            for (int un = blockIdx.x; un < 4 * (D / 128); un += G) {
                const int ru = un & 3, n0 = (un >> 2) * 128; float v[8], xv[8];
                sgemm_tile<DFF>(VAL + (size_t)(MPR + 32 * ru) * DFF, WDN + (size_t)n0 * DFF, (LAS float*)lds, tid, v);
                float* o = p.out + (size_t)(MPR + 32 * ru + (tid >> 4)) * D + n0 + (tid & 15) * 8;
                ld8f(o, xv);
#pragma unroll
                for (int e = 0; e < 8; ++e) v[e] += xv[e];
                st8f(o, v);
            }
        }
        pg8::Gemm g{VAL, WDN, MPR, D, DFF}; pg8::StaticOrder S; S.init(MPR, D, G, (int)blockIdx.x);
        EpiDown E{p.out};
        pg8::gemm_phase<EpiDown, pg8::StaticOrder, true, true>(lds, g, S, E);
    }
    PR_END(8);
    if constexpr (PROBE_MASK != 0) { const unsigned long long te = __builtin_amdgcn_s_memrealtime(); while (__builtin_amdgcn_s_memrealtime() - te < PROBE_MULT * pr_acc) __builtin_amdgcn_s_sleep(8); }
}

extern "C" void kernel_launch(void* const* d_in, const int* in_sizes, int n_in, void* d_out, int out_size, void* d_ws, size_t ws_size, hipStream_t stream) {
    static int grid = 0;
    if (grid == 0) {
        if (n_in != 26 || (size_t)out_size != O_END || ws_size < WS_END) { fprintf(stderr, "kernel_launch: unexpected shapes: n_in %d out %d ws %zu (need %zu)\n", n_in, out_size, ws_size, (size_t)WS_END); grid = -1; return; }
        int dev = 0, cus = 0, per_cu = 0;
        hipGetDevice(&dev); hipDeviceGetAttribute(&cus, hipDeviceAttributeMultiprocessorCount, dev);
        if (hipFuncSetAttribute((const void*)hawk_fwd, hipFuncAttributeMaxDynamicSharedMemorySize, LDS_BYTES) != hipSuccess) { fprintf(stderr, "kernel_launch: hipFuncSetAttribute failed\n"); grid = -1; return; }
        if (hipOccupancyMaxActiveBlocksPerMultiprocessor(&per_cu, (const void*)hawk_fwd, 512, LDS_BYTES) != hipSuccess || per_cu < 1) { fprintf(stderr, "kernel_launch: occupancy query gave %d\n", per_cu); (void)hipGetLastError(); per_cu = 1; }
        grid = cus * per_cu;
    }
    if (grid < 0) return;
    (void)hipMemsetAsync((char*)d_ws + WS_CTL, 0, 131072, stream);
    Params prm{};
    for (int i = 0; i < 26; ++i) prm.in[i] = (const float*)d_in[i];
    prm.out = (float*)d_out; prm.ws = (unsigned char*)d_ws;
    void* args[] = {&prm};
    hipError_t e = hipLaunchCooperativeKernel((const void*)hawk_fwd, dim3(grid), dim3(512), args, LDS_BYTES, stream);
    if (e != hipSuccess) fprintf(stderr, "cooperative launch failed: %s (grid %d)\n", hipGetErrorString(e), grid);
}
```

```cpp
#include <hip/hip_runtime.h>
#include <hip/hip_cooperative_groups.h>
#include <cstdio>
#include <cstdint>
#include <cmath>
namespace cg = cooperative_groups;
#ifndef PH_MASK
#define PH_MASK 0x1ff
#endif
#ifndef PROBE_MASK
#define PROBE_MASK 0
#endif
#ifndef PROBE_MULT
#define PROBE_MULT 2
#endif
namespace pg8 {
#define PG8_LAS __attribute__((address_space(3)))
typedef unsigned short bf16_t;
typedef short bf16x8 __attribute__((ext_vector_type(8)));
typedef float f32x4 __attribute__((ext_vector_type(4)));
typedef unsigned u32x4 __attribute__((ext_vector_type(4)));
constexpr int BM = 256, BK = 64, HALF = 128, HTB = HALF * BK * 2  , STAGE_BYTES = 8 * HTB, NXCD = 8, WGM = 8;

__host__ __device__ __forceinline__ int lds_byte(int r, int c) { const int st = (r >> 4) * 2 + (c >> 5), rr = r & 15, cc = c & 31, ob = rr * 64 + cc * 2; return st * 1024 + (ob ^ (((ob >> 9) & 1) << 5)); }
__host__ __device__ __forceinline__ void stage_rc(int b, int& R, int& C) { const int st = b / 1024, sb = b % 1024, swz = sb ^ (((sb >> 9) & 1) << 5); R = (st >> 1) * 16 + swz / 64; C = (st & 1) * 32 + (swz % 64) / 2; }
__host__ __device__ __forceinline__ int perm32(int rho) { const int n = rho >> 4, i = rho & 15; return 8 * (i >> 2) + 4 * n + (i & 3); }

struct Unit { int pm, pn; };
struct Gemm { const bf16_t* A; const bf16_t* Bt; int M, N, K; };

struct StaticOrder {
    int nM, nN, nwg, G, c;
    __host__ __device__ void init(int M, int N, int G_, int c_) { nM = M / BM; nN = N / BM; nwg = nM * nN; G = G_; c = c_; }
    __host__ __device__ bool next(int i, Unit& u) const {
        const long L = (long)i * G + c; if (L >= nwg) return false;
        int wgid = (int)L; { const int q = nwg / NXCD, r = nwg % NXCD, xcd = wgid % NXCD, off = wgid / NXCD; wgid = (xcd < r ? xcd * (q + 1) : r * (q + 1) + (xcd - r) * q) + off; }
        const int nig = WGM * nN, gid = wgid / nig, fm = gid * WGM, gsz = (nM - fm) < WGM ? (nM - fm) : WGM;
        u.pm = fm + ((wgid % nig) % gsz); u.pn = (wgid % nig) / gsz; return true;
    }
    __device__ __forceinline__ void a_ready(const Unit&) const {}
    __device__ __forceinline__ void done(const Unit&) const {}
};

__device__ __forceinline__ unsigned cvt_pk_bf16(float lo, float hi) { unsigned r; asm volatile("v_cvt_pk_bf16_f32 %0, %1, %2" : "=v"(r) : "v"(lo), "v"(hi)); return r; }
typedef float f32x2 __attribute__((ext_vector_type(2)));
__device__ __forceinline__ f32x2 gelu_pk(f32x2 v) {
    const f32x2 av = __builtin_elementwise_abs(v), d = av * 0.2316418882f + 1.0f;
    f32x2 t; t.x = __builtin_amdgcn_rcpf(d.x); t.y = __builtin_amdgcn_rcpf(d.y);
    f32x2 q = t * 0.5307027145f + (-0.7265760135f); q = q * t + 0.7107068705f; q = q * t + (-0.142248368f); q = q * t + 0.127414796f; q = q * t;
    const f32x2 s = (v * v) * (-0.72134752044f);
    f32x2 e; e.x = __builtin_amdgcn_exp2f(s.x); e.y = __builtin_amdgcn_exp2f(s.y);
    const f32x2 m = v * (q * e), r = v - m;
    f32x2 o; o.x = v.x < 0.f ? m.x : r.x; o.y = v.y < 0.f ? m.y : r.y; return o;
}

template <int ACT  > struct EpiBf16 {
    static constexpr bool PERM = true, AFTER_DRAIN = false; static_assert(ACT == 0 || ACT == 1, "EpiBf16: ACT is 0 (none) or 1 (gelu_pk)");
    bf16_t* O; int ldc; const float* bias; int split_cols; size_t split_stride; float scale0;
    __device__ __forceinline__ void operator()(const f32x4 (&acc)[2][2][4][2], const Unit& u, int wr, int wc, int fr, int fq) const {
        const int row0 = u.pm * BM + wr * 64 + fr; int colt = u.pn * BM; bf16_t* base = O;
        float sc = 1.f; if (split_cols) { const int t = colt / split_cols; base += (size_t)t * split_stride; colt -= t * split_cols; if (t == 0) sc = scale0; }
        const int col0 = colt + wc * 32 + 8 * fq, bcol0 = u.pn * BM + wc * 32 + 8 * fq;
        f32x4 bv[2][2];
#pragma unroll
        for (int bj = 0; bj < 2; ++bj)
#pragma unroll
            for (int n = 0; n < 2; ++n) bv[bj][n] = bias ? *(const f32x4*)(bias + bcol0 + bj * HALF + 4 * n) : (f32x4){0.f, 0.f, 0.f, 0.f};
#pragma unroll
        for (int ai = 0; ai < 2; ++ai)
#pragma unroll
            for (int m = 0; m < 4; ++m) { bf16_t* rowp = base + (size_t)(row0 + ai * HALF + m * 16) * ldc + col0;
#pragma unroll
                for (int bj = 0; bj < 2; ++bj) { f32x4 v0 = acc[ai][bj][m][0] + bv[bj][0], v1 = acc[ai][bj][m][1] + bv[bj][1];
                    if (ACT == 1) { f32x2 a = gelu_pk((f32x2){v0[0], v0[1]}), b = gelu_pk((f32x2){v0[2], v0[3]}), c = gelu_pk((f32x2){v1[0], v1[1]}), d = gelu_pk((f32x2){v1[2], v1[3]});
                        v0 = (f32x4){a.x, a.y, b.x, b.y}; v1 = (f32x4){c.x, c.y, d.x, d.y}; }
                    v0 = v0 * sc; v1 = v1 * sc; u32x4 w; w.x = cvt_pk_bf16(v0[0], v0[1]); w.y = cvt_pk_bf16(v0[2], v0[3]); w.z = cvt_pk_bf16(v1[0], v1[1]); w.w = cvt_pk_bf16(v1[2], v1[3]);
                    *(u32x4*)(rowp + bj * HALF) = w; } }
    }
};
template <class Epi, class Sched, bool ALIGN_EPI = false, bool SP2 = false>
__device__ __forceinline__ void gemm_phase(PG8_LAS unsigned char* lds, const Gemm g, const Sched& S, const Epi& E) {
    int tid_l = threadIdx.x; asm volatile("" : "+v"(tid_l));
    const int tid = tid_l, wid = __builtin_amdgcn_readfirstlane(tid >> 6), lane = tid & 63, wr = wid >> 2, wc = wid & 3, fr = lane & 15, fq = lane >> 4;
    const int K = g.K, nt = K / BK;
    unsigned voffA[2], voffB[2];
#pragma unroll
    for (int i = 0; i < 2; ++i) { int R, C; stage_rc(tid * 16 + i * 8192, R, C); const int Rb = Epi::PERM ? ((R & ~31) + perm32(R & 31)) : R;
        voffA[i] = (unsigned)(R * K + C) * 2u; voffB[i] = (unsigned)(Rb * K + C) * 2u; }
    const size_t kstep = (size_t)(BK * 2);
    const size_t hstep = (size_t)HALF * K * 2;
    const size_t tstep = 2 * hstep;
    const unsigned ldsw = (unsigned)wid * 1024u;
    const int aoff = lds_byte(wr * 64 + fr, fq * 8), boff = lds_byte(wc * 32 + fr, fq * 8);
#define PG8_SA(b, h) (((b) * 2 + (h)) * HTB)
#define PG8_SB(b, h) ((4 + (b) * 2 + (h)) * HTB)
#define PG8_STAGE(bufoff, gbase, voff) do { _Pragma("unroll") for (int _i = 0; _i < 2; ++_i) \
        __builtin_amdgcn_global_load_lds((const unsigned*)((const char*)(gbase) + (voff)[_i]), (PG8_LAS unsigned*)(lds + (bufoff) + ldsw + _i * 8192), 16, 0, 0); } while (0)
#define PG8_LDA(dst, b, h) do { _Pragma("unroll") for (int m = 0; m < 4; ++m) _Pragma("unroll") for (int k = 0; k < 2; ++k) dst[m][k] = *(const PG8_LAS bf16x8*)(lds + PG8_SA(b, h) + aoff + m * 2048 + k * 1024); } while (0)
#define PG8_LDB(dst, b, h) do { _Pragma("unroll") for (int n = 0; n < 2; ++n) _Pragma("unroll") for (int k = 0; k < 2; ++k) dst[n][k] = *(const PG8_LAS bf16x8*)(lds + PG8_SB(b, h) + boff + n * 2048 + k * 1024); } while (0)
#define PG8_MMA(ai, bj, At, Bt) do { __builtin_amdgcn_s_setprio(1); _Pragma("unroll") for (int m = 0; m < 4; ++m) _Pragma("unroll") for (int n = 0; n < 2; ++n) _Pragma("unroll") for (int k = 0; k < 2; ++k) \
        acc[ai][bj][m][n] = __builtin_amdgcn_mfma_f32_16x16x32_bf16(Bt[n][k], At[m][k], acc[ai][bj][m][n], 0, 0, 0); __builtin_amdgcn_s_setprio(0); } while (0)
#define PG8_WAIT_V(n) asm volatile("s_waitcnt vmcnt(" #n ")" ::: "memory")
#define PG8_WAIT_L(n) asm volatile("s_waitcnt lgkmcnt(" #n ")" ::: "memory")
#define PG8_BAR __builtin_amdgcn_s_barrier()
#define PG8_SCHED __builtin_amdgcn_sched_barrier(0)
    Unit cur, nxt; int ui = 0;
    if (!S.next(0, cur)) return;
    f32x4 acc[2][2][4][2];
#pragma unroll
    for (int a = 0; a < 2; ++a)
#pragma unroll
        for (int b = 0; b < 2; ++b)
#pragma unroll
            for (int m = 0; m < 4; ++m)
#pragma unroll
                for (int n = 0; n < 2; ++n) acc[a][b][m][n] = (f32x4){0.f, 0.f, 0.f, 0.f};
    bf16x8 At[4][2], B0[2][2], B1[2][2];
    const char* cA = (const char*)g.A + (size_t)cur.pm * tstep; const char* cB = (const char*)g.Bt + (size_t)cur.pn * tstep;
    S.a_ready(cur);
    if constexpr (SP2) {
        PG8_STAGE(PG8_SB(0, 0), cB, voffB); PG8_STAGE(PG8_SB(0, 1), cB + hstep, voffB); PG8_STAGE(PG8_SA(0, 0), cA, voffA); PG8_STAGE(PG8_SA(0, 1), cA + hstep, voffA);
        if (wr == 1) PG8_BAR;
        PG8_WAIT_V(2); PG8_BAR;
        PG8_STAGE(PG8_SB(1, 0), cB + kstep, voffB); PG8_STAGE(PG8_SA(1, 0), cA + kstep, voffA); PG8_STAGE(PG8_SB(1, 1), cB + hstep + kstep, voffB);
        PG8_WAIT_V(6); PG8_BAR;
    } else {
        PG8_STAGE(PG8_SB(0, 0), cB, voffB); PG8_STAGE(PG8_SA(0, 0), cA, voffA); PG8_STAGE(PG8_SB(0, 1), cB + hstep, voffB); PG8_STAGE(PG8_SA(0, 1), cA + hstep, voffA);
        if (wr == 1) PG8_BAR;
        PG8_WAIT_V(4); PG8_BAR;
        PG8_STAGE(PG8_SB(1, 0), cB + kstep, voffB); PG8_STAGE(PG8_SA(1, 0), cA + kstep, voffA); PG8_STAGE(PG8_SB(1, 1), cB + hstep + kstep, voffB);
        PG8_WAIT_V(6); PG8_BAR;
    }
    for (;;) {
        const bool has_next = S.next(ui + 1, nxt);
        const char* nA = has_next ? (const char*)g.A + (size_t)nxt.pm * tstep : cA; const char* nB = has_next ? (const char*)g.Bt + (size_t)nxt.pn * tstep : cB;
        for (int t = 0; t < nt; t += 2) {
            const bool last = (t == nt - 2);
            const char* a1 = cA + (size_t)(t + 1) * kstep;
            const char* a2 = last ? nA : cA + (size_t)(t + 2) * kstep; const char* b2 = last ? nB : cB + (size_t)(t + 2) * kstep;
            const char* a3 = a2 + kstep; const char* b3 = b2 + kstep;
            if (last && has_next) S.a_ready(nxt);
            if constexpr (SP2) {
            PG8_LDB(B0, 0, 0); PG8_LDB(B1, 0, 1); PG8_SCHED; PG8_LDA(At, 0, 0); PG8_STAGE(PG8_SA(1, 1), a1 + hstep, voffA);
            PG8_WAIT_V(8); PG8_WAIT_L(0); PG8_BAR; PG8_MMA(0, 0, At, B0); PG8_MMA(0, 1, At, B1); PG8_BAR; PG8_SCHED;
            PG8_LDA(At, 0, 1); PG8_STAGE(PG8_SB(0, 0), b2, voffB); PG8_STAGE(PG8_SB(0, 1), b2 + hstep, voffB); PG8_STAGE(PG8_SA(0, 0), a2, voffA);
            PG8_WAIT_V(8); PG8_WAIT_L(0); PG8_BAR; PG8_MMA(1, 0, At, B0); PG8_MMA(1, 1, At, B1); PG8_BAR; PG8_SCHED;
            PG8_LDB(B0, 1, 0); PG8_LDB(B1, 1, 1); PG8_SCHED; PG8_LDA(At, 1, 0); PG8_STAGE(PG8_SA(0, 1), a2 + hstep, voffA);
            PG8_WAIT_V(8); PG8_WAIT_L(0); PG8_BAR; PG8_MMA(0, 0, At, B0); PG8_MMA(0, 1, At, B1); PG8_BAR; PG8_SCHED;
            PG8_LDA(At, 1, 1); PG8_STAGE(PG8_SB(1, 0), b3, voffB); PG8_STAGE(PG8_SB(1, 1), b3 + hstep, voffB); PG8_STAGE(PG8_SA(1, 0), a3, voffA);
            PG8_WAIT_V(8); PG8_WAIT_L(0); PG8_BAR; PG8_MMA(1, 0, At, B0); PG8_MMA(1, 1, At, B1); PG8_BAR; PG8_SCHED;
            } else {
            PG8_LDB(B0, 0, 0); PG8_SCHED; PG8_LDA(At, 0, 0); PG8_STAGE(PG8_SA(1, 1), a1 + hstep, voffA);
            PG8_WAIT_L(8); PG8_BAR; PG8_WAIT_L(0); PG8_MMA(0, 0, At, B0); PG8_BAR; PG8_SCHED;
            PG8_LDB(B1, 0, 1); PG8_STAGE(PG8_SB(0, 0), b2, voffB);
            PG8_BAR; PG8_WAIT_L(0); PG8_MMA(0, 1, At, B1); PG8_BAR;
            PG8_LDA(At, 0, 1); PG8_STAGE(PG8_SA(0, 0), a2, voffA);
            PG8_BAR; PG8_WAIT_L(0); PG8_MMA(1, 0, At, B0); PG8_BAR; PG8_SCHED;
            PG8_STAGE(PG8_SB(0, 1), b2 + hstep, voffB);
            PG8_WAIT_V(6); PG8_BAR; PG8_MMA(1, 1, At, B1); PG8_BAR;
            PG8_LDB(B0, 1, 0); PG8_SCHED; PG8_LDA(At, 1, 0); PG8_STAGE(PG8_SA(0, 1), a2 + hstep, voffA);
            PG8_WAIT_L(8); PG8_BAR; PG8_WAIT_L(0); PG8_MMA(0, 0, At, B0); PG8_BAR; PG8_SCHED;
            PG8_LDB(B1, 1, 1); PG8_STAGE(PG8_SB(1, 0), b3, voffB);
            PG8_BAR; PG8_WAIT_L(0); PG8_MMA(0, 1, At, B1); PG8_BAR;
            PG8_LDA(At, 1, 1); PG8_STAGE(PG8_SA(1, 0), a3, voffA);
            PG8_BAR; PG8_WAIT_L(0); PG8_MMA(1, 0, At, B0); PG8_BAR; PG8_SCHED;
            PG8_STAGE(PG8_SB(1, 1), b3 + hstep, voffB);
            PG8_WAIT_V(6); PG8_BAR; PG8_MMA(1, 1, At, B1); PG8_BAR;
            }
        }
        if constexpr (ALIGN_EPI) { if (wr == 0) PG8_BAR; }
        if constexpr (!Epi::AFTER_DRAIN) { E(acc, cur, wr, wc, fr, fq); S.done(cur); }
        if (!has_next) break;
#pragma unroll
        for (int a = 0; a < 2; ++a)
#pragma unroll
            for (int b = 0; b < 2; ++b)
#pragma unroll
                for (int m = 0; m < 4; ++m)
#pragma unroll
                    for (int n = 0; n < 2; ++n) acc[a][b][m][n] = (f32x4){0.f, 0.f, 0.f, 0.f};
        cur = nxt; cA = nA; cB = nB; ++ui;
        if constexpr (ALIGN_EPI) { if (wr == 1) PG8_BAR; }
    }
    PG8_WAIT_V(0);
    if constexpr (!ALIGN_EPI) { if (wr == 0) PG8_BAR; }
    PG8_BAR;
    if constexpr (Epi::AFTER_DRAIN) { E.fused(acc, cur, wr, wc, fr, fq, lds, wid, lane); S.done(cur); }
#undef PG8_SA
#undef PG8_SB
#undef PG8_STAGE
#undef PG8_LDA
#undef PG8_LDB
#undef PG8_MMA
#undef PG8_WAIT_V
#undef PG8_WAIT_L
#undef PG8_BAR
#undef PG8_SCHED
}
}

#define LAS __attribute__((address_space(3)))
typedef unsigned short bf16;
typedef float f32x4 __attribute__((ext_vector_type(4)));
typedef float f32x2 __attribute__((ext_vector_type(2)));
typedef float f32x16 __attribute__((ext_vector_type(16)));
typedef short bf16x8 __attribute__((ext_vector_type(8)));
typedef unsigned u32x4 __attribute__((ext_vector_type(4)));
typedef unsigned u32x2 __attribute__((ext_vector_type(2)));
typedef __bf16 bf16x2_t __attribute__((ext_vector_type(2)));

constexpr int D = 1024, BP = 4, TP = 4096, MPR = BP * TP, BS = 8, TS = 16, MS = BS * TS, MROWS = MPR + MS, MP = 16640;
constexpr int PAST = 1024, NH = 8, HD = 128, DFF = 3072, DIN = 7168;
constexpr float EPS = 1e-6f;
constexpr int NCHUNK = TP / 64;

constexpr size_t O_YP = 0, O_YS = O_YP + (size_t)MPR * D, O_KP = O_YS + (size_t)MS * D, O_VP = O_KP + (size_t)MPR * D,
                 O_RCP = O_VP + (size_t)MPR * D, O_HP = O_RCP + (size_t)BP * 3 * D, O_FCP = O_HP + (size_t)BP * D,
                 O_KS = O_FCP + (size_t)BP * 2 * DFF, O_VS = O_KS + (size_t)MS * D, O_RCS = O_VS + (size_t)MS * D,
                 O_HS = O_RCS + (size_t)BS * 3 * D, O_FCS = O_HS + (size_t)BS * D, O_END = O_FCS + (size_t)BS * 2 * DFF;

constexpr size_t MiB = 1u << 20;
constexpr size_t SLOT = (size_t)MP * D * 2;
constexpr size_t WS_CTL = 0, CTL_BYTES = 1 * MiB;
constexpr size_t WS_WUP = 1 * MiB, WS_WDN = 13 * MiB, WS_WPR = 19 * MiB, WS_WPA = 21 * MiB, WS_WOUT = 23 * MiB, WS_WAT = 25 * MiB, WS_WXT = WS_WAT + 131072;
constexpr size_t WS_S0 = 25 * MiB + 262144;
constexpr size_t WS_S1 = WS_S0 + SLOT, WS_S2 = WS_S1 + SLOT, WS_S3 = WS_S2 + SLOT, WS_S4 = WS_S3 + SLOT, WS_S5 = WS_S4 + SLOT, WS_S6 = WS_S5 + SLOT;
constexpr size_t WS_VTS = WS_S6 + SLOT, WS_SUMP = WS_VTS + 1 * MiB, WS_SUMH = WS_SUMP + 1 * MiB, WS_END = WS_SUMH + 1 * MiB;
static_assert(WS_END <= 256 * MiB, "workspace map exceeds 256 MiB");

constexpr int WLDS = 18816;
constexpr int LDS_BYTES = 8 * WLDS;
constexpr int LDS_SCR = 131072;

__device__ __forceinline__ unsigned pk2(float lo, float hi) { f32x2 v = {lo, hi}; bf16x2_t b = __builtin_convertvector(v, bf16x2_t); return __builtin_bit_cast(unsigned, b); }
__device__ __forceinline__ float bf2f(unsigned short x) { return __uint_as_float((unsigned)x << 16); }
__device__ __forceinline__ float bflo(unsigned x) { return __uint_as_float(x << 16); }
__device__ __forceinline__ float bfhi(unsigned x) { return __uint_as_float(x & 0xffff0000u); }
__device__ __forceinline__ float sigmoid_f(float x) { return __builtin_amdgcn_rcpf(1.f + __expf(-x)); }
__device__ __forceinline__ float gelu_f(float x) { const float u = 1.5957691216057308f * (x + 0.044715f * x * x * x); return x * sigmoid_f(u); }
__device__ __forceinline__ float softplus_f(float z) { return fmaxf(z, 0.f) + __logf(1.f + __expf(-fabsf(z))); }
__device__ __forceinline__ float wave_sum(float v) {
#pragma unroll
    for (int o = 1; o < 64; o <<= 1) v += __shfl_xor(v, o);
    return v;
}
__device__ __forceinline__ void unpack8(const u32x4 w, float (&f)[8]) {
    f[0] = bflo(w.x); f[1] = bfhi(w.x); f[2] = bflo(w.y); f[3] = bfhi(w.y); f[4] = bflo(w.z); f[5] = bfhi(w.z); f[6] = bflo(w.w); f[7] = bfhi(w.w);
}

__device__ __forceinline__ u32x4 pack8(const float (&v)[8]) { u32x4 w; w.x = pk2(v[0], v[1]); w.y = pk2(v[2], v[3]); w.z = pk2(v[4], v[5]); w.w = pk2(v[6], v[7]); return w; }
__device__ __forceinline__ void st8f(float* o, const float (&v)[8]) { *(f32x4*)o = (f32x4){v[0], v[1], v[2], v[3]}; *(f32x4*)(o + 4) = (f32x4){v[4], v[5], v[6], v[7]}; }
__device__ __forceinline__ void ld8f(const float* o, float (&v)[8]) { const f32x4 a = *(const f32x4*)o, b = *(const f32x4*)(o + 4); v[0] = a.x; v[1] = a.y; v[2] = a.z; v[3] = a.w; v[4] = b.x; v[5] = b.y; v[6] = b.z; v[7] = b.w; }
__device__ __forceinline__ float sum16(float s) { s += __shfl_xor(s, 1); s += __shfl_xor(s, 2); s += __shfl_xor(s, 4); s += __shfl_xor(s, 8); return s; }
struct Params { const float* in[26]; float* out; unsigned char* ws; };
#define WSB(off) ((bf16*)(p.ws + (off)))
#define D0 ((bf16*)p.out)
#define D1 (((bf16*)p.out) + (size_t)MROWS * D)
#define WUP WSB(WS_WUP)
#define WDN WSB(WS_WDN)
#define WPR WSB(WS_WPR)
#define WPA WSB(WS_WPA)
#define WOUT WSB(WS_WOUT)
#define WAT WSB(WS_WAT)
#define WXT WSB(WS_WXT)
#define S0 WSB(WS_S0)
#define S1 WSB(WS_S1)
#define S2 WSB(WS_S2)
#define S3 WSB(WS_S3)
#define S4 WSB(WS_S4)
#define S5 WSB(WS_S5)
#define S6 WSB(WS_S6)
#define KFs WSB(WS_VTS)
#define VFs WSB(WS_VTS + 524288)
#define C8T ((float*)(p.ws + WS_CTL + 131072))
#define SUMP ((float*)(p.ws + WS_SUMP))
#define SUMH ((float*)(p.ws + WS_SUMH))
#define SS2 ((float*)(p.ws + WS_CTL))
#define U1 D0
#define XR D1
#define GG S0
#define QN S1
#define KF S2
#define VF S3
#define SG1 S4
#define SG2 S5
#define WIN S6
#define T1 S2
#define MG S6
#define U2 S0
#define GP S1
#define VAL S4
#define HLB S6
#define PCB D0

__device__ __forceinline__ void p0_transpose_item(const float* W, int K, int N, bf16* WT, LAS float* scr, int item, int lane) {
    const int nblk = N / 32, kb = item / nblk, nb = item % nblk, k0 = 64 * kb, n0 = 32 * nb;
#pragma unroll 32
    for (int i = 0; i < 32; ++i) { const int kk = 2 * i + (lane >> 5); scr[kk * 33 + (lane & 31)] = W[(size_t)(k0 + kk) * N + n0 + (lane & 31)]; }
    asm volatile("s_waitcnt lgkmcnt(0)" ::: "memory");
    const int c = lane & 7;
#pragma unroll
    for (int j = 0; j < 4; ++j) { const int n = (lane >> 3) + 8 * j; const LAS float* s = scr + (8 * c) * 33 + n;
        u32x4 o; o.x = pk2(s[0 * 33], s[1 * 33]); o.y = pk2(s[2 * 33], s[3 * 33]); o.z = pk2(s[4 * 33], s[5 * 33]); o.w = pk2(s[6 * 33], s[7 * 33]);
        *(u32x4*)(WT + (size_t)(n0 + n) * K + k0 + 8 * c) = o; }
    asm volatile("s_waitcnt lgkmcnt(0)" ::: "memory");
}
__device__ __forceinline__ void rms_row(const float* xrow, const float* g, bf16* orow, int lane) {
    const f32x4* xr = (const f32x4*)xrow + lane; const f32x4* gr = (const f32x4*)g + lane;
    f32x4 v[4]; float s = 0.f;
#pragma unroll
    for (int j = 0; j < 4; ++j) { v[j] = xr[64 * j]; s += (v[j].x * v[j].x + v[j].y * v[j].y) + (v[j].z * v[j].z + v[j].w * v[j].w); }
    const float rs = rsqrtf(wave_sum(s) * (1.f / D) + EPS);
    u32x2* o8 = (u32x2*)orow + lane;
#pragma unroll
    for (int j = 0; j < 4; ++j) { const f32x4 gv = gr[64 * j]; u32x2 o; o.x = pk2(v[j].x * rs * gv.x, v[j].y * rs * gv.y); o.y = pk2(v[j].z * rs * gv.z, v[j].w * rs * gv.w); o8[64 * j] = o; }
}

#define EPI_ARGS const f32x4 (&acc)[2][2][4][2], const pg8::Unit& u, int wr, int wc, int fr, int fq

struct EpiIn {
    static constexpr bool PERM = true, AFTER_DRAIN = false;
    bf16 *xr_, *gg_, *qn_, *kf_, *vf_, *sg1_, *sg2_; float* out; const float *qg, *kg; LAS float* scr;
    __device__ __forceinline__ void operator()(EPI_ARGS) const {
        const int seg = u.pn >> 2, cb = (u.pn & 3) * 256;
        const int rbase = u.pm * 256 + wr * 64 + fr;
        const int cl = wc * 32 + 8 * fq;
        if (seg == 2 || seg == 3) {
#pragma unroll
            for (int ai = 0; ai < 2; ++ai)
#pragma unroll
                for (int m = 0; m < 4; ++m)
#pragma unroll
                    for (int bj = 0; bj < 2; ++bj) {
                        const f32x4 a = acc[ai][bj][m][0], b = acc[ai][bj][m][1];
                        float s = (a.x * a.x + a.y * a.y) + (a.z * a.z + a.w * a.w) + (b.x * b.x + b.y * b.y) + (b.z * b.z + b.w * b.w);
                        s += __shfl_xor(s, 16); s += __shfl_xor(s, 32);
                        if (fq == 0) scr[((ai * 128 + wr * 64 + m * 16 + fr) * 2 + bj) * 4 + wc] = s;
                    }
            asm volatile("s_waitcnt lgkmcnt(0)" ::: "memory"); __builtin_amdgcn_s_barrier(); asm volatile("" ::: "memory");
            const float* gain = (seg == 2) ? qg : kg; const float osc = (seg == 2) ? 0.08838834764831845f : 1.0f;
            const f32x4 g0 = *(const f32x4*)(gain + cl), g1 = *(const f32x4*)(gain + cl + 4);

#pragma unroll
            for (int ai = 0; ai < 2; ++ai)
#pragma unroll
                for (int m = 0; m < 4; ++m) {
                    const int r = rbase + ai * 128 + m * 16;
#pragma unroll
                    for (int bj = 0; bj < 2; ++bj) {
                        const f32x4 pp = *(const LAS f32x4*)(scr + ((ai * 128 + wr * 64 + m * 16 + fr) * 2 + bj) * 4);
                        const float rs = rsqrtf(((pp.x + pp.y) + (pp.z + pp.w)) * (1.f / HD) + EPS);
                        const f32x4 a = acc[ai][bj][m][0] * rs * g0, b = acc[ai][bj][m][1] * rs * g1;
                        const int col = cb + bj * 128 + cl;
                        u32x4 w; w.x = pk2(a.x * osc, a.y * osc); w.y = pk2(a.z * osc, a.w * osc); w.z = pk2(b.x * osc, b.y * osc); w.w = pk2(b.z * osc, b.w * osc);
                        if (seg == 2) *(u32x4*)(qn_ + (size_t)r * D + col) = w;
                        else {
                            const int bb = r >> 12, t = r & (TP - 1), hh = (cb + bj * 128) >> 7;
                            *(u32x4*)(kf_ + ((((size_t)(bb * NH + hh) * (TP / 32) + (t >> 5)) * 8 + (cl >> 4)) * 512 + ((t & 31) + 32 * ((cl >> 3) & 1)) * 8)) = w;
                            float* o = out + O_KP + (size_t)r * D + col;
                            *(f32x4*)o = a; *(f32x4*)(o + 4) = b;
                        }
                    }
                }
        } else if (seg == 4) {
            LAS bf16* wscr = (LAS bf16*)scr + (wr * 4 + wc) * 512;
            const int L = fr + 16 * fq, dl = L & 31, hk = L >> 5;
#pragma unroll
            for (int ai = 0; ai < 2; ++ai)
#pragma unroll
                for (int m = 0; m < 4; ++m) {
                    const int r = rbase + ai * 128 + m * 16, bb = r >> 12, t0 = (r - fr) & (TP - 1);
#pragma unroll
                    for (int bj = 0; bj < 2; ++bj) {
                        const f32x4 a = acc[ai][bj][m][0], b = acc[ai][bj][m][1];
                        const int col = cb + bj * 128 + cl, hh = (cb + bj * 128) >> 7;
                        float* o = out + O_VP + (size_t)r * D + col;
                        *(f32x4*)o = a; *(f32x4*)(o + 4) = b;
                        u32x4 w; w.x = pk2(a.x, a.y); w.y = pk2(a.z, a.w); w.z = pk2(b.x, b.y); w.w = pk2(b.z, b.w);
                        *(LAS u32x4*)(wscr + fr * 32 + 8 * fq) = w;
                        asm volatile("s_waitcnt lgkmcnt(0)" ::: "memory");
                        unsigned short e[8];
#pragma unroll
                        for (int j = 0; j < 8; ++j) e[j] = wscr[(8 * (j >> 2) + 4 * hk + (j & 3)) * 32 + dl];
                        asm volatile("s_waitcnt lgkmcnt(0)" ::: "memory");
                        u32x4 g; g.x = (unsigned)e[0] | ((unsigned)e[1] << 16); g.y = (unsigned)e[2] | ((unsigned)e[3] << 16); g.z = (unsigned)e[4] | ((unsigned)e[5] << 16); g.w = (unsigned)e[6] | ((unsigned)e[7] << 16);
                        *(u32x4*)(vf_ + ((((size_t)(bb * NH + hh) * (TP / 32) + (t0 >> 5)) * 4 + wc) * 2 + ((t0 >> 4) & 1)) * 512 + L * 8) = g;
                    }
                }
        } else {
            bf16* dst = (seg == 0) ? xr_ : (seg == 1) ? gg_ : (seg == 5) ? sg1_ : sg2_;
            const int rlim = (seg == 0) ? MROWS : MP;
#pragma unroll
            for (int ai = 0; ai < 2; ++ai)
#pragma unroll
                for (int m = 0; m < 4; ++m) {
                    const int r = rbase + ai * 128 + m * 16;
                    if (r < rlim) {
#pragma unroll
                        for (int bj = 0; bj < 2; ++bj) {
                            f32x4 a = acc[ai][bj][m][0], b = acc[ai][bj][m][1];
                            if (seg == 1) { a.x = gelu_f(a.x); a.y = gelu_f(a.y); a.z = gelu_f(a.z); a.w = gelu_f(a.w); b.x = gelu_f(b.x); b.y = gelu_f(b.y); b.z = gelu_f(b.z); b.w = gelu_f(b.w); }
                            else if (seg >= 5) { a.x = sigmoid_f(a.x); a.y = sigmoid_f(a.y); a.z = sigmoid_f(a.z); a.w = sigmoid_f(a.w); b.x = sigmoid_f(b.x); b.y = sigmoid_f(b.y); b.z = sigmoid_f(b.z); b.w = sigmoid_f(b.w); }
                            u32x4 w; w.x = pk2(a.x, a.y); w.y = pk2(a.z, a.w); w.z = pk2(b.x, b.y); w.w = pk2(b.z, b.w);
                            *(u32x4*)(dst + (size_t)r * D + cb + bj * 128 + cl) = w;
                        }
                    }
                }
        }
    }
};

struct EpiT1 {
    static constexpr bool PERM = true, AFTER_DRAIN = false;
    const bf16* SG; bf16* t1_;
    __device__ __forceinline__ void operator()(EPI_ARGS) const {
        const int rbase = u.pm * 256 + wr * 64 + fr, c0 = u.pn * 256 + wc * 32 + 8 * fq;
        u32x4 sg[2][4][2];
#pragma unroll
        for (int ai = 0; ai < 2; ++ai)
#pragma unroll
            for (int m = 0; m < 4; ++m)
#pragma unroll
                for (int bj = 0; bj < 2; ++bj) sg[ai][m][bj] = *(const u32x4*)(SG + (size_t)(rbase + ai * 128 + m * 16) * D + c0 + bj * 128);
        __builtin_amdgcn_sched_barrier(0);
#pragma unroll
        for (int ai = 0; ai < 2; ++ai)
#pragma unroll
            for (int m = 0; m < 4; ++m)
#pragma unroll
                for (int bj = 0; bj < 2; ++bj) {
                    float g[8]; unpack8(sg[ai][m][bj], g);
                    const f32x4 a = acc[ai][bj][m][0], b = acc[ai][bj][m][1];
                    u32x4 w; w.x = pk2(a.x * g[0], a.y * g[1]); w.y = pk2(a.z * g[2], a.w * g[3]); w.z = pk2(b.x * g[4], b.y * g[5]); w.w = pk2(b.z * g[6], b.w * g[7]);
                    *(u32x4*)(t1_ + (size_t)(rbase + ai * 128 + m * 16) * D + c0 + bj * 128) = w;
                }
    }
};
struct EpiMG {
    static constexpr bool PERM = true, AFTER_DRAIN = false;
    const bf16* SG; const bf16* t1_; bf16* mg_;
    __device__ __forceinline__ void operator()(EPI_ARGS) const {
        const int rbase = u.pm * 256 + wr * 64 + fr, c0 = u.pn * 256 + wc * 32 + 8 * fq;
        u32x4 sg[4][2], tt[4][2], res[4][2];
#define MG_LOAD(AI) _Pragma("unroll") for (int m = 0; m < 4; ++m) _Pragma("unroll") for (int bj = 0; bj < 2; ++bj) { \
            const size_t off = (size_t)(rbase + (AI) * 128 + m * 16) * D + c0 + bj * 128; sg[m][bj] = *(const u32x4*)(SG + off); tt[m][bj] = *(const u32x4*)(t1_ + off); }
#define MG_CALC(AI) _Pragma("unroll") for (int m = 0; m < 4; ++m) _Pragma("unroll") for (int bj = 0; bj < 2; ++bj) { \
            float g[8], t[8]; unpack8(sg[m][bj], g); unpack8(tt[m][bj], t); const f32x4 a = acc[AI][bj][m][0], b = acc[AI][bj][m][1]; \
            u32x4 w; w.x = pk2(t[0] + a.x * g[0], t[1] + a.y * g[1]); w.y = pk2(t[2] + a.z * g[2], t[3] + a.w * g[3]); \
            w.z = pk2(t[4] + b.x * g[4], t[5] + b.y * g[5]); w.w = pk2(t[6] + b.z * g[6], t[7] + b.w * g[7]); res[m][bj] = w; }
#define MG_STORE(AI) _Pragma("unroll") for (int m = 0; m < 4; ++m) _Pragma("unroll") for (int bj = 0; bj < 2; ++bj) \
            *(u32x4*)(mg_ + (size_t)(rbase + (AI) * 128 + m * 16) * D + c0 + bj * 128) = res[m][bj];
        MG_LOAD(0)
        __builtin_amdgcn_sched_barrier(0);
        MG_CALC(0)
        MG_LOAD(1)
        __builtin_amdgcn_sched_barrier(0);
        MG_STORE(0)
        MG_CALC(1)
        MG_STORE(1)
#undef MG_LOAD
#undef MG_CALC
#undef MG_STORE
    }
};
struct EpiX1 {
    static constexpr bool PERM = true, AFTER_DRAIN = false;
    const float *xp, *xs, *ln2; float* out; bf16* u2_; float* ss2_;
    __device__ __forceinline__ void operator()(EPI_ARGS) const {
        const int rbase = u.pm * 256 + wr * 64 + fr, c0 = u.pn * 256 + wc * 32 + 8 * fq;
        f32x4 l[2][2];
#pragma unroll
        for (int bj = 0; bj < 2; ++bj) { l[bj][0] = *(const f32x4*)(ln2 + c0 + bj * 128); l[bj][1] = *(const f32x4*)(ln2 + c0 + bj * 128 + 4); }
        f32x4 xv[2][2][2], res[2][2][2];
#define X1_LOAD(Q) _Pragma("unroll") for (int mm = 0; mm < 2; ++mm) _Pragma("unroll") for (int bj = 0; bj < 2; ++bj) { \
            const float* xin = xp + (size_t)(rbase + ((Q) >> 1) * 128 + (((Q) & 1) * 2 + mm) * 16) * D + c0 + bj * 128; xv[mm][bj][0] = *(const f32x4*)xin; xv[mm][bj][1] = *(const f32x4*)(xin + 4); }
#define X1_ADD(Q) _Pragma("unroll") for (int mm = 0; mm < 2; ++mm) _Pragma("unroll") for (int bj = 0; bj < 2; ++bj) { \
            res[mm][bj][0] = acc[(Q) >> 1][bj][((Q) & 1) * 2 + mm][0] + xv[mm][bj][0]; res[mm][bj][1] = acc[(Q) >> 1][bj][((Q) & 1) * 2 + mm][1] + xv[mm][bj][1]; }
#define X1_STORE(Q) _Pragma("unroll") for (int mm = 0; mm < 2; ++mm) { const int r = rbase + ((Q) >> 1) * 128 + (((Q) & 1) * 2 + mm) * 16; float ss = 0.f; \
            _Pragma("unroll") for (int bj = 0; bj < 2; ++bj) { const f32x4 a = res[mm][bj][0], b = res[mm][bj][1]; const int col = c0 + bj * 128; \
                *(f32x4*)(out + (size_t)r * D + col) = a; *(f32x4*)(out + (size_t)r * D + col + 4) = b; \
                ss += (a.x * a.x + a.y * a.y) + (a.z * a.z + a.w * a.w) + (b.x * b.x + b.y * b.y) + (b.z * b.z + b.w * b.w); \
                u32x4 w; w.x = pk2(a.x * l[bj][0].x, a.y * l[bj][0].y); w.y = pk2(a.z * l[bj][0].z, a.w * l[bj][0].w); w.z = pk2(b.x * l[bj][1].x, b.y * l[bj][1].y); w.w = pk2(b.z * l[bj][1].z, b.w * l[bj][1].w); \
                *(u32x4*)(u2_ + (size_t)r * D + col) = w; } \
            ss += __shfl_xor(ss, 16); ss += __shfl_xor(ss, 32); if (fq == 0) atomicAdd(ss2_ + r, ss); }
        X1_LOAD(0)
        __builtin_amdgcn_sched_barrier(0);
        X1_ADD(0) X1_LOAD(1)
        __builtin_amdgcn_sched_barrier(0);
        X1_STORE(0) X1_ADD(1) X1_LOAD(2)
        __builtin_amdgcn_sched_barrier(0);
        X1_STORE(1) X1_ADD(2) X1_LOAD(3)
        __builtin_amdgcn_sched_barrier(0);
        X1_STORE(2) X1_ADD(3) X1_STORE(3)
#undef X1_LOAD
#undef X1_ADD
#undef X1_STORE
    }
};
struct PairOrder {
    pg8::StaticOrder base;
    __device__ __forceinline__ bool next(int i, pg8::Unit& u) const { pg8::Unit t; if (!base.next(i >> 1, t)) return false; u.pm = t.pm + ((i & 1) ? MP / 256 : 0); u.pn = t.pn + ((i & 1) ? 4 : 0); return true; }
    __device__ __forceinline__ void a_ready(const pg8::Unit&) const {}
    __device__ __forceinline__ void done(const pg8::Unit&) const {}
};
struct EpiP4 {
    static constexpr bool PERM = true, AFTER_DRAIN = false;
    EpiT1 e1; EpiMG e2;
    __device__ __forceinline__ void operator()(EPI_ARGS) const {
        if (u.pm >= MP / 256) { const pg8::Unit v{u.pm - MP / 256, u.pn - 4}; e2(acc, v, wr, wc, fr, fq); }
        else e1(acc, u, wr, wc, fr, fq);
    }
};
struct EpiUp {
    static constexpr bool PERM = true, AFTER_DRAIN = false;
    const float* ss2_; bf16 *gp_, *val_;
    __device__ __forceinline__ void operator()(EPI_ARGS) const {
        const int rbase = u.pm * 256 + wr * 64 + fr;
        bf16* dst = (u.pn < 12) ? gp_ : val_; const int c0 = (u.pn < 12 ? u.pn : u.pn - 12) * 256 + wc * 32 + 8 * fq;
        float ssv[2][4];
#pragma unroll
        for (int ai = 0; ai < 2; ++ai)
#pragma unroll
            for (int m = 0; m < 4; ++m) ssv[ai][m] = ss2_[rbase + ai * 128 + m * 16];
#pragma unroll
        for (int ai = 0; ai < 2; ++ai)
#pragma unroll
            for (int m = 0; m < 4; ++m) {
                const int r = rbase + ai * 128 + m * 16;
                const float rs = rsqrtf(ssv[ai][m] * (1.f / D) + EPS);
#pragma unroll
                for (int bj = 0; bj < 2; ++bj) {
                    const f32x4 a = acc[ai][bj][m][0] * rs, b = acc[ai][bj][m][1] * rs;
                    u32x4 w; w.x = pk2(a.x, a.y); w.y = pk2(a.z, a.w); w.z = pk2(b.x, b.y); w.w = pk2(b.z, b.w);
                    *(u32x4*)(dst + (size_t)r * DFF + c0 + bj * 128) = w;
                }
            }
    }
};
struct EpiDown {
    static constexpr bool PERM = true, AFTER_DRAIN = false;
    float* out;
    __device__ __forceinline__ void operator()(EPI_ARGS) const {
        const int rbase = u.pm * 256 + wr * 64 + fr, c0 = u.pn * 256 + wc * 32 + 8 * fq;
        f32x4 xv[4][2][2], res[4][2][2];
#define DN_LOAD(AI) _Pragma("unroll") for (int m = 0; m < 4; ++m) _Pragma("unroll") for (int bj = 0; bj < 2; ++bj) { \
            const float* o = out + (size_t)(rbase + (AI) * 128 + m * 16) * D + c0 + bj * 128; xv[m][bj][0] = *(const f32x4*)o; xv[m][bj][1] = *(const f32x4*)(o + 4); }
#define DN_ADD(AI) _Pragma("unroll") for (int m = 0; m < 4; ++m) _Pragma("unroll") for (int bj = 0; bj < 2; ++bj) { res[m][bj][0] = acc[AI][bj][m][0] + xv[m][bj][0]; res[m][bj][1] = acc[AI][bj][m][1] + xv[m][bj][1]; }
#define DN_STORE(AI) _Pragma("unroll") for (int m = 0; m < 4; ++m) _Pragma("unroll") for (int bj = 0; bj < 2; ++bj) { \
            float* o = out + (size_t)(rbase + (AI) * 128 + m * 16) * D + c0 + bj * 128; *(f32x4*)o = res[m][bj][0]; *(f32x4*)(o + 4) = res[m][bj][1]; }
        DN_LOAD(0)
        __builtin_amdgcn_sched_barrier(0);
        DN_ADD(0)
        DN_LOAD(1)
        __builtin_amdgcn_sched_barrier(0);
        DN_STORE(0)
        DN_ADD(1)
        DN_STORE(1)
#undef DN_LOAD
#undef DN_ADD
#undef DN_STORE
    }
};

#define MFMA32(a, b, c) __builtin_amdgcn_mfma_f32_32x32x16_bf16((a), (b), (c), 0, 0, 0)
template <bool SAMPLE>
__device__ __forceinline__ void attn_unit(const bf16* qn_, const bf16* kf_, const bf16* vf_, const bf16* kfs_, const bf16* vfs_, const float* ck, const float* cv, bf16* YA,
                                          int b, int h, int qb, LAS unsigned char* wl, LAS unsigned char* slabs, int lane) {
    const int r32 = lane & 31, hi = lane >> 5;
    int qpos0, qrow0, nq, kb;
    if (SAMPLE) { qpos0 = PAST; qrow0 = MPR + b * TS; nq = TS; kb = PAST / 32; }
    else { qpos0 = qb * 32; qrow0 = b * TP + qpos0; nq = 32; kb = (qpos0 + 30) >> 5; }
    const int qr = r32 < nq ? r32 : nq - 1;
    LAS bf16x8* qst = (LAS bf16x8*)wl + lane;
    { const bf16* qp = qn_ + (size_t)(qrow0 + qr) * D + h * HD + 8 * hi;
      bf16x8 qf[8];
#pragma unroll
      for (int ks = 0; ks < 8; ++ks) qf[ks] = *(const bf16x8*)(qp + 16 * ks);
      __builtin_amdgcn_sched_barrier(0);
#pragma unroll
      for (int ks = 0; ks < 8; ++ks) qst[ks * 64] = qf[ks]; }
    f32x16 o[4];
#pragma unroll
    for (int d = 0; d < 4; ++d)
#pragma unroll
        for (int i = 0; i < 16; ++i) o[d][i] = 0.f;
    float carry = 0.f;
    const int qpos = qpos0 + qr;
    for (; kb >= 0; --kb) {
        const bool cache = SAMPLE && (kb < PAST / 32 - 8);
        const bool inlds = SAMPLE && !cache && (kb < PAST / 32);
        f32x16 s;
        bf16x8 kf[8], vf[8];
        if (inlds) {
            const LAS bf16x8* sl = (const LAS bf16x8*)(slabs + (PAST / 32 - 1 - kb) * 16384) + lane;
#pragma unroll
            for (int ks = 0; ks < 8; ++ks) kf[ks] = sl[ks * 64];
#pragma unroll
            for (int f = 0; f < 8; ++f) vf[f] = sl[512 + f * 64];
        } else if (cache) {
            const int kk = 32 * kb + r32;
            const float* kp = ck + (((size_t)b * PAST + kk) * NH + h) * HD + 8 * hi;
#pragma unroll
            for (int ks = 0; ks < 8; ++ks) { const f32x4 a = *(const f32x4*)(kp + 16 * ks), c = *(const f32x4*)(kp + 16 * ks + 4);
                u32x4 w; w.x = pk2(a.x, a.y); w.y = pk2(a.z, a.w); w.z = pk2(c.x, c.y); w.w = pk2(c.z, c.w); kf[ks] = __builtin_bit_cast(bf16x8, w); }
#pragma unroll
            for (int f = 0; f < 8; ++f) {
                const int k0 = 32 * kb + 16 * (f & 1) + 4 * hi;
                const float* vp = cv + (((size_t)b * PAST + k0) * NH + h) * HD + (f >> 1) * 32 + r32;
                float e[8];
#pragma unroll
                for (int j = 0; j < 8; ++j) e[j] = vp[(size_t)(8 * (j >> 2) + (j & 3)) * (NH * HD)];
                u32x4 w; w.x = pk2(e[0], e[1]); w.y = pk2(e[2], e[3]); w.z = pk2(e[4], e[5]); w.w = pk2(e[6], e[7]); vf[f] = __builtin_bit_cast(bf16x8, w);
            }
        } else {
            const size_t fo = (SAMPLE ? (size_t)(b * NH + h) : ((size_t)(b * NH + h) * (TP / 32) + kb)) * 8 * 512 + lane * 8;
            const bf16* kp = (SAMPLE ? kfs_ : kf_) + fo; const bf16* vp = (SAMPLE ? vfs_ : vf_) + fo;
#pragma unroll
            for (int ks = 0; ks < 8; ++ks) kf[ks] = *(const bf16x8*)(kp + ks * 512);
#pragma unroll
            for (int f = 0; f < 8; ++f) vf[f] = *(const bf16x8*)(vp + f * 512);
        }
        __builtin_amdgcn_sched_barrier(0);
#pragma unroll
        for (int i = 0; i < 16; ++i) s[i] = 0.f;
#pragma unroll
        for (int ks = 0; ks < 8; ++ks) s = MFMA32(kf[ks], qst[ks * 64], s);
        f32x16 Lv; float own[4], oth[4];
#pragma unroll
        for (int i = 0; i < 16; ++i) {
            const float z = s[i];
            const int kpos = 32 * kb + (i & 3) + 8 * (i >> 2) + 4 * hi;
            const float sp = softplus_f(z);
            Lv[i] = (kpos < qpos) ? -sp : 0.f;
            s[i] = z - sp;
        }
#pragma unroll
        for (int g = 0; g < 4; ++g) { own[g] = (Lv[4 * g] + Lv[4 * g + 1]) + (Lv[4 * g + 2] + Lv[4 * g + 3]); oth[g] = __shfl_xor(own[g], 32); }
        float run = 0.f, after[4];
#pragma unroll
        for (int g = 3; g >= 0; --g) { after[g] = run + (hi == 0 ? oth[g] : 0.f); run += own[g] + oth[g]; }
        bf16x8 pa[2];
        {
            float w[16];
#pragma unroll
            for (int g = 0; g < 4; ++g) {
                float sfx = carry + after[g];
#pragma unroll
                for (int e = 3; e >= 0; --e) {
                    const int i = 4 * g + e;
                    const int kpos = 32 * kb + (i & 3) + 8 * (i >> 2) + 4 * hi;
                    w[i] = (kpos < qpos) ? __expf(s[i] + sfx) : 0.f;
                    sfx += Lv[i];
                }
            }
#pragma unroll
            for (int st = 0; st < 2; ++st) { u32x4 pw; pw.x = pk2(w[8 * st], w[8 * st + 1]); pw.y = pk2(w[8 * st + 2], w[8 * st + 3]); pw.z = pk2(w[8 * st + 4], w[8 * st + 5]); pw.w = pk2(w[8 * st + 6], w[8 * st + 7]);
                pa[st] = __builtin_bit_cast(bf16x8, pw); }
        }
        carry += run;
#pragma unroll
        for (int db = 0; db < 4; ++db)
#pragma unroll
            for (int st = 0; st < 2; ++st) o[db] = MFMA32(vf[db * 2 + st], pa[st], o[db]);
        if (__all(carry < -104.0f)) break;
    }
    if (r32 < nq) {
        bf16* op = YA + (size_t)(qrow0 + r32) * D + h * HD + 4 * hi;
#pragma unroll
        for (int db = 0; db < 4; ++db)
#pragma unroll
            for (int g = 0; g < 4; ++g) { u32x2 w; w.x = pk2(o[db][4 * g], o[db][4 * g + 1]); w.y = pk2(o[db][4 * g + 2], o[db][4 * g + 3]); *(u32x2*)(op + db * 32 + 8 * g) = w; }
    }
}

#define MFMA16(a, b, c) __builtin_amdgcn_mfma_f32_16x16x32_bf16((a), (b), (c), 0, 0, 0)
constexpr int XCS = 72;
template <int NB>
__device__ __forceinline__ void scan16(f32x4 (&A)[NB], f32x4 (&B)[NB], int fr) {
#pragma unroll
    for (int sft = 1; sft < 16; sft <<= 1) {
#pragma unroll
        for (int nb = 0; nb < NB; ++nb)
#pragma unroll
            for (int i = 0; i < 4; ++i) {
                const float ap = __shfl_up(A[nb][i], sft, 16), bp = __shfl_up(B[nb][i], sft, 16);
                if (fr >= sft) { B[nb][i] = A[nb][i] * bp + B[nb][i]; A[nb][i] = A[nb][i] * ap; }
            }
    }
}
template <bool FINAL, bool sample>
__device__ __forceinline__ void lru_unit(const Params& p, int b, int j0, int n, LAS unsigned char* wl, int lane) {
    constexpr int NCH = sample ? 1 : 2;
    const int fr = lane & 15, fq = lane >> 4;
    const int ntok = sample ? TS : 64, nmb = sample ? 1 : 4;
    LAS bf16* xcs = (LAS bf16*)wl;
    const int c = n * 64 + lane;
    f32x4 Hc[4], Pc[4];
    LAS float* cst = (LAS float*)(wl + 9648); LAS u32x2* gst = (LAS u32x2*)(wl + 10416) + lane; (void)gst;
    cst[lane] = C8T[c]; cst[64 + lane] = p.in[12][c]; cst[128 + lane] = p.in[14][c];
#pragma unroll
    for (int nb = 0; nb < 4; ++nb) {
        const int d0 = n * 64 + 16 * nb + 4 * fq;
        Hc[nb] = (f32x4){0.f, 0.f, 0.f, 0.f}; Pc[nb] = (f32x4){1.f, 1.f, 1.f, 1.f};
        if (FINAL && sample) Hc[nb] = *(const f32x4*)(p.in[5] + (size_t)b * D + d0);
    }
    const float* cw = p.in[9]; const float w0 = cw[c], w1 = cw[D + c], w2 = cw[2 * D + c], w3 = cw[3 * D + c], cbias = p.in[10][c];
    if (FINAL && !sample) {
        const float* sp = SUMP + (size_t)b * NCHUNK * D + n * 64 + 4 * fq; const float* sh = SUMH + (size_t)b * NCHUNK * D + n * 64 + 4 * fq;
#pragma unroll 1
        for (int g = 0; g < j0; g += 16) {
            const int jj = g + fr; f32x4 A[4], B[4];
#pragma unroll
            for (int nb = 0; nb < 4; ++nb) { A[nb] = (f32x4){1.f, 1.f, 1.f, 1.f}; B[nb] = (f32x4){0.f, 0.f, 0.f, 0.f};
                if (jj < j0) { A[nb] = *(const f32x4*)(sp + (size_t)jj * D + 16 * nb); B[nb] = *(const f32x4*)(sh + (size_t)jj * D + 16 * nb); } }
            scan16<4>(A, B, fr);
#pragma unroll
            for (int nb = 0; nb < 4; ++nb)
#pragma unroll
                for (int i = 0; i < 4; ++i) { const float pt = __shfl(A[nb][i], 15, 16), ht = __shfl(B[nb][i], 15, 16); Hc[nb][i] = pt * Hc[nb][i] + ht; }
        }
    }
    bf16x8 wa[4][2], wx[4][2];
#pragma unroll
    for (int nb = 0; nb < 4; ++nb)
#pragma unroll
        for (int k = 0; k < 2; ++k) { const size_t off = (size_t)(n * 64 + 16 * nb + fr) * 64 + 8 * fq + 32 * k; wa[nb][k] = *(const bf16x8*)(WAT + off); wx[nb][k] = *(const bf16x8*)(WXT + off); }
#pragma unroll 1
    for (int jc = 0; jc < NCH; ++jc) {
        const int j = j0 + jc;
        const int row0 = sample ? MPR + b * TS : b * TP + j * 64;
        if (FINAL) {
            u32x2 gtmp[16];
#pragma unroll
            for (int q = 0; q < 16; ++q) gtmp[q] = ((q >> 2) < nmb) ? *(const u32x2*)(GG + (size_t)(row0 + 16 * (q >> 2) + fr) * D + n * 64 + 16 * (q & 3) + 4 * fq) : (u32x2){0u, 0u};
#pragma unroll
            for (int q = 0; q < 16; ++q) gst[q * 64] = gtmp[q];
        }
        {
            const int rr = lane >> 3, cc = (lane & 7) * 8;
            u32x4 stg[9];
#pragma unroll
            for (int i = 0; i < 9; ++i) {
                const int tr = 8 * i + rr - 3;
                stg[i] = (u32x4){0u, 0u, 0u, 0u};
                if (tr < ntok) {
                    if (tr >= 0 || (!sample && j > 0)) stg[i] = *(const u32x4*)(XR + (size_t)(row0 + tr) * D + n * 64 + cc);
                    else if (sample) { float hv[8]; ld8f(p.in[4] + ((size_t)b * 3 + (tr + 3)) * D + n * 64 + cc, hv); stg[i] = pack8(hv); }
                }
            }
#pragma unroll
            for (int i = 0; i < 9; ++i) { const int tr = 8 * i + rr - 3; if (tr < ntok) *(LAS u32x4*)(xcs + (tr + 3) * XCS + cc) = stg[i]; }
            asm volatile("s_waitcnt lgkmcnt(0)" ::: "memory");
            float x3 = bf2f(xcs[0 * XCS + lane]), x2 = bf2f(xcs[1 * XCS + lane]), x1 = bf2f(xcs[2 * XCS + lane]);
#pragma unroll 8
            for (int t = 0; t < ntok; ++t) {
                const float x0 = bf2f(xcs[(t + 3) * XCS + lane]);
                const float y = w0 * x3 + w1 * x2 + w2 * x1 + w3 * x0 + cbias;
                xcs[t * XCS + lane] = (bf16)(pk2(y, 0.f) & 0xffffu);
                x3 = x2; x2 = x1; x1 = x0;
            }
            if (FINAL && (sample || j == NCHUNK - 1)) {
                float* o = p.out + (sample ? O_RCS + (size_t)b * 3 * D : O_RCP + (size_t)b * 3 * D) + c;
                o[0] = x3; o[D] = x2; o[2 * D] = x1;
            }
        }
        asm volatile("s_waitcnt lgkmcnt(0)" ::: "memory");
        if (!FINAL) {
#pragma unroll
            for (int nb = 0; nb < 4; ++nb) { Hc[nb] = (f32x4){0.f, 0.f, 0.f, 0.f}; Pc[nb] = (f32x4){1.f, 1.f, 1.f, 1.f}; }
        }
#pragma unroll 1
        for (int mb = 0; mb < 4; ++mb) {
            if (mb < nmb) {
                const LAS bf16* xrow = xcs + (16 * mb + fr) * XCS;
                const bf16x8 xf0 = *(const LAS bf16x8*)(xrow + 8 * fq), xf1 = *(const LAS bf16x8*)(xrow + 8 * fq + 32);
#pragma unroll
                for (int hf = 0; hf < 2; ++hf) {
                    f32x4 A[2], B[2];
#pragma unroll
                    for (int q = 0; q < 2; ++q) {
                        const int nb = 2 * hf + q;
                        f32x4 aa = (f32x4){0.f, 0.f, 0.f, 0.f}, ax = aa;
                        aa = MFMA16(wa[nb][0], xf0, aa); aa = MFMA16(wa[nb][1], xf1, aa);
                        ax = MFMA16(wx[nb][0], xf0, ax); ax = MFMA16(wx[nb][1], xf1, ax);
                        const u32x2 xw = *(const LAS u32x2*)(xrow + 16 * nb + 4 * fq);
                        const f32x4 c8v = *(const LAS f32x4*)(cst + 16 * nb + 4 * fq), bav = *(const LAS f32x4*)(cst + 64 + 16 * nb + 4 * fq), bxv = *(const LAS f32x4*)(cst + 128 + 16 * nb + 4 * fq);
                        const float xc[4] = {bflo(xw.x), bfhi(xw.x), bflo(xw.y), bfhi(xw.y)};
#pragma unroll
                        for (int i = 0; i < 4; ++i) {
                            const float ra = sigmoid_f(aa[i] + bav[i]), ri = sigmoid_f(ax[i] + bxv[i]);
                            const float a = __expf(c8v[i] * ra);
                            A[q][i] = a; B[q][i] = __builtin_amdgcn_sqrtf(fmaxf(1.f - a * a, 0.f)) * (ri * xc[i]);
                        }
                    }
                    scan16<2>(A, B, fr);
#pragma unroll
                    for (int q = 0; q < 2; ++q) {
                        const int nb = 2 * hf + q;
                        f32x4 hv = B[q] + A[q] * Hc[nb], pv = A[q] * Pc[nb];
                        if (!FINAL) {
                            const size_t off = (size_t)(row0 + 16 * mb + fr) * D + n * 64 + 16 * nb + 4 * fq;
                            u32x2 hw; hw.x = pk2(hv.x, hv.y); hw.y = pk2(hv.z, hv.w); *(u32x2*)(HLB + off) = hw;
                            u32x2 pw; pw.x = pk2(pv.x, pv.y); pw.y = pk2(pv.z, pv.w); *(u32x2*)(PCB + off) = pw;
                        }
                        if (FINAL) {
                            const u32x2 gw = gst[(mb * 4 + nb) * 64];
                            u32x2 yw; yw.x = pk2(hv.x * bflo(gw.x), hv.y * bfhi(gw.x)); yw.y = pk2(hv.z * bflo(gw.y), hv.w * bfhi(gw.y));
                            *(u32x2*)(GG + (size_t)(row0 + 16 * mb + fr) * D + n * 64 + 16 * nb + 4 * fq) = yw;
                        }
#pragma unroll
                        for (int i = 0; i < 4; ++i) { Hc[nb][i] = __shfl(hv[i], 15, 16); Pc[nb][i] = __shfl(pv[i], 15, 16); }
                    }
                }
            }
        }
        if (fr == 0) {
#pragma unroll
            for (int nb = 0; nb < 4; ++nb) {
                const int d0 = n * 64 + 16 * nb + 4 * fq;
                if (!FINAL) { const size_t so = ((size_t)b * NCHUNK + j) * D + d0; *(f32x4*)(SUMP + so) = Pc[nb]; *(f32x4*)(SUMH + so) = Hc[nb]; }
                else if (sample || j == NCHUNK - 1) *(f32x4*)(p.out + (sample ? O_HS + (size_t)b * D : O_HP + (size_t)b * D) + d0) = Hc[nb];
            }
        }
        asm volatile("s_waitcnt lgkmcnt(0)" ::: "memory");
    }
}


__device__ __forceinline__ void lru_final_light(const Params& p, int b, int j0, int n, int lane) {
    const int fr = lane & 15, fq = lane >> 4;
    f32x4 Hc[4];
#pragma unroll
    for (int nb = 0; nb < 4; ++nb) Hc[nb] = (f32x4){0.f, 0.f, 0.f, 0.f};
    const float* sp = SUMP + (size_t)b * NCHUNK * D + n * 64 + 4 * fq; const float* sh = SUMH + (size_t)b * NCHUNK * D + n * 64 + 4 * fq;
#pragma unroll 1
    for (int g = 0; g < j0; g += 16) {
        const int jj = g + fr; f32x4 A[4], B[4];
#pragma unroll
        for (int nb = 0; nb < 4; ++nb) { A[nb] = (f32x4){1.f, 1.f, 1.f, 1.f}; B[nb] = (f32x4){0.f, 0.f, 0.f, 0.f};
            if (jj < j0) { A[nb] = *(const f32x4*)(sp + (size_t)jj * D + 16 * nb); B[nb] = *(const f32x4*)(sh + (size_t)jj * D + 16 * nb); } }
        scan16<4>(A, B, fr);
#pragma unroll
        for (int nb = 0; nb < 4; ++nb)
#pragma unroll
            for (int i = 0; i < 4; ++i) { const float pt = __shfl(A[nb][i], 15, 16), ht = __shfl(B[nb][i], 15, 16); Hc[nb][i] = pt * Hc[nb][i] + ht; }
    }
#pragma unroll 1
    for (int jc = 0; jc < 2; ++jc) {
        const int j = j0 + jc, row0 = b * TP + j * 64;
        u32x2 hl[4][4], pc[4][4], gg[4][4];
#pragma unroll
        for (int mb = 0; mb < 4; ++mb)
#pragma unroll
            for (int nb = 0; nb < 4; ++nb) { const size_t off = (size_t)(row0 + 16 * mb + fr) * D + n * 64 + 16 * nb + 4 * fq; hl[mb][nb] = *(const u32x2*)(HLB + off); pc[mb][nb] = *(const u32x2*)(PCB + off); gg[mb][nb] = *(const u32x2*)(GG + off); }
        f32x4 pe[4], he[4];
#pragma unroll
        for (int nb = 0; nb < 4; ++nb) { const size_t so = ((size_t)b * NCHUNK + j) * D + n * 64 + 16 * nb + 4 * fq; pe[nb] = *(const f32x4*)(SUMP + so); he[nb] = *(const f32x4*)(SUMH + so); }
#pragma unroll
        for (int mb = 0; mb < 4; ++mb)
#pragma unroll
            for (int nb = 0; nb < 4; ++nb) {
                const u32x2 a = hl[mb][nb], c = pc[mb][nb], g = gg[mb][nb];
                const float h0 = bflo(a.x) + bflo(c.x) * Hc[nb].x, h1 = bfhi(a.x) + bfhi(c.x) * Hc[nb].y, h2 = bflo(a.y) + bflo(c.y) * Hc[nb].z, h3 = bfhi(a.y) + bfhi(c.y) * Hc[nb].w;
                u32x2 yw; yw.x = pk2(h0 * bflo(g.x), h1 * bfhi(g.x)); yw.y = pk2(h2 * bflo(g.y), h3 * bfhi(g.y));
                *(u32x2*)(GG + (size_t)(row0 + 16 * mb + fr) * D + n * 64 + 16 * nb + 4 * fq) = yw;
            }
#pragma unroll
        for (int nb = 0; nb < 4; ++nb) Hc[nb] = pe[nb] * Hc[nb] + he[nb];
        if (j == NCHUNK - 1) {
            if (fr == 0) {
#pragma unroll
                for (int nb = 0; nb < 4; ++nb) *(f32x4*)(p.out + O_HP + (size_t)b * D + n * 64 + 16 * nb + 4 * fq) = Hc[nb];
            }
            const int c = n * 64 + lane;
#pragma unroll
            for (int i = 0; i < 3; ++i) p.out[O_RCP + ((size_t)b * 3 + i) * D + c] = bf2f(XR[(size_t)(b * TP + TP - 3 + i) * D + c]);
        }
    }
}

constexpr int RSTR = 132;
template <int K>
__device__ __forceinline__ void sgemm_tile(const bf16* A, const bf16* Bt, LAS float* red, int tid, float (&v)[8]) {
    const int lane = tid & 63, w = __builtin_amdgcn_readfirstlane(tid >> 6), fr = lane & 15, fq = lane >> 4;
    constexpr int KW = K / 8, NKS = KW / 32;
    f32x4 acc[2][8];
#pragma unroll
    for (int mb = 0; mb < 2; ++mb)
#pragma unroll
        for (int nb = 0; nb < 8; ++nb) acc[mb][nb] = (f32x4){0.f, 0.f, 0.f, 0.f};
    const bf16* ap = A + (size_t)fr * K + w * KW + 8 * fq;
    const bf16* bp = Bt + (size_t)fr * K + w * KW + 8 * fq;
#pragma unroll 4
    for (int ks = 0; ks < NKS; ++ks) {
        bf16x8 af[2], bb[8];
#pragma unroll
        for (int mb = 0; mb < 2; ++mb) af[mb] = *(const bf16x8*)(ap + (size_t)mb * 16 * K + ks * 32);
#pragma unroll
        for (int nb = 0; nb < 8; ++nb) bb[nb] = *(const bf16x8*)(bp + (size_t)nb * 16 * K + ks * 32);
#pragma unroll
        for (int mb = 0; mb < 2; ++mb)
#pragma unroll
            for (int nb = 0; nb < 8; ++nb) acc[mb][nb] = MFMA16(bb[nb], af[mb], acc[mb][nb]);
    }
    LAS float* slab = red + w * (32 * RSTR);
#pragma unroll
    for (int mb = 0; mb < 2; ++mb)
#pragma unroll
        for (int nb = 0; nb < 8; ++nb) *(LAS f32x4*)(slab + (16 * mb + fr) * RSTR + 16 * nb + 4 * fq) = acc[mb][nb];
    __syncthreads();
    const int row = tid >> 4, c8 = (tid & 15) * 8;
    f32x4 s0 = (f32x4){0.f, 0.f, 0.f, 0.f}, s1 = s0;
#pragma unroll
    for (int sl = 0; sl < 8; ++sl) { const LAS float* q = red + sl * (32 * RSTR) + row * RSTR + c8; s0 += *(const LAS f32x4*)q; s1 += *(const LAS f32x4*)(q + 4); }
    v[0] = s0.x; v[1] = s0.y; v[2] = s0.z; v[3] = s0.w; v[4] = s1.x; v[5] = s1.y; v[6] = s1.z; v[7] = s1.w;
    __syncthreads();
}

#define XB_TMO      128
#define XB_XCNT(j)  (256  + 64 * (j))
#define XB_XSUB(j)  (1280 + 64 * (j))
#define XB_XGEN(j)  (2304 + 64 * (j))
#define XB_TOP      3328
#define XB_TOPGEN   3392
#define XCD_BAR_WORDS 3456
#define XB_SPIN_CAP (1u << 18)

__device__ __forceinline__ unsigned xb_ld(unsigned* p)              { return __hip_atomic_load(p, __ATOMIC_RELAXED, __HIP_MEMORY_SCOPE_AGENT); }
__device__ __forceinline__ unsigned xb_add(unsigned* p, unsigned v) { return __hip_atomic_fetch_add(p, v, __ATOMIC_RELAXED, __HIP_MEMORY_SCOPE_AGENT); }
__device__ __forceinline__ unsigned xb_xcc_id() { return (unsigned)__builtin_amdgcn_s_getreg((3 << 11) | 20) & 0xFu; }
#define XB_SPIN(cond, bar) do { unsigned _sp = 0; while (cond) { __builtin_amdgcn_s_sleep(1); \
    if ((++_sp & 255u) == 0u) { if (xb_ld(&(bar)[XB_TMO])) break; if (_sp > XB_SPIN_CAP) { atomicAdd(&(bar)[XB_TMO], 1u); break; } } } } while (0)

struct XcdBarrier {
    unsigned* bar; unsigned x;
    volatile LAS unsigned* st;
};

__device__ __forceinline__ XcdBarrier xcd_barrier_post(unsigned* bar, volatile LAS unsigned* st) {
    XcdBarrier b; b.bar = bar; b.x = xb_xcc_id(); b.st = st;
    if (threadIdx.x == 0) (void)xb_add(&bar[XB_XCNT(b.x)], 1u);
    return b;
}
__device__ __forceinline__ void xcd_barrier_complete(unsigned* bar, unsigned x, unsigned& nloc, unsigned& nx) {
    const unsigned G = gridDim.x * gridDim.y * gridDim.z;
    unsigned sum, cnt, mine, sp = 0u;
    for (;;) {
        sum = 0u; cnt = 0u; mine = 0u;
#pragma unroll
        for (unsigned j = 0; j < 16; ++j) { const unsigned c = xb_ld(&bar[XB_XCNT(j)]); sum += c; cnt += (c > 0u) ? 1u : 0u; mine = (j == x) ? c : mine; }
        if (sum == G) break;
        __builtin_amdgcn_s_sleep(1);
        if ((++sp & 255u) == 0u) { if (xb_ld(&bar[XB_TMO])) break; if (sp > XB_SPIN_CAP) { atomicAdd(&bar[XB_TMO], 1u); break; } }
    }
    nloc = mine > 0u ? mine : 1u; nx = cnt > 0u ? cnt : 1u;
}

__device__ __forceinline__ void xcd_barrier(const XcdBarrier& b) {
    asm volatile("s_waitcnt vmcnt(0)" ::: "memory");
    __syncthreads();
    if (threadIdx.x == 0) {
        unsigned* bar = b.bar;
        __builtin_amdgcn_s_waitcnt(0);
        unsigned nloc = b.st[0], nx = b.st[1];
        if (nloc == 0u) { xcd_barrier_complete(bar, b.x, nloc, nx); b.st[0] = nloc; b.st[1] = nx; }
        const unsigned old = xb_add(&bar[XB_XSUB(b.x)], 1u);
        const unsigned gen = old / nloc;
        if (old + 1u == (gen + 1u) * nloc) {
            __builtin_amdgcn_fence(__ATOMIC_RELEASE, "agent");
            asm volatile("s_waitcnt vmcnt(0)" ::: "memory");
            const unsigned og = xb_add(&bar[XB_TOP], 1u);
            const unsigned tg = og / nx;
            if (og + 1u == (tg + 1u) * nx) xb_add(&bar[XB_TOPGEN], 1u);
            else XB_SPIN(xb_ld(&bar[XB_TOPGEN]) == tg, bar);
            __builtin_amdgcn_fence(__ATOMIC_ACQUIRE, "agent");
            xb_add(&bar[XB_XGEN(b.x)], 1u);
            asm volatile("s_waitcnt vmcnt(0)" ::: "memory");
        } else {
            XB_SPIN(xb_ld(&bar[XB_XGEN(b.x)]) == gen, bar);
            __builtin_amdgcn_fence(__ATOMIC_ACQUIRE, "agent");
            asm volatile("s_waitcnt vmcnt(0)" ::: "memory");
        }
    }
    __syncthreads();
}

__global__ void __launch_bounds__(512, 2) hawk_fwd(Params p) {
    extern __shared__ __attribute__((aligned(16))) unsigned char lds_raw[];
    cg::grid_group grid = cg::this_grid();
    LAS unsigned char* lds = (LAS unsigned char*)lds_raw;
    const int G = gridDim.x, NGW = G * 8;
    { volatile LAS unsigned* xb_st0 = (volatile LAS unsigned*)(lds + (LDS_BYTES - 16)); if (threadIdx.x < 4) xb_st0[threadIdx.x] = 0u; }
    __syncthreads();
    volatile LAS unsigned* xb_st = (volatile LAS unsigned*)(lds + (LDS_BYTES - 16));
    (void)xcd_barrier_post((unsigned*)(p.ws + WS_CTL + 69632), xb_st);
    if (p.ws == nullptr) grid.sync();
#define XBAR() do { XcdBarrier xb_; xb_.bar = (unsigned*)(p.ws + WS_CTL + 69632); xb_.x = xb_xcc_id(); xb_.st = (volatile LAS unsigned*)(lds + (LDS_BYTES - 16)); xcd_barrier(xb_); } while (0)
    unsigned long long pr_acc = 0, pr_t = 0; (void)pr_acc; (void)pr_t;
#define PR_BEGIN(k) do { if constexpr ((PROBE_MASK >> (k)) & 1) pr_t = __builtin_amdgcn_s_memrealtime(); } while (0)
#define PR_END(k) do { if constexpr ((PROBE_MASK >> (k)) & 1) pr_acc += __builtin_amdgcn_s_memrealtime() - pr_t; } while (0)
#define PHASE_IDS int tid = threadIdx.x; asm volatile("" : "+v"(tid)); const int lane = tid & 63, wave = __builtin_amdgcn_readfirstlane(tid >> 6), gw = blockIdx.x * 8 + wave; (void)lane; (void)gw;

    PR_BEGIN(0);
    if constexpr ((PH_MASK >> 0) & 1) {
        PHASE_IDS
        LAS float* scr = (LAS float*)(lds + wave * 16384);
        constexpr int I_IN = (D / 64) * (DIN / 32), I_LB = 2;
        constexpr int NITEMS = I_IN + 32 * I_LB;
        for (int it = gw; it < NITEMS; it += NGW) {
            int r = it;
            if (r < I_IN) { p0_transpose_item(p.in[8], D, DIN, WIN, scr, r, lane); continue; } r -= I_IN;
            { const int which = r / (16 * I_LB), rr = r % (16 * I_LB), blk = rr / I_LB, item = rr % I_LB;
              p0_transpose_item((which ? p.in[13] : p.in[11]) + (size_t)blk * 4096, 64, 64, (which ? WXT : WAT) + (size_t)blk * 4096, scr, item, lane); }
        }
        if (blockIdx.x == 0) for (int d = tid; d < D; d += 512) C8T[d] = -8.f * log1pf(expf(-p.in[15][d]));
        for (int m = gw; m < MROWS; m += NGW)
            rms_row(m < MPR ? p.in[0] + (size_t)m * D : p.in[1] + (size_t)(m - MPR) * D, p.in[7], U1 + (size_t)m * D, lane);
    }
    XBAR();
    PR_END(0);

    PR_BEGIN(1);
    if constexpr ((PH_MASK >> 1) & 1) {
        {
            int tid = threadIdx.x; asm volatile("" : "+v"(tid));
            for (int un = blockIdx.x; un < 4 * (DIN / 128); un += G) {
                const int ru = un & 3, n0 = (un >> 2) * 128; float v[8];
                sgemm_tile<D>(U1 + (size_t)(MPR + 32 * ru) * D, WIN + (size_t)n0 * D, (LAS float*)lds, tid, v);
                const int r = MPR + 32 * ru + (tid >> 4), seg = n0 >> 10, cin = (tid & 15) * 8, c = (n0 & 1023) + cin;
                if (seg == 2 || seg == 3) {
                    float ss = 0.f;
#pragma unroll
                    for (int e = 0; e < 8; ++e) ss += v[e] * v[e];
                    const float rs = rsqrtf(sum16(ss) * (1.f / HD) + EPS);
                    float gn[8]; ld8f((seg == 2 ? p.in[16] : p.in[17]) + cin, gn);
#pragma unroll
                    for (int e = 0; e < 8; ++e) v[e] = v[e] * rs * gn[e];
                    if (seg == 3) { st8f(p.out + O_KS + (size_t)(r - MPR) * D + c, v); const int sb = (r - MPR) >> 4, t = (r - MPR) & 15, hh = (n0 & 1023) >> 7;
                        *(u32x4*)(KFs + (((size_t)(sb * NH + hh) * 8 + (cin >> 4)) * 512 + (t + 32 * ((cin >> 3) & 1)) * 8)) = pack8(v); }
                    else {
#pragma unroll
                        for (int e = 0; e < 8; ++e) v[e] *= 0.08838834764831845f;
                        *(u32x4*)(QN + (size_t)r * D + c) = pack8(v); }
                } else if (seg == 4) {
                    st8f(p.out + O_VS + (size_t)(r - MPR) * D + c, v);
                    const int sb = (r - MPR) >> 4, t = (r - MPR) & 15, hh = (n0 & 1023) >> 7;
                    bf16* vt = VFs + (((size_t)(sb * NH + hh) * 4 + (cin >> 5)) * 2 + 0) * 512 + ((cin & 31) + 32 * ((t >> 2) & 1)) * 8 + 4 * (t >> 3) + (t & 3); const u32x4 w = pack8(v);
                    vt[0] = (bf16)w.x; vt[8] = (bf16)(w.x >> 16); vt[16] = (bf16)w.y; vt[24] = (bf16)(w.y >> 16); vt[32] = (bf16)w.z; vt[40] = (bf16)(w.z >> 16); vt[48] = (bf16)w.w; vt[56] = (bf16)(w.w >> 16);
                } else {
                    if (seg == 1) {
#pragma unroll
                        for (int e = 0; e < 8; ++e) v[e] = gelu_f(v[e]);
                    } else if (seg >= 5) {
#pragma unroll
                        for (int e = 0; e < 8; ++e) v[e] = sigmoid_f(v[e]);
                    }
                    bf16* dst = (seg == 0) ? XR : (seg == 1) ? GG : (seg == 5) ? SG1 : SG2;
                    *(u32x4*)(dst + (size_t)r * D + c) = pack8(v);
                }
            }
        }
        pg8::Gemm g{U1, WIN, MPR, DIN, D}; pg8::StaticOrder S; S.init(MPR, DIN, G, (int)blockIdx.x);
        EpiIn E{XR, GG, QN, KF, VF, SG1, SG2, p.out, p.in[16], p.in[17], (LAS float*)(lds + LDS_SCR)};
        pg8::gemm_phase<EpiIn, pg8::StaticOrder, true, true>(lds, g, S, E);
    }
    XBAR();
    PR_END(1);

    PR_BEGIN(2);
    if constexpr ((PH_MASK >> 2) & 1) {
        PHASE_IDS
        constexpr int NA_P = BP * NH * (TP / 32), NA_S = BS * NH, NL = BP * (NCHUNK / 2) * 16;
        for (int su = blockIdx.x; su < NA_S; su += G) {
            const int b = su / NH, h = su % NH, r32 = lane & 31, hi = lane >> 5, kb = PAST / 32 - 1 - wave;
            LAS bf16x8* sl = (LAS bf16x8*)(lds + wave * 16384) + lane;
            const float* kp = p.in[2] + (((size_t)b * PAST + 32 * kb + r32) * NH + h) * HD + 8 * hi;
#pragma unroll
            for (int ks = 0; ks < 8; ++ks) { const f32x4 a = *(const f32x4*)(kp + 16 * ks), c = *(const f32x4*)(kp + 16 * ks + 4);
                u32x4 w; w.x = pk2(a.x, a.y); w.y = pk2(a.z, a.w); w.z = pk2(c.x, c.y); w.w = pk2(c.z, c.w); sl[ks * 64] = __builtin_bit_cast(bf16x8, w); }
#pragma unroll
            for (int f = 0; f < 8; ++f) {
                const int k0 = 32 * kb + 16 * (f & 1) + 4 * hi;
                const float* vp = p.in[3] + (((size_t)b * PAST + k0) * NH + h) * HD + (f >> 1) * 32 + r32;
                float e[8];
#pragma unroll
                for (int j = 0; j < 8; ++j) e[j] = vp[(size_t)(8 * (j >> 2) + (j & 3)) * (NH * HD)];
                u32x4 w; w.x = pk2(e[0], e[1]); w.y = pk2(e[2], e[3]); w.z = pk2(e[4], e[5]); w.w = pk2(e[6], e[7]); sl[512 + f * 64] = __builtin_bit_cast(bf16x8, w);
            }
            __syncthreads();
            if (wave == 0) { PR_BEGIN(9); attn_unit<true>(QN, KF, VF, KFs, VFs, p.in[2], p.in[3], QN, b, h, 0, lds + LDS_SCR, lds, lane); PR_END(9); }
            __syncthreads();
        }
        for (int it = gw; it < NA_P; it += NGW) {
            const int grp = it >> 3, bh = grp & (BP * NH - 1), qb = (TP / 32 - 1) - ((grp / (BP * NH)) * 8 + (it & 7)); attn_unit<false>(QN, KF, VF, KFs, VFs, p.in[2], p.in[3], QN, bh / NH, bh % NH, qb, lds + wave * WLDS, lds, lane); }
        PR_BEGIN(10);
        for (int r = gw; r < NL; r += NGW) lru_unit<false, false>(p, r / ((NCHUNK / 2) * 16), 2 * ((r / 16) % (NCHUNK / 2)), r % 16, lds + wave * WLDS, lane);
        PR_END(10);
    }
    XBAR();
    PR_END(2);

    PR_BEGIN(3);
    if constexpr ((PH_MASK >> 3) & 1) {
        PHASE_IDS
        constexpr int NL = BP * (NCHUNK / 2) * 16, NLS = BS * 16;
        if (NGW == 2048) {
            const int q = (gw >> 4) & 31;
            if (q >= 30) { const int r = (q - 30) * 64 + (gw >> 9) * 16 + (gw & 15); lru_unit<true, true>(p, r / 16, 0, r % 16, lds + wave * WLDS, lane); }
            lru_final_light(p, gw / ((NCHUNK / 2) * 16), 2 * ((NCHUNK / 2 - 1) - q), gw % 16, lane);
        } else {
            for (int it = gw; it < NL + NLS; it += NGW) {
                if (it < NL) lru_final_light(p, it / ((NCHUNK / 2) * 16), 2 * ((NCHUNK / 2 - 1) - ((it / 16) % (NCHUNK / 2))), it % 16, lane);
                else { const int r = it - NL; lru_unit<true, true>(p, r / 16, 0, r % 16, lds + wave * WLDS, lane); }
            }
        }
        {
            LAS float* scr = (LAS float*)(lds + wave * WLDS);
            constexpr int I_SQ = (D / 64) * (D / 32), I_UP = (D / 64) * (2 * DFF / 32), I_DN = (DFF / 64) * (D / 32);
            for (int it = gw; it < 3 * I_SQ + I_UP + I_DN; it += NGW) {
                int r = it;
                if (r < I_SQ) { p0_transpose_item(p.in[18], D, D, WPR, scr, r, lane); continue; } r -= I_SQ;
                if (r < I_SQ) { p0_transpose_item(p.in[19], D, D, WPA, scr, r, lane); continue; } r -= I_SQ;
                if (r < I_SQ) { p0_transpose_item(p.in[20], D, D, WOUT, scr, r, lane); continue; } r -= I_SQ;
                if (r < I_UP) { p0_transpose_item(p.in[22], D, 2 * DFF, WUP, scr, r, lane); continue; } r -= I_UP;
                p0_transpose_item(p.in[25], DFF, D, WDN, scr, r, lane);
            }
        }
    }
    XBAR();
    PR_END(3);

    PR_BEGIN(4);
    if constexpr ((PH_MASK >> 4) & 1) {
        {
            int tid = threadIdx.x; asm volatile("" : "+v"(tid));
            for (int un = blockIdx.x; un < 4 * (D / 128); un += G) {
                const int ru = un & 3, n0 = (un >> 2) * 128; float a[8], b2[8];
                sgemm_tile<D>(GG + (size_t)(MPR + 32 * ru) * D, WPR + (size_t)n0 * D, (LAS float*)lds, tid, a);
                sgemm_tile<D>(QN + (size_t)(MPR + 32 * ru) * D, WPA + (size_t)n0 * D, (LAS float*)lds, tid, b2);
                const size_t off = (size_t)(MPR + 32 * ru + (tid >> 4)) * D + n0 + (tid & 15) * 8;
                float g1[8], g2[8]; unpack8(*(const u32x4*)(SG1 + off), g1); unpack8(*(const u32x4*)(SG2 + off), g2);
#pragma unroll
                for (int e = 0; e < 8; ++e) a[e] = a[e] * g1[e] + b2[e] * g2[e];
                *(u32x4*)(MG + off) = pack8(a);
            }
        }
        static_assert(WS_S1 - WS_S0 == (size_t)(MP / 256) * 256 * D * 2 && WS_WPA - WS_WPR == (size_t)4 * 256 * D * 2, "operand adjacency the paired units rely on");
        PairOrder S; S.base.init(MPR, D, G, (int)blockIdx.x);
        pg8::Gemm g{GG, WPR, MPR, D, D}; EpiP4 E{EpiT1{SG1, T1}, EpiMG{SG2, T1, MG}};
        pg8::gemm_phase<EpiP4, PairOrder, true, true>(lds, g, S, E);
    }
    XBAR();
    PR_END(4);

    PR_BEGIN(5);
    if constexpr ((PH_MASK >> 5) & 1) {
        {
            int tid = threadIdx.x; asm volatile("" : "+v"(tid));
            for (int un = blockIdx.x; un < 4 * (D / 128); un += G) {
                const int ru = un & 3, n0 = (un >> 2) * 128; float v[8], xv[8], lv[8];
                sgemm_tile<D>(MG + (size_t)(MPR + 32 * ru) * D, WOUT + (size_t)n0 * D, (LAS float*)lds, tid, v);
                const int r = MPR + 32 * ru + (tid >> 4), col = n0 + (tid & 15) * 8;
                ld8f(p.in[1] + (size_t)(r - MPR) * D + col, xv); ld8f(p.in[21] + col, lv);
                float ss = 0.f;
#pragma unroll
                for (int e = 0; e < 8; ++e) { v[e] += xv[e]; ss += v[e] * v[e]; }
                st8f(p.out + (size_t)r * D + col, v);
#pragma unroll
                for (int e = 0; e < 8; ++e) v[e] *= lv[e];
                *(u32x4*)(U2 + (size_t)r * D + col) = pack8(v);
                ss = sum16(ss);
                if ((tid & 15) == 0) atomicAdd(SS2 + r, ss);
            }
        }
        pg8::Gemm g{MG, WOUT, MPR, D, D}; pg8::StaticOrder S; S.init(MPR, D, G, (int)blockIdx.x);
        EpiX1 E{p.in[0], p.in[1], p.in[21], p.out, U2, SS2};
        pg8::gemm_phase<EpiX1, pg8::StaticOrder, true, true>(lds, g, S, E);
    }
    XBAR();
    PR_END(5);

    PR_BEGIN(6);
    if constexpr ((PH_MASK >> 6) & 1) {
        {
            int tid = threadIdx.x; asm volatile("" : "+v"(tid));
            for (int un = blockIdx.x; un < 4 * (2 * DFF / 128); un += G) {
                const int ru = un & 3, n0 = (un >> 2) * 128; float v[8];
                sgemm_tile<D>(U2 + (size_t)(MPR + 32 * ru) * D, WUP + (size_t)n0 * D, (LAS float*)lds, tid, v);
                const int r = MPR + 32 * ru + (tid >> 4), col = n0 + (tid & 15) * 8;
                const float rs = rsqrtf(SS2[r] * (1.f / D) + EPS);
#pragma unroll
                for (int e = 0; e < 8; ++e) v[e] *= rs;
                bf16* dst = (col < DFF) ? GP + (size_t)r * DFF + col : VAL + (size_t)r * DFF + (col - DFF);
                *(u32x4*)dst = pack8(v);
            }
        }
        pg8::Gemm g{U2, WUP, MPR, 2 * DFF, D}; pg8::StaticOrder S; S.init(MPR, 2 * DFF, G, (int)blockIdx.x);
        EpiUp E{SS2, GP, VAL};
        pg8::gemm_phase<EpiUp, pg8::StaticOrder, true, true>(lds, g, S, E);
    }
    XBAR();
    PR_END(6);

    PR_BEGIN(7);
    if constexpr ((PH_MASK >> 7) & 1) {
        PHASE_IDS
        constexpr int NCC = DFF / 8, NITEMS = (MROWS / 16) * NCC;
        const float* fw = p.in[23]; const float* fb = p.in[24];
        for (int it = blockIdx.x * 512 + tid; it < NITEMS; it += G * 512) {
            const int rg = it / NCC, c0 = (it % NCC) * 8, r0 = rg * 16;
            float gm2[8], gm1[8], w0[8], w1[8], w2[8], bb[8];
#pragma unroll
            for (int e = 0; e < 8; ++e) { w0[e] = fw[c0 + e]; w1[e] = fw[DFF + c0 + e]; w2[e] = fw[2 * DFF + c0 + e]; bb[e] = fb[c0 + e]; gm2[e] = 0.f; gm1[e] = 0.f; }
            const bool smp = r0 >= MPR;
            if (smp) { const float* hs = p.in[6] + (size_t)((r0 - MPR) >> 4) * 2 * DFF + c0;
#pragma unroll
                for (int e = 0; e < 8; ++e) { gm2[e] = hs[e]; gm1[e] = hs[DFF + e]; } }
            else if ((r0 & (TP - 1)) != 0) { unpack8(*(const u32x4*)(GP + (size_t)(r0 - 2) * DFF + c0), gm2); unpack8(*(const u32x4*)(GP + (size_t)(r0 - 1) * DFF + c0), gm1); }
#pragma unroll 4
            for (int k = 0; k < 16; ++k) {
                float g2[8], vv[8]; const size_t off = (size_t)(r0 + k) * DFF + c0;
                unpack8(*(const u32x4*)(GP + off), g2); unpack8(*(const u32x4*)(VAL + off), vv);
                float hm[8];
#pragma unroll
                for (int e = 0; e < 8; ++e) { hm[e] = gelu_f(w0[e] * gm2[e] + w1[e] * gm1[e] + w2[e] * g2[e] + bb[e]) * vv[e]; gm2[e] = gm1[e]; gm1[e] = g2[e]; }
                u32x4 w; w.x = pk2(hm[0], hm[1]); w.y = pk2(hm[2], hm[3]); w.z = pk2(hm[4], hm[5]); w.w = pk2(hm[6], hm[7]);
                *(u32x4*)(VAL + off) = w;
            }
            if (smp || ((r0 + 16) & (TP - 1)) == 0) {
                float* o = p.out + (smp ? O_FCS + (size_t)((r0 - MPR) >> 4) * 2 * DFF : O_FCP + (size_t)(r0 >> 12) * 2 * DFF) + c0;
#pragma unroll
                for (int e = 0; e < 8; ++e) { o[e] = gm2[e]; o[DFF + e] = gm1[e]; }
            }
        }
    }
    XBAR();
    PR_END(7);

    PR_BEGIN(8);
    if constexpr ((PH_MASK >> 8) & 1) {
        {
            int tid = threadIdx.x; asm volatile("" : "+v"(tid));
            for (int un = blockIdx.x; un < 4 * (D / 128); un += G) {
                const int ru = un & 3, n0 = (un >> 2) * 128; float v[8], xv[8];
                sgemm_tile<DFF>(VAL + (size_t)(MPR + 32 * ru) * DFF, WDN + (size_t)n0 * DFF, (LAS float*)lds, tid, v);
                float* o = p.out + (size_t)(MPR + 32 * ru + (tid >> 4)) * D + n0 + (tid & 15) * 8;
                ld8f(o, xv);
#pragma unroll
                for (int e = 0; e < 8; ++e) v[e] += xv[e];
                st8f(o, v);
            }
        }
        pg8::Gemm g{VAL, WDN, MPR, D, DFF}; pg8::StaticOrder S; S.init(MPR, D, G, (int)blockIdx.x);
        EpiDown E{p.out};
        pg8::gemm_phase<EpiDown, pg8::StaticOrder, true, true>(lds, g, S, E);
    }
    PR_END(8);
    if constexpr (PROBE_MASK != 0) { const unsigned long long te = __builtin_amdgcn_s_memrealtime(); while (__builtin_amdgcn_s_memrealtime() - te < PROBE_MULT * pr_acc) __builtin_amdgcn_s_sleep(8); }
}

extern "C" void kernel_launch(void* const* d_in, const int* in_sizes, int n_in, void* d_out, int out_size, void* d_ws, size_t ws_size, hipStream_t stream) {
    static int grid = 0;
    if (grid == 0) {
        if (n_in != 26 || (size_t)out_size != O_END || ws_size < WS_END) { fprintf(stderr, "kernel_launch: unexpected shapes: n_in %d out %d ws %zu (need %zu)\n", n_in, out_size, ws_size, (size_t)WS_END); grid = -1; return; }
        int dev = 0, cus = 0, per_cu = 0;
        hipGetDevice(&dev); hipDeviceGetAttribute(&cus, hipDeviceAttributeMultiprocessorCount, dev);
        if (hipFuncSetAttribute((const void*)hawk_fwd, hipFuncAttributeMaxDynamicSharedMemorySize, LDS_BYTES) != hipSuccess) { fprintf(stderr, "kernel_launch: hipFuncSetAttribute failed\n"); grid = -1; return; }
        if (hipOccupancyMaxActiveBlocksPerMultiprocessor(&per_cu, (const void*)hawk_fwd, 512, LDS_BYTES) != hipSuccess || per_cu < 1) { fprintf(stderr, "kernel_launch: occupancy query gave %d\n", per_cu); (void)hipGetLastError(); per_cu = 1; }
        grid = cus * per_cu;
    }
    if (grid < 0) return;
    (void)hipMemsetAsync((char*)d_ws + WS_CTL, 0, 131072, stream);
    Params prm{};
    for (int i = 0; i < 26; ++i) prm.in[i] = (const float*)d_in[i];
    prm.out = (float*)d_out; prm.ws = (unsigned char*)d_ws;
    void* args[] = {&prm};
    hipError_t e = hipLaunchCooperativeKernel((const void*)hawk_fwd, dim3(grid), dim3(512), args, LDS_BYTES, stream);
    if (e != hipSuccess) fprintf(stderr, "cooperative launch failed: %s (grid %d)\n", hipGetErrorString(e), grid);
}
```

```cpp
#include <hip/hip_runtime.h>
#include <hip/hip_cooperative_groups.h>
#include <cstdio>
#include <cstdint>
#include <cmath>
namespace cg = cooperative_groups;
#ifndef PH_MASK
#define PH_MASK 0x1ff
#endif
#ifndef PROBE_MASK
#define PROBE_MASK 0
#endif
#ifndef PROBE_MULT
#define PROBE_MULT 2
#endif
namespace pg8 {
#define PG8_LAS __attribute__((address_space(3)))
typedef unsigned short bf16_t;
typedef short bf16x8 __attribute__((ext_vector_type(8)));
typedef float f32x4 __attribute__((ext_vector_type(4)));
typedef unsigned u32x4 __attribute__((ext_vector_type(4)));
constexpr int BM = 256, BK = 64, HALF = 128, HTB = HALF * BK * 2  , STAGE_BYTES = 8 * HTB, NXCD = 8, WGM = 8;

__host__ __device__ __forceinline__ int lds_byte(int r, int c) { const int st = (r >> 4) * 2 + (c >> 5), rr = r & 15, cc = c & 31, ob = rr * 64 + cc * 2; return st * 1024 + (ob ^ (((ob >> 9) & 1) << 5)); }
__host__ __device__ __forceinline__ void stage_rc(int b, int& R, int& C) { const int st = b / 1024, sb = b % 1024, swz = sb ^ (((sb >> 9) & 1) << 5); R = (st >> 1) * 16 + swz / 64; C = (st & 1) * 32 + (swz % 64) / 2; }
__host__ __device__ __forceinline__ int perm32(int rho) { const int n = rho >> 4, i = rho & 15; return 8 * (i >> 2) + 4 * n + (i & 3); }

struct Unit { int pm, pn; };
struct Gemm { const bf16_t* A; const bf16_t* Bt; int M, N, K; };

struct StaticOrder {
    int nM, nN, nwg, G, c;
    __host__ __device__ void init(int M, int N, int G_, int c_) { nM = M / BM; nN = N / BM; nwg = nM * nN; G = G_; c = c_; }
    __host__ __device__ bool next(int i, Unit& u) const {
        const long L = (long)i * G + c; if (L >= nwg) return false;
        int wgid = (int)L; { const int q = nwg / NXCD, r = nwg % NXCD, xcd = wgid % NXCD, off = wgid / NXCD; wgid = (xcd < r ? xcd * (q + 1) : r * (q + 1) + (xcd - r) * q) + off; }
        const int nig = WGM * nN, gid = wgid / nig, fm = gid * WGM, gsz = (nM - fm) < WGM ? (nM - fm) : WGM;
        u.pm = fm + ((wgid % nig) % gsz); u.pn = (wgid % nig) / gsz; return true;
    }
    __device__ __forceinline__ void a_ready(const Unit&) const {}
    __device__ __forceinline__ void done(const Unit&) const {}
};

__device__ __forceinline__ unsigned cvt_pk_bf16(float lo, float hi) { unsigned r; asm volatile("v_cvt_pk_bf16_f32 %0, %1, %2" : "=v"(r) : "v"(lo), "v"(hi)); return r; }
typedef float f32x2 __attribute__((ext_vector_type(2)));
__device__ __forceinline__ f32x2 gelu_pk(f32x2 v) {
    const f32x2 av = __builtin_elementwise_abs(v), d = av * 0.2316418882f + 1.0f;
    f32x2 t; t.x = __builtin_amdgcn_rcpf(d.x); t.y = __builtin_amdgcn_rcpf(d.y);
    f32x2 q = t * 0.5307027145f + (-0.7265760135f); q = q * t + 0.7107068705f; q = q * t + (-0.142248368f); q = q * t + 0.127414796f; q = q * t;
    const f32x2 s = (v * v) * (-0.72134752044f);
    f32x2 e; e.x = __builtin_amdgcn_exp2f(s.x); e.y = __builtin_amdgcn_exp2f(s.y);
    const f32x2 m = v * (q * e), r = v - m;
    f32x2 o; o.x = v.x < 0.f ? m.x : r.x; o.y = v.y < 0.f ? m.y : r.y; return o;
}

template <int ACT  > struct EpiBf16 {
    static constexpr bool PERM = true, AFTER_DRAIN = false; static_assert(ACT == 0 || ACT == 1, "EpiBf16: ACT is 0 (none) or 1 (gelu_pk)");
    bf16_t* O; int ldc; const float* bias; int split_cols; size_t split_stride; float scale0;
    __device__ __forceinline__ void operator()(const f32x4 (&acc)[2][2][4][2], const Unit& u, int wr, int wc, int fr, int fq) const {
        const int row0 = u.pm * BM + wr * 64 + fr; int colt = u.pn * BM; bf16_t* base = O;
        float sc = 1.f; if (split_cols) { const int t = colt / split_cols; base += (size_t)t * split_stride; colt -= t * split_cols; if (t == 0) sc = scale0; }
        const int col0 = colt + wc * 32 + 8 * fq, bcol0 = u.pn * BM + wc * 32 + 8 * fq;
        f32x4 bv[2][2];
#pragma unroll
        for (int bj = 0; bj < 2; ++bj)
#pragma unroll
            for (int n = 0; n < 2; ++n) bv[bj][n] = bias ? *(const f32x4*)(bias + bcol0 + bj * HALF + 4 * n) : (f32x4){0.f, 0.f, 0.f, 0.f};
#pragma unroll
        for (int ai = 0; ai < 2; ++ai)
#pragma unroll
            for (int m = 0; m < 4; ++m) { bf16_t* rowp = base + (size_t)(row0 + ai * HALF + m * 16) * ldc + col0;
#pragma unroll
                for (int bj = 0; bj < 2; ++bj) { f32x4 v0 = acc[ai][bj][m][0] + bv[bj][0], v1 = acc[ai][bj][m][1] + bv[bj][1];
                    if (ACT == 1) { f32x2 a = gelu_pk((f32x2){v0[0], v0[1]}), b = gelu_pk((f32x2){v0[2], v0[3]}), c = gelu_pk((f32x2){v1[0], v1[1]}), d = gelu_pk((f32x2){v1[2], v1[3]});
                        v0 = (f32x4){a.x, a.y, b.x, b.y}; v1 = (f32x4){c.x, c.y, d.x, d.y}; }
                    v0 = v0 * sc; v1 = v1 * sc; u32x4 w; w.x = cvt_pk_bf16(v0[0], v0[1]); w.y = cvt_pk_bf16(v0[2], v0[3]); w.z = cvt_pk_bf16(v1[0], v1[1]); w.w = cvt_pk_bf16(v1[2], v1[3]);
                    *(u32x4*)(rowp + bj * HALF) = w; } }
    }
};
template <class Epi, class Sched, bool ALIGN_EPI = false, bool SP2 = false>
__device__ __forceinline__ void gemm_phase(PG8_LAS unsigned char* lds, const Gemm g, const Sched& S, const Epi& E) {
    int tid_l = threadIdx.x; asm volatile("" : "+v"(tid_l));
    const int tid = tid_l, wid = __builtin_amdgcn_readfirstlane(tid >> 6), lane = tid & 63, wr = wid >> 2, wc = wid & 3, fr = lane & 15, fq = lane >> 4;
    const int K = g.K, nt = K / BK;
    unsigned voffA[2], voffB[2];
#pragma unroll
    for (int i = 0; i < 2; ++i) { int R, C; stage_rc(tid * 16 + i * 8192, R, C); const int Rb = Epi::PERM ? ((R & ~31) + perm32(R & 31)) : R;
        voffA[i] = (unsigned)(R * K + C) * 2u; voffB[i] = (unsigned)(Rb * K + C) * 2u; }
    const size_t kstep = (size_t)(BK * 2);
    const size_t hstep = (size_t)HALF * K * 2;
    const size_t tstep = 2 * hstep;
    const unsigned ldsw = (unsigned)wid * 1024u;
    const int aoff = lds_byte(wr * 64 + fr, fq * 8), boff = lds_byte(wc * 32 + fr, fq * 8);
#define PG8_SA(b, h) (((b) * 2 + (h)) * HTB)
#define PG8_SB(b, h) ((4 + (b) * 2 + (h)) * HTB)
#define PG8_STAGE(bufoff, gbase, voff) do { _Pragma("unroll") for (int _i = 0; _i < 2; ++_i) \
        __builtin_amdgcn_global_load_lds((const unsigned*)((const char*)(gbase) + (voff)[_i]), (PG8_LAS unsigned*)(lds + (bufoff) + ldsw + _i * 8192), 16, 0, 0); } while (0)
#define PG8_LDA(dst, b, h) do { _Pragma("unroll") for (int m = 0; m < 4; ++m) _Pragma("unroll") for (int k = 0; k < 2; ++k) dst[m][k] = *(const PG8_LAS bf16x8*)(lds + PG8_SA(b, h) + aoff + m * 2048 + k * 1024); } while (0)
#define PG8_LDB(dst, b, h) do { _Pragma("unroll") for (int n = 0; n < 2; ++n) _Pragma("unroll") for (int k = 0; k < 2; ++k) dst[n][k] = *(const PG8_LAS bf16x8*)(lds + PG8_SB(b, h) + boff + n * 2048 + k * 1024); } while (0)
#define PG8_MMA(ai, bj, At, Bt) do { __builtin_amdgcn_s_setprio(1); _Pragma("unroll") for (int m = 0; m < 4; ++m) _Pragma("unroll") for (int n = 0; n < 2; ++n) _Pragma("unroll") for (int k = 0; k < 2; ++k) \
        acc[ai][bj][m][n] = __builtin_amdgcn_mfma_f32_16x16x32_bf16(Bt[n][k], At[m][k], acc[ai][bj][m][n], 0, 0, 0); __builtin_amdgcn_s_setprio(0); } while (0)
#define PG8_WAIT_V(n) asm volatile("s_waitcnt vmcnt(" #n ")" ::: "memory")
#define PG8_WAIT_L(n) asm volatile("s_waitcnt lgkmcnt(" #n ")" ::: "memory")
#define PG8_BAR __builtin_amdgcn_s_barrier()
#define PG8_SCHED __builtin_amdgcn_sched_barrier(0)
    Unit cur, nxt; int ui = 0;
    if (!S.next(0, cur)) return;
    f32x4 acc[2][2][4][2];
#pragma unroll
    for (int a = 0; a < 2; ++a)
#pragma unroll
        for (int b = 0; b < 2; ++b)
#pragma unroll
            for (int m = 0; m < 4; ++m)
#pragma unroll
                for (int n = 0; n < 2; ++n) acc[a][b][m][n] = (f32x4){0.f, 0.f, 0.f, 0.f};
    bf16x8 At[4][2], B0[2][2], B1[2][2];
    const char* cA = (const char*)g.A + (size_t)cur.pm * tstep; const char* cB = (const char*)g.Bt + (size_t)cur.pn * tstep;
    S.a_ready(cur);
    if constexpr (SP2) {
        PG8_STAGE(PG8_SB(0, 0), cB, voffB); PG8_STAGE(PG8_SB(0, 1), cB + hstep, voffB); PG8_STAGE(PG8_SA(0, 0), cA, voffA); PG8_STAGE(PG8_SA(0, 1), cA + hstep, voffA);
        if (wr == 1) PG8_BAR;
        PG8_WAIT_V(2); PG8_BAR;
        PG8_STAGE(PG8_SB(1, 0), cB + kstep, voffB); PG8_STAGE(PG8_SA(1, 0), cA + kstep, voffA); PG8_STAGE(PG8_SB(1, 1), cB + hstep + kstep, voffB);
        PG8_WAIT_V(6); PG8_BAR;
    } else {
        PG8_STAGE(PG8_SB(0, 0), cB, voffB); PG8_STAGE(PG8_SA(0, 0), cA, voffA); PG8_STAGE(PG8_SB(0, 1), cB + hstep, voffB); PG8_STAGE(PG8_SA(0, 1), cA + hstep, voffA);
        if (wr == 1) PG8_BAR;
        PG8_WAIT_V(4); PG8_BAR;
        PG8_STAGE(PG8_SB(1, 0), cB + kstep, voffB); PG8_STAGE(PG8_SA(1, 0), cA + kstep, voffA); PG8_STAGE(PG8_SB(1, 1), cB + hstep + kstep, voffB);
        PG8_WAIT_V(6); PG8_BAR;
    }
    for (;;) {
        const bool has_next = S.next(ui + 1, nxt);
        const char* nA = has_next ? (const char*)g.A + (size_t)nxt.pm * tstep : cA; const char* nB = has_next ? (const char*)g.Bt + (size_t)nxt.pn * tstep : cB;
        for (int t = 0; t < nt; t += 2) {
            const bool last = (t == nt - 2);
            const char* a1 = cA + (size_t)(t + 1) * kstep;
            const char* a2 = last ? nA : cA + (size_t)(t + 2) * kstep; const char* b2 = last ? nB : cB + (size_t)(t + 2) * kstep;
            const char* a3 = a2 + kstep; const char* b3 = b2 + kstep;
            if (last && has_next) S.a_ready(nxt);
            if constexpr (SP2) {
            PG8_LDB(B0, 0, 0); PG8_LDB(B1, 0, 1); PG8_SCHED; PG8_LDA(At, 0, 0); PG8_STAGE(PG8_SA(1, 1), a1 + hstep, voffA);
            PG8_WAIT_V(8); PG8_WAIT_L(0); PG8_BAR; PG8_MMA(0, 0, At, B0); PG8_MMA(0, 1, At, B1); PG8_BAR; PG8_SCHED;
            PG8_LDA(At, 0, 1); PG8_STAGE(PG8_SB(0, 0), b2, voffB); PG8_STAGE(PG8_SB(0, 1), b2 + hstep, voffB); PG8_STAGE(PG8_SA(0, 0), a2, voffA);
            PG8_WAIT_V(8); PG8_WAIT_L(0); PG8_BAR; PG8_MMA(1, 0, At, B0); PG8_MMA(1, 1, At, B1); PG8_BAR; PG8_SCHED;
            PG8_LDB(B0, 1, 0); PG8_LDB(B1, 1, 1); PG8_SCHED; PG8_LDA(At, 1, 0); PG8_STAGE(PG8_SA(0, 1), a2 + hstep, voffA);
            PG8_WAIT_V(8); PG8_WAIT_L(0); PG8_BAR; PG8_MMA(0, 0, At, B0); PG8_MMA(0, 1, At, B1); PG8_BAR; PG8_SCHED;
            PG8_LDA(At, 1, 1); PG8_STAGE(PG8_SB(1, 0), b3, voffB); PG8_STAGE(PG8_SB(1, 1), b3 + hstep, voffB); PG8_STAGE(PG8_SA(1, 0), a3, voffA);
            PG8_WAIT_V(8); PG8_WAIT_L(0); PG8_BAR; PG8_MMA(1, 0, At, B0); PG8_MMA(1, 1, At, B1); PG8_BAR; PG8_SCHED;
            } else {
            PG8_LDB(B0, 0, 0); PG8_SCHED; PG8_LDA(At, 0, 0); PG8_STAGE(PG8_SA(1, 1), a1 + hstep, voffA);
            PG8_WAIT_L(8); PG8_BAR; PG8_WAIT_L(0); PG8_MMA(0, 0, At, B0); PG8_BAR; PG8_SCHED;
            PG8_LDB(B1, 0, 1); PG8_STAGE(PG8_SB(0, 0), b2, voffB);
            PG8_BAR; PG8_WAIT_L(0); PG8_MMA(0, 1, At, B1); PG8_BAR;
            PG8_LDA(At, 0, 1); PG8_STAGE(PG8_SA(0, 0), a2, voffA);
            PG8_BAR; PG8_WAIT_L(0); PG8_MMA(1, 0, At, B0); PG8_BAR; PG8_SCHED;
            PG8_STAGE(PG8_SB(0, 1), b2 + hstep, voffB);
            PG8_WAIT_V(6); PG8_BAR; PG8_MMA(1, 1, At, B1); PG8_BAR;
            PG8_LDB(B0, 1, 0); PG8_SCHED; PG8_LDA(At, 1, 0); PG8_STAGE(PG8_SA(0, 1), a2 + hstep, voffA);
            PG8_WAIT_L(8); PG8_BAR; PG8_WAIT_L(0); PG8_MMA(0, 0, At, B0); PG8_BAR; PG8_SCHED;
            PG8_LDB(B1, 1, 1); PG8_STAGE(PG8_SB(1, 0), b3, voffB);
            PG8_BAR; PG8_WAIT_L(0); PG8_MMA(0, 1, At, B1); PG8_BAR;
            PG8_LDA(At, 1, 1); PG8_STAGE(PG8_SA(1, 0), a3, voffA);
            PG8_BAR; PG8_WAIT_L(0); PG8_MMA(1, 0, At, B0); PG8_BAR; PG8_SCHED;
            PG8_STAGE(PG8_SB(1, 1), b3 + hstep, voffB);
            PG8_WAIT_V(6); PG8_BAR; PG8_MMA(1, 1, At, B1); PG8_BAR;
            }
        }
        if constexpr (ALIGN_EPI) { if (wr == 0) PG8_BAR; }
        if constexpr (!Epi::AFTER_DRAIN) { E(acc, cur, wr, wc, fr, fq); S.done(cur); }
        if (!has_next) break;
#pragma unroll
        for (int a = 0; a < 2; ++a)
#pragma unroll
            for (int b = 0; b < 2; ++b)
#pragma unroll
                for (int m = 0; m < 4; ++m)
#pragma unroll
                    for (int n = 0; n < 2; ++n) acc[a][b][m][n] = (f32x4){0.f, 0.f, 0.f, 0.f};
        cur = nxt; cA = nA; cB = nB; ++ui;
        if constexpr (ALIGN_EPI) { if (wr == 1) PG8_BAR; }
    }
    PG8_WAIT_V(0);
    if constexpr (!ALIGN_EPI) { if (wr == 0) PG8_BAR; }
    PG8_BAR;
    if constexpr (Epi::AFTER_DRAIN) { E.fused(acc, cur, wr, wc, fr, fq, lds, wid, lane); S.done(cur); }
#undef PG8_SA
#undef PG8_SB
#undef PG8_STAGE
#undef PG8_LDA
#undef PG8_LDB
#undef PG8_MMA
#undef PG8_WAIT_V
#undef PG8_WAIT_L
#undef PG8_BAR
#undef PG8_SCHED
}
}

#define LAS __attribute__((address_space(3)))
typedef unsigned short bf16;
typedef float f32x4 __attribute__((ext_vector_type(4)));
typedef float f32x2 __attribute__((ext_vector_type(2)));
typedef float f32x16 __attribute__((ext_vector_type(16)));
typedef short bf16x8 __attribute__((ext_vector_type(8)));
typedef unsigned u32x4 __attribute__((ext_vector_type(4)));
typedef unsigned u32x2 __attribute__((ext_vector_type(2)));
typedef __bf16 bf16x2_t __attribute__((ext_vector_type(2)));

constexpr int D = 1024, BP = 4, TP = 4096, MPR = BP * TP, BS = 8, TS = 16, MS = BS * TS, MROWS = MPR + MS, MP = 16640;
constexpr int PAST = 1024, NH = 8, HD = 128, DFF = 3072, DIN = 7168;
constexpr float EPS = 1e-6f;
constexpr int NCHUNK = TP / 64;

constexpr size_t O_YP = 0, O_YS = O_YP + (size_t)MPR * D, O_KP = O_YS + (size_t)MS * D, O_VP = O_KP + (size_t)MPR * D,
                 O_RCP = O_VP + (size_t)MPR * D, O_HP = O_RCP + (size_t)BP * 3 * D, O_FCP = O_HP + (size_t)BP * D,
                 O_KS = O_FCP + (size_t)BP * 2 * DFF, O_VS = O_KS + (size_t)MS * D, O_RCS = O_VS + (size_t)MS * D,
                 O_HS = O_RCS + (size_t)BS * 3 * D, O_FCS = O_HS + (size_t)BS * D, O_END = O_FCS + (size_t)BS * 2 * DFF;

constexpr size_t MiB = 1u << 20;
constexpr size_t SLOT = (size_t)MP * D * 2;
constexpr size_t WS_CTL = 0, CTL_BYTES = 1 * MiB;
constexpr size_t WS_WUP = 1 * MiB, WS_WDN = 13 * MiB, WS_WPR = 19 * MiB, WS_WPA = 21 * MiB, WS_WOUT = 23 * MiB, WS_WAT = 25 * MiB, WS_WXT = WS_WAT + 131072;
constexpr size_t WS_S0 = 25 * MiB + 262144;
constexpr size_t WS_S1 = WS_S0 + SLOT, WS_S2 = WS_S1 + SLOT, WS_S3 = WS_S2 + SLOT, WS_S4 = WS_S3 + SLOT, WS_S5 = WS_S4 + SLOT, WS_S6 = WS_S5 + SLOT;
constexpr size_t WS_VTS = WS_S6 + SLOT, WS_SUMP = WS_VTS + 1 * MiB, WS_SUMH = WS_SUMP + 1 * MiB, WS_END = WS_SUMH + 1 * MiB;
static_assert(WS_END <= 256 * MiB, "workspace map exceeds 256 MiB");

constexpr int WLDS = 18816;
constexpr int LDS_BYTES = 8 * WLDS;
constexpr int LDS_SCR = 131072;

__device__ __forceinline__ unsigned pk2(float lo, float hi) { f32x2 v = {lo, hi}; bf16x2_t b = __builtin_convertvector(v, bf16x2_t); return __builtin_bit_cast(unsigned, b); }
__device__ __forceinline__ float bf2f(unsigned short x) { return __uint_as_float((unsigned)x << 16); }
__device__ __forceinline__ float bflo(unsigned x) { return __uint_as_float(x << 16); }
__device__ __forceinline__ float bfhi(unsigned x) { return __uint_as_float(x & 0xffff0000u); }
__device__ __forceinline__ float sigmoid_f(float x) { return __builtin_amdgcn_rcpf(1.f + __expf(-x)); }
__device__ __forceinline__ float gelu_f(float x) { const float u = 1.5957691216057308f * (x + 0.044715f * x * x * x); return x * sigmoid_f(u); }
__device__ __forceinline__ float softplus_f(float z) { return fmaxf(z, 0.f) + __logf(1.f + __expf(-fabsf(z))); }
__device__ __forceinline__ float wave_sum(float v) {
#pragma unroll
    for (int o = 1; o < 64; o <<= 1) v += __shfl_xor(v, o);
    return v;
}
__device__ __forceinline__ void unpack8(const u32x4 w, float (&f)[8]) {
    f[0] = bflo(w.x); f[1] = bfhi(w.x); f[2] = bflo(w.y); f[3] = bfhi(w.y); f[4] = bflo(w.z); f[5] = bfhi(w.z); f[6] = bflo(w.w); f[7] = bfhi(w.w);
}

__device__ __forceinline__ u32x4 pack8(const float (&v)[8]) { u32x4 w; w.x = pk2(v[0], v[1]); w.y = pk2(v[2], v[3]); w.z = pk2(v[4], v[5]); w.w = pk2(v[6], v[7]); return w; }
__device__ __forceinline__ void st8f(float* o, const float (&v)[8]) { *(f32x4*)o = (f32x4){v[0], v[1], v[2], v[3]}; *(f32x4*)(o + 4) = (f32x4){v[4], v[5], v[6], v[7]}; }
__device__ __forceinline__ void ld8f(const float* o, float (&v)[8]) { const f32x4 a = *(const f32x4*)o, b = *(const f32x4*)(o + 4); v[0] = a.x; v[1] = a.y; v[2] = a.z; v[3] = a.w; v[4] = b.x; v[5] = b.y; v[6] = b.z; v[7] = b.w; }
__device__ __forceinline__ float sum16(float s) { s += __shfl_xor(s, 1); s += __shfl_xor(s, 2); s += __shfl_xor(s, 4); s += __shfl_xor(s, 8); return s; }
struct Params { const float* in[26]; float* out; unsigned char* ws; };
#define WSB(off) ((bf16*)(p.ws + (off)))
#define D0 ((bf16*)p.out)
#define D1 (((bf16*)p.out) + (size_t)MROWS * D)
#define WUP WSB(WS_WUP)
#define WDN WSB(WS_WDN)
#define WPR WSB(WS_WPR)
#define WPA WSB(WS_WPA)
#define WOUT WSB(WS_WOUT)
#define WAT WSB(WS_WAT)
#define WXT WSB(WS_WXT)
#define S0 WSB(WS_S0)
#define S1 WSB(WS_S1)
#define S2 WSB(WS_S2)
#define S3 WSB(WS_S3)
#define S4 WSB(WS_S4)
#define S5 WSB(WS_S5)
#define S6 WSB(WS_S6)
#define KFs WSB(WS_VTS)
#define VFs WSB(WS_VTS + 524288)
#define C8T ((float*)(p.ws + WS_CTL + 131072))
#define SUMP ((float*)(p.ws + WS_SUMP))
#define SUMH ((float*)(p.ws + WS_SUMH))
#define SS2 ((float*)(p.ws + WS_CTL))
#define U1 D0
#define XR D1
#define GG S0
#define QN S1
#define KF S2
#define VF S3
#define SG1 S4
#define SG2 S5
#define WIN S6
#define T1 S2
#define MG S6
#define U2 S0
#define GP S1
#define VAL S4
#define HLB S6
#define PCB D0

__device__ __forceinline__ void p0_transpose_item(const float* W, int K, int N, bf16* WT, LAS float* scr, int item, int lane) {
    const int nblk = N / 32, kb = item / nblk, nb = item % nblk, k0 = 64 * kb, n0 = 32 * nb;
#pragma unroll 32
    for (int i = 0; i < 32; ++i) { const int kk = 2 * i + (lane >> 5); scr[kk * 33 + (lane & 31)] = W[(size_t)(k0 + kk) * N + n0 + (lane & 31)]; }
    asm volatile("s_waitcnt lgkmcnt(0)" ::: "memory");
    const int c = lane & 7;
#pragma unroll
    for (int j = 0; j < 4; ++j) { const int n = (lane >> 3) + 8 * j; const LAS float* s = scr + (8 * c) * 33 + n;
        u32x4 o; o.x = pk2(s[0 * 33], s[1 * 33]); o.y = pk2(s[2 * 33], s[3 * 33]); o.z = pk2(s[4 * 33], s[5 * 33]); o.w = pk2(s[6 * 33], s[7 * 33]);
        *(u32x4*)(WT + (size_t)(n0 + n) * K + k0 + 8 * c) = o; }
    asm volatile("s_waitcnt lgkmcnt(0)" ::: "memory");
}
__device__ __forceinline__ void rms_row(const float* xrow, const float* g, bf16* orow, int lane) {
    const f32x4* xr = (const f32x4*)xrow + lane; const f32x4* gr = (const f32x4*)g + lane;
    f32x4 v[4]; float s = 0.f;
#pragma unroll
    for (int j = 0; j < 4; ++j) { v[j] = xr[64 * j]; s += (v[j].x * v[j].x + v[j].y * v[j].y) + (v[j].z * v[j].z + v[j].w * v[j].w); }
    const float rs = rsqrtf(wave_sum(s) * (1.f / D) + EPS);
    u32x2* o8 = (u32x2*)orow + lane;
#pragma unroll
    for (int j = 0; j < 4; ++j) { const f32x4 gv = gr[64 * j]; u32x2 o; o.x = pk2(v[j].x * rs * gv.x, v[j].y * rs * gv.y); o.y = pk2(v[j].z * rs * gv.z, v[j].w * rs * gv.w); o8[64 * j] = o; }
}

#define EPI_ARGS const f32x4 (&acc)[2][2][4][2], const pg8::Unit& u, int wr, int wc, int fr, int fq

struct EpiIn {
    static constexpr bool PERM = true, AFTER_DRAIN = false;
    bf16 *xr_, *gg_, *qn_, *kf_, *vf_, *sg1_, *sg2_; float* out; const float *qg, *kg; LAS float* scr;
    __device__ __forceinline__ void operator()(EPI_ARGS) const {
        const int seg = u.pn >> 2, cb = (u.pn & 3) * 256;
        const int rbase = u.pm * 256 + wr * 64 + fr;
        const int cl = wc * 32 + 8 * fq;
        if (seg == 2 || seg == 3) {
#pragma unroll
            for (int ai = 0; ai < 2; ++ai)
#pragma unroll
                for (int m = 0; m < 4; ++m)
#pragma unroll
                    for (int bj = 0; bj < 2; ++bj) {
                        const f32x4 a = acc[ai][bj][m][0], b = acc[ai][bj][m][1];
                        float s = (a.x * a.x + a.y * a.y) + (a.z * a.z + a.w * a.w) + (b.x * b.x + b.y * b.y) + (b.z * b.z + b.w * b.w);
                        s += __shfl_xor(s, 16); s += __shfl_xor(s, 32);
                        if (fq == 0) scr[((ai * 128 + wr * 64 + m * 16 + fr) * 2 + bj) * 4 + wc] = s;
                    }
            asm volatile("s_waitcnt lgkmcnt(0)" ::: "memory"); __builtin_amdgcn_s_barrier(); asm volatile("" ::: "memory");
            const float* gain = (seg == 2) ? qg : kg; const float osc = (seg == 2) ? 0.08838834764831845f : 1.0f;
            const f32x4 g0 = *(const f32x4*)(gain + cl), g1 = *(const f32x4*)(gain + cl + 4);

#pragma unroll
            for (int ai = 0; ai < 2; ++ai)
#pragma unroll
                for (int m = 0; m < 4; ++m) {
                    const int r = rbase + ai * 128 + m * 16;
#pragma unroll
                    for (int bj = 0; bj < 2; ++bj) {
                        const f32x4 pp = *(const LAS f32x4*)(scr + ((ai * 128 + wr * 64 + m * 16 + fr) * 2 + bj) * 4);
                        const float rs = rsqrtf(((pp.x + pp.y) + (pp.z + pp.w)) * (1.f / HD) + EPS);
                        const f32x4 a = acc[ai][bj][m][0] * rs * g0, b = acc[ai][bj][m][1] * rs * g1;
                        const int col = cb + bj * 128 + cl;
                        u32x4 w; w.x = pk2(a.x * osc, a.y * osc); w.y = pk2(a.z * osc, a.w * osc); w.z = pk2(b.x * osc, b.y * osc); w.w = pk2(b.z * osc, b.w * osc);
                        if (seg == 2) *(u32x4*)(qn_ + (size_t)r * D + col) = w;
                        else {
                            const int bb = r >> 12, t = r & (TP - 1), hh = (cb + bj * 128) >> 7;
                            *(u32x4*)(kf_ + ((((size_t)(bb * NH + hh) * (TP / 32) + (t >> 5)) * 8 + (cl >> 4)) * 512 + ((t & 31) + 32 * ((cl >> 3) & 1)) * 8)) = w;
                            float* o = out + O_KP + (size_t)r * D + col;
                            *(f32x4*)o = a; *(f32x4*)(o + 4) = b;
                        }
                    }
                }
        } else if (seg == 4) {
            LAS bf16* wscr = (LAS bf16*)scr + (wr * 4 + wc) * 512;
            const int L = fr + 16 * fq, dl = L & 31, hk = L >> 5;
#pragma unroll
            for (int ai = 0; ai < 2; ++ai)
#pragma unroll
                for (int m = 0; m < 4; ++m) {
                    const int r = rbase + ai * 128 + m * 16, bb = r >> 12, t0 = (r - fr) & (TP - 1);
#pragma unroll
                    for (int bj = 0; bj < 2; ++bj) {
                        const f32x4 a = acc[ai][bj][m][0], b = acc[ai][bj][m][1];
                        const int col = cb + bj * 128 + cl, hh = (cb + bj * 128) >> 7;
                        float* o = out + O_VP + (size_t)r * D + col;
                        *(f32x4*)o = a; *(f32x4*)(o + 4) = b;
                        u32x4 w; w.x = pk2(a.x, a.y); w.y = pk2(a.z, a.w); w.z = pk2(b.x, b.y); w.w = pk2(b.z, b.w);
                        *(LAS u32x4*)(wscr + fr * 32 + 8 * fq) = w;
                        asm volatile("s_waitcnt lgkmcnt(0)" ::: "memory");
                        unsigned short e[8];
#pragma unroll
                        for (int j = 0; j < 8; ++j) e[j] = wscr[(8 * (j >> 2) + 4 * hk + (j & 3)) * 32 + dl];
                        asm volatile("s_waitcnt lgkmcnt(0)" ::: "memory");
                        u32x4 g; g.x = (unsigned)e[0] | ((unsigned)e[1] << 16); g.y = (unsigned)e[2] | ((unsigned)e[3] << 16); g.z = (unsigned)e[4] | ((unsigned)e[5] << 16); g.w = (unsigned)e[6] | ((unsigned)e[7] << 16);
                        *(u32x4*)(vf_ + ((((size_t)(bb * NH + hh) * (TP / 32) + (t0 >> 5)) * 4 + wc) * 2 + ((t0 >> 4) & 1)) * 512 + L * 8) = g;
                    }
                }
        } else {
            bf16* dst = (seg == 0) ? xr_ : (seg == 1) ? gg_ : (seg == 5) ? sg1_ : sg2_;
            const int rlim = (seg == 0) ? MROWS : MP;
#pragma unroll
            for (int ai = 0; ai < 2; ++ai)
#pragma unroll
                for (int m = 0; m < 4; ++m) {
                    const int r = rbase + ai * 128 + m * 16;
                    if (r < rlim) {
#pragma unroll
                        for (int bj = 0; bj < 2; ++bj) {
                            f32x4 a = acc[ai][bj][m][0], b = acc[ai][bj][m][1];
                            if (seg == 1) { a.x = gelu_f(a.x); a.y = gelu_f(a.y); a.z = gelu_f(a.z); a.w = gelu_f(a.w); b.x = gelu_f(b.x); b.y = gelu_f(b.y); b.z = gelu_f(b.z); b.w = gelu_f(b.w); }
                            else if (seg >= 5) { a.x = sigmoid_f(a.x); a.y = sigmoid_f(a.y); a.z = sigmoid_f(a.z); a.w = sigmoid_f(a.w); b.x = sigmoid_f(b.x); b.y = sigmoid_f(b.y); b.z = sigmoid_f(b.z); b.w = sigmoid_f(b.w); }
                            u32x4 w; w.x = pk2(a.x, a.y); w.y = pk2(a.z, a.w); w.z = pk2(b.x, b.y); w.w = pk2(b.z, b.w);
                            *(u32x4*)(dst + (size_t)r * D + cb + bj * 128 + cl) = w;
                        }
                    }
                }
        }
    }
};

struct EpiT1 {
    static constexpr bool PERM = true, AFTER_DRAIN = false;
    const bf16* SG; bf16* t1_;
    __device__ __forceinline__ void operator()(EPI_ARGS) const {
        const int rbase = u.pm * 256 + wr * 64 + fr, c0 = u.pn * 256 + wc * 32 + 8 * fq;
        u32x4 sg[2][4][2];
#pragma unroll
        for (int ai = 0; ai < 2; ++ai)
#pragma unroll
            for (int m = 0; m < 4; ++m)
#pragma unroll
                for (int bj = 0; bj < 2; ++bj) sg[ai][m][bj] = *(const u32x4*)(SG + (size_t)(rbase + ai * 128 + m * 16) * D + c0 + bj * 128);
        __builtin_amdgcn_sched_barrier(0);
#pragma unroll
        for (int ai = 0; ai < 2; ++ai)
#pragma unroll
            for (int m = 0; m < 4; ++m)
#pragma unroll
                for (int bj = 0; bj < 2; ++bj) {
                    float g[8]; unpack8(sg[ai][m][bj], g);
                    const f32x4 a = acc[ai][bj][m][0], b = acc[ai][bj][m][1];
                    u32x4 w; w.x = pk2(a.x * g[0], a.y * g[1]); w.y = pk2(a.z * g[2], a.w * g[3]); w.z = pk2(b.x * g[4], b.y * g[5]); w.w = pk2(b.z * g[6], b.w * g[7]);
                    *(u32x4*)(t1_ + (size_t)(rbase + ai * 128 + m * 16) * D + c0 + bj * 128) = w;
                }
    }
};
struct EpiMG {
    static constexpr bool PERM = true, AFTER_DRAIN = false;
    const bf16* SG; const bf16* t1_; bf16* mg_;
    __device__ __forceinline__ void operator()(EPI_ARGS) const {
        const int rbase = u.pm * 256 + wr * 64 + fr, c0 = u.pn * 256 + wc * 32 + 8 * fq;
        u32x4 sg[4][2], tt[4][2], res[4][2];
#define MG_LOAD(AI) _Pragma("unroll") for (int m = 0; m < 4; ++m) _Pragma("unroll") for (int bj = 0; bj < 2; ++bj) { \
            const size_t off = (size_t)(rbase + (AI) * 128 + m * 16) * D + c0 + bj * 128; sg[m][bj] = *(const u32x4*)(SG + off); tt[m][bj] = *(const u32x4*)(t1_ + off); }
#define MG_CALC(AI) _Pragma("unroll") for (int m = 0; m < 4; ++m) _Pragma("unroll") for (int bj = 0; bj < 2; ++bj) { \
            float g[8], t[8]; unpack8(sg[m][bj], g); unpack8(tt[m][bj], t); const f32x4 a = acc[AI][bj][m][0], b = acc[AI][bj][m][1]; \
            u32x4 w; w.x = pk2(t[0] + a.x * g[0], t[1] + a.y * g[1]); w.y = pk2(t[2] + a.z * g[2], t[3] + a.w * g[3]); \
            w.z = pk2(t[4] + b.x * g[4], t[5] + b.y * g[5]); w.w = pk2(t[6] + b.z * g[6], t[7] + b.w * g[7]); res[m][bj] = w; }
#define MG_STORE(AI) _Pragma("unroll") for (int m = 0; m < 4; ++m) _Pragma("unroll") for (int bj = 0; bj < 2; ++bj) \
            *(u32x4*)(mg_ + (size_t)(rbase + (AI) * 128 + m * 16) * D + c0 + bj * 128) = res[m][bj];
        MG_LOAD(0)
        __builtin_amdgcn_sched_barrier(0);
        MG_CALC(0)
        MG_LOAD(1)
        __builtin_amdgcn_sched_barrier(0);
        MG_STORE(0)
        MG_CALC(1)
        MG_STORE(1)
#undef MG_LOAD
#undef MG_CALC
#undef MG_STORE
    }
};
struct EpiX1 {
    static constexpr bool PERM = true, AFTER_DRAIN = false;
    const float *xp, *xs, *ln2; float* out; bf16* u2_; float* ss2_;
    __device__ __forceinline__ void operator()(EPI_ARGS) const {
        const int rbase = u.pm * 256 + wr * 64 + fr, c0 = u.pn * 256 + wc * 32 + 8 * fq;
        f32x4 l[2][2];
#pragma unroll
        for (int bj = 0; bj < 2; ++bj) { l[bj][0] = *(const f32x4*)(ln2 + c0 + bj * 128); l[bj][1] = *(const f32x4*)(ln2 + c0 + bj * 128 + 4); }
        f32x4 xv[2][2][2], res[2][2][2];
#define X1_LOAD(Q) _Pragma("unroll") for (int mm = 0; mm < 2; ++mm) _Pragma("unroll") for (int bj = 0; bj < 2; ++bj) { \
            const float* xin = xp + (size_t)(rbase + ((Q) >> 1) * 128 + (((Q) & 1) * 2 + mm) * 16) * D + c0 + bj * 128; xv[mm][bj][0] = *(const f32x4*)xin; xv[mm][bj][1] = *(const f32x4*)(xin + 4); }
#define X1_ADD(Q) _Pragma("unroll") for (int mm = 0; mm < 2; ++mm) _Pragma("unroll") for (int bj = 0; bj < 2; ++bj) { \
            res[mm][bj][0] = acc[(Q) >> 1][bj][((Q) & 1) * 2 + mm][0] + xv[mm][bj][0]; res[mm][bj][1] = acc[(Q) >> 1][bj][((Q) & 1) * 2 + mm][1] + xv[mm][bj][1]; }
#define X1_STORE(Q) _Pragma("unroll") for (int mm = 0; mm < 2; ++mm) { const int r = rbase + ((Q) >> 1) * 128 + (((Q) & 1) * 2 + mm) * 16; float ss = 0.f; \
            _Pragma("unroll") for (int bj = 0; bj < 2; ++bj) { const f32x4 a = res[mm][bj][0], b = res[mm][bj][1]; const int col = c0 + bj * 128; \
                *(f32x4*)(out + (size_t)r * D + col) = a; *(f32x4*)(out + (size_t)r * D + col + 4) = b; \
                ss += (a.x * a.x + a.y * a.y) + (a.z * a.z + a.w * a.w) + (b.x * b.x + b.y * b.y) + (b.z * b.z + b.w * b.w); \
                u32x4 w; w.x = pk2(a.x * l[bj][0].x, a.y * l[bj][0].y); w.y = pk2(a.z * l[bj][0].z, a.w * l[bj][0].w); w.z = pk2(b.x * l[bj][1].x, b.y * l[bj][1].y); w.w = pk2(b.z * l[bj][1].z, b.w * l[bj][1].w); \
                *(u32x4*)(u2_ + (size_t)r * D + col) = w; } \
            ss += __shfl_xor(ss, 16); ss += __shfl_xor(ss, 32); if (fq == 0) atomicAdd(ss2_ + r, ss); }
        X1_LOAD(0)
        __builtin_amdgcn_sched_barrier(0);
        X1_ADD(0) X1_LOAD(1)
        __builtin_amdgcn_sched_barrier(0);
        X1_STORE(0) X1_ADD(1) X1_LOAD(2)
        __builtin_amdgcn_sched_barrier(0);
        X1_STORE(1) X1_ADD(2) X1_LOAD(3)
        __builtin_amdgcn_sched_barrier(0);
        X1_STORE(2) X1_ADD(3) X1_STORE(3)
#undef X1_LOAD
#undef X1_ADD
#undef X1_STORE
    }
};
struct PairOrder {
    pg8::StaticOrder base;
    __device__ __forceinline__ bool next(int i, pg8::Unit& u) const { pg8::Unit t; if (!base.next(i >> 1, t)) return false; u.pm = t.pm + ((i & 1) ? MP / 256 : 0); u.pn = t.pn + ((i & 1) ? 4 : 0); return true; }
    __device__ __forceinline__ void a_ready(const pg8::Unit&) const {}
    __device__ __forceinline__ void done(const pg8::Unit&) const {}
};
struct EpiP4 {
    static constexpr bool PERM = true, AFTER_DRAIN = false;
    EpiT1 e1; EpiMG e2;
    __device__ __forceinline__ void operator()(EPI_ARGS) const {
        if (u.pm >= MP / 256) { const pg8::Unit v{u.pm - MP / 256, u.pn - 4}; e2(acc, v, wr, wc, fr, fq); }
        else e1(acc, u, wr, wc, fr, fq);
    }
};
struct EpiUp {
    static constexpr bool PERM = true, AFTER_DRAIN = false;
    const float* ss2_; bf16 *gp_, *val_;
    __device__ __forceinline__ void operator()(EPI_ARGS) const {
        const int rbase = u.pm * 256 + wr * 64 + fr;
        bf16* dst = (u.pn < 12) ? gp_ : val_; const int c0 = (u.pn < 12 ? u.pn : u.pn - 12) * 256 + wc * 32 + 8 * fq;
        float ssv[2][4];
#pragma unroll
        for (int ai = 0; ai < 2; ++ai)
#pragma unroll
            for (int m = 0; m < 4; ++m) ssv[ai][m] = ss2_[rbase + ai * 128 + m * 16];
#pragma unroll
        for (int ai = 0; ai < 2; ++ai)
#pragma unroll
            for (int m = 0; m < 4; ++m) {
                const int r = rbase + ai * 128 + m * 16;
                const float rs = rsqrtf(ssv[ai][m] * (1.f / D) + EPS);
#pragma unroll
                for (int bj = 0; bj < 2; ++bj) {
                    const f32x4 a = acc[ai][bj][m][0] * rs, b = acc[ai][bj][m][1] * rs;
                    u32x4 w; w.x = pk2(a.x, a.y); w.y = pk2(a.z, a.w); w.z = pk2(b.x, b.y); w.w = pk2(b.z, b.w);
                    *(u32x4*)(dst + (size_t)r * DFF + c0 + bj * 128) = w;
                }
            }
    }
};
struct EpiDown {
    static constexpr bool PERM = true, AFTER_DRAIN = false;
    float* out;
    __device__ __forceinline__ void operator()(EPI_ARGS) const {
        const int rbase = u.pm * 256 + wr * 64 + fr, c0 = u.pn * 256 + wc * 32 + 8 * fq;
        f32x4 xv[4][2][2], res[4][2][2];
#define DN_LOAD(AI) _Pragma("unroll") for (int m = 0; m < 4; ++m) _Pragma("unroll") for (int bj = 0; bj < 2; ++bj) { \
            const float* o = out + (size_t)(rbase + (AI) * 128 + m * 16) * D + c0 + bj * 128; xv[m][bj][0] = *(const f32x4*)o; xv[m][bj][1] = *(const f32x4*)(o + 4); }
#define DN_ADD(AI) _Pragma("unroll") for (int m = 0; m < 4; ++m) _Pragma("unroll") for (int bj = 0; bj < 2; ++bj) { res[m][bj][0] = acc[AI][bj][m][0] + xv[m][bj][0]; res[m][bj][1] = acc[AI][bj][m][1] + xv[m][bj][1]; }
#define DN_STORE(AI) _Pragma("unroll") for (int m = 0; m < 4; ++m) _Pragma("unroll") for (int bj = 0; bj < 2; ++bj) { \
            float* o = out + (size_t)(rbase + (AI) * 128 + m * 16) * D + c0 + bj * 128; *(f32x4*)o = res[m][bj][0]; *(f32x4*)(o + 4) = res[m][bj][1]; }
        DN_LOAD(0)
        __builtin_amdgcn_sched_barrier(0);
        DN_ADD(0)
        DN_LOAD(1)
        __builtin_amdgcn_sched_barrier(0);
        DN_STORE(0)
        DN_ADD(1)
        DN_STORE(1)
#undef DN_LOAD
#undef DN_ADD
#undef DN_STORE
    }
};

#define MFMA32(a, b, c) __builtin_amdgcn_mfma_f32_32x32x16_bf16((a), (b), (c), 0, 0, 0)
template <bool SAMPLE>
__device__ __forceinline__ void attn_unit(const bf16* qn_, const bf16* kf_, const bf16* vf_, const bf16* kfs_, const bf16* vfs_, const float* ck, const float* cv, bf16* YA,
                                          int b, int h, int qb, LAS unsigned char* wl, LAS unsigned char* slabs, int lane) {
    const int r32 = lane & 31, hi = lane >> 5;
    int qpos0, qrow0, nq, kb;
    if (SAMPLE) { qpos0 = PAST; qrow0 = MPR + b * TS; nq = TS; kb = PAST / 32; }
    else { qpos0 = qb * 32; qrow0 = b * TP + qpos0; nq = 32; kb = (qpos0 + 30) >> 5; }
    const int qr = r32 < nq ? r32 : nq - 1;
    LAS bf16x8* qst = (LAS bf16x8*)wl + lane;
    { const bf16* qp = qn_ + (size_t)(qrow0 + qr) * D + h * HD + 8 * hi;
      bf16x8 qf[8];
#pragma unroll
      for (int ks = 0; ks < 8; ++ks) qf[ks] = *(const bf16x8*)(qp + 16 * ks);
      __builtin_amdgcn_sched_barrier(0);
#pragma unroll
      for (int ks = 0; ks < 8; ++ks) qst[ks * 64] = qf[ks]; }
    f32x16 o[4];
#pragma unroll
    for (int d = 0; d < 4; ++d)
#pragma unroll
        for (int i = 0; i < 16; ++i) o[d][i] = 0.f;
    float carry = 0.f;
    const int qpos = qpos0 + qr;
    for (; kb >= 0; --kb) {
        const bool cache = SAMPLE && (kb < PAST / 32 - 8);
        const bool inlds = SAMPLE && !cache && (kb < PAST / 32);
        f32x16 s;
        bf16x8 kf[8], vf[8];
        if (inlds) {
            const LAS bf16x8* sl = (const LAS bf16x8*)(slabs + (PAST / 32 - 1 - kb) * 16384) + lane;
#pragma unroll
            for (int ks = 0; ks < 8; ++ks) kf[ks] = sl[ks * 64];
#pragma unroll
            for (int f = 0; f < 8; ++f) vf[f] = sl[512 + f * 64];
        } else if (cache) {
            const int kk = 32 * kb + r32;
            const float* kp = ck + (((size_t)b * PAST + kk) * NH + h) * HD + 8 * hi;
#pragma unroll
            for (int ks = 0; ks < 8; ++ks) { const f32x4 a = *(const f32x4*)(kp + 16 * ks), c = *(const f32x4*)(kp + 16 * ks + 4);
                u32x4 w; w.x = pk2(a.x, a.y); w.y = pk2(a.z, a.w); w.z = pk2(c.x, c.y); w.w = pk2(c.z, c.w); kf[ks] = __builtin_bit_cast(bf16x8, w); }
#pragma unroll
            for (int f = 0; f < 8; ++f) {
                const int k0 = 32 * kb + 16 * (f & 1) + 4 * hi;
                const float* vp = cv + (((size_t)b * PAST + k0) * NH + h) * HD + (f >> 1) * 32 + r32;
                float e[8];
#pragma unroll
                for (int j = 0; j < 8; ++j) e[j] = vp[(size_t)(8 * (j >> 2) + (j & 3)) * (NH * HD)];
                u32x4 w; w.x = pk2(e[0], e[1]); w.y = pk2(e[2], e[3]); w.z = pk2(e[4], e[5]); w.w = pk2(e[6], e[7]); vf[f] = __builtin_bit_cast(bf16x8, w);
            }
        } else {
            const size_t fo = (SAMPLE ? (size_t)(b * NH + h) : ((size_t)(b * NH + h) * (TP / 32) + kb)) * 8 * 512 + lane * 8;
            const bf16* kp = (SAMPLE ? kfs_ : kf_) + fo; const bf16* vp = (SAMPLE ? vfs_ : vf_) + fo;
#pragma unroll
            for (int ks = 0; ks < 8; ++ks) kf[ks] = *(const bf16x8*)(kp + ks * 512);
#pragma unroll
            for (int f = 0; f < 8; ++f) vf[f] = *(const bf16x8*)(vp + f * 512);
        }
        __builtin_amdgcn_sched_barrier(0);
#pragma unroll
        for (int i = 0; i < 16; ++i) s[i] = 0.f;
#pragma unroll
        for (int ks = 0; ks < 8; ++ks) s = MFMA32(kf[ks], qst[ks * 64], s);
        f32x16 Lv; float own[4], oth[4];
#pragma unroll
        for (int i = 0; i < 16; ++i) {
            const float z = s[i];
            const int kpos = 32 * kb + (i & 3) + 8 * (i >> 2) + 4 * hi;
            const float sp = softplus_f(z);
            Lv[i] = (kpos < qpos) ? -sp : 0.f;
            s[i] = z - sp;
        }
#pragma unroll
        for (int g = 0; g < 4; ++g) { own[g] = (Lv[4 * g] + Lv[4 * g + 1]) + (Lv[4 * g + 2] + Lv[4 * g + 3]); oth[g] = __shfl_xor(own[g], 32); }
        float run = 0.f, after[4];
#pragma unroll
        for (int g = 3; g >= 0; --g) { after[g] = run + (hi == 0 ? oth[g] : 0.f); run += own[g] + oth[g]; }
        bf16x8 pa[2];
        {
            float w[16];
#pragma unroll
            for (int g = 0; g < 4; ++g) {
                float sfx = carry + after[g];
#pragma unroll
                for (int e = 3; e >= 0; --e) {
                    const int i = 4 * g + e;
                    const int kpos = 32 * kb + (i & 3) + 8 * (i >> 2) + 4 * hi;
                    w[i] = (kpos < qpos) ? __expf(s[i] + sfx) : 0.f;
                    sfx += Lv[i];
                }
            }
#pragma unroll
            for (int st = 0; st < 2; ++st) { u32x4 pw; pw.x = pk2(w[8 * st], w[8 * st + 1]); pw.y = pk2(w[8 * st + 2], w[8 * st + 3]); pw.z = pk2(w[8 * st + 4], w[8 * st + 5]); pw.w = pk2(w[8 * st + 6], w[8 * st + 7]);
                pa[st] = __builtin_bit_cast(bf16x8, pw); }
        }
        carry += run;
#pragma unroll
        for (int db = 0; db < 4; ++db)
#pragma unroll
            for (int st = 0; st < 2; ++st) o[db] = MFMA32(vf[db * 2 + st], pa[st], o[db]);
        if (__all(carry < -104.0f)) break;
    }
    if (r32 < nq) {
        bf16* op = YA + (size_t)(qrow0 + r32) * D + h * HD + 4 * hi;
#pragma unroll
        for (int db = 0; db < 4; ++db)
#pragma unroll
            for (int g = 0; g < 4; ++g) { u32x2 w; w.x = pk2(o[db][4 * g], o[db][4 * g + 1]); w.y = pk2(o[db][4 * g + 2], o[db][4 * g + 3]); *(u32x2*)(op + db * 32 + 8 * g) = w; }
    }
}

#define MFMA16(a, b, c) __builtin_amdgcn_mfma_f32_16x16x32_bf16((a), (b), (c), 0, 0, 0)
constexpr int XCS = 72;
template <int NB>
__device__ __forceinline__ void scan16(f32x4 (&A)[NB], f32x4 (&B)[NB], int fr) {
#pragma unroll
    for (int sft = 1; sft < 16; sft <<= 1) {
#pragma unroll
        for (int nb = 0; nb < NB; ++nb)
#pragma unroll
            for (int i = 0; i < 4; ++i) {
                const float ap = __shfl_up(A[nb][i], sft, 16), bp = __shfl_up(B[nb][i], sft, 16);
                if (fr >= sft) { B[nb][i] = A[nb][i] * bp + B[nb][i]; A[nb][i] = A[nb][i] * ap; }
            }
    }
}
template <bool FINAL, bool sample>
__device__ __forceinline__ void lru_unit(const Params& p, int b, int j0, int n, LAS unsigned char* wl, int lane) {
    constexpr int NCH = sample ? 1 : 2;
    const int fr = lane & 15, fq = lane >> 4;
    const int ntok = sample ? TS : 64, nmb = sample ? 1 : 4;
    LAS bf16* xcs = (LAS bf16*)wl;
    const int c = n * 64 + lane;
    f32x4 Hc[4], Pc[4];
    LAS float* cst = (LAS float*)(wl + 9648); LAS u32x2* gst = (LAS u32x2*)(wl + 10416) + lane; (void)gst;
    cst[lane] = C8T[c]; cst[64 + lane] = p.in[12][c]; cst[128 + lane] = p.in[14][c];
#pragma unroll
    for (int nb = 0; nb < 4; ++nb) {
        const int d0 = n * 64 + 16 * nb + 4 * fq;
        Hc[nb] = (f32x4){0.f, 0.f, 0.f, 0.f}; Pc[nb] = (f32x4){1.f, 1.f, 1.f, 1.f};
        if (FINAL && sample) Hc[nb] = *(const f32x4*)(p.in[5] + (size_t)b * D + d0);
    }
    const float* cw = p.in[9]; const float w0 = cw[c], w1 = cw[D + c], w2 = cw[2 * D + c], w3 = cw[3 * D + c], cbias = p.in[10][c];
    if (FINAL && !sample) {
        const float* sp = SUMP + (size_t)b * NCHUNK * D + n * 64 + 4 * fq; const float* sh = SUMH + (size_t)b * NCHUNK * D + n * 64 + 4 * fq;
#pragma unroll 1
        for (int g = 0; g < j0; g += 16) {
            const int jj = g + fr; f32x4 A[4], B[4];
#pragma unroll
            for (int nb = 0; nb < 4; ++nb) { A[nb] = (f32x4){1.f, 1.f, 1.f, 1.f}; B[nb] = (f32x4){0.f, 0.f, 0.f, 0.f};
                if (jj < j0) { A[nb] = *(const f32x4*)(sp + (size_t)jj * D + 16 * nb); B[nb] = *(const f32x4*)(sh + (size_t)jj * D + 16 * nb); } }
            scan16<4>(A, B, fr);
#pragma unroll
            for (int nb = 0; nb < 4; ++nb)
#pragma unroll
                for (int i = 0; i < 4; ++i) { const float pt = __shfl(A[nb][i], 15, 16), ht = __shfl(B[nb][i], 15, 16); Hc[nb][i] = pt * Hc[nb][i] + ht; }
        }
    }
    bf16x8 wa[4][2], wx[4][2];
#pragma unroll
    for (int nb = 0; nb < 4; ++nb)
#pragma unroll
        for (int k = 0; k < 2; ++k) { const size_t off = (size_t)(n * 64 + 16 * nb + fr) * 64 + 8 * fq + 32 * k; wa[nb][k] = *(const bf16x8*)(WAT + off); wx[nb][k] = *(const bf16x8*)(WXT + off); }
#pragma unroll 1
    for (int jc = 0; jc < NCH; ++jc) {
        const int j = j0 + jc;
        const int row0 = sample ? MPR + b * TS : b * TP + j * 64;
        if (FINAL) {
            u32x2 gtmp[16];
#pragma unroll
            for (int q = 0; q < 16; ++q) gtmp[q] = ((q >> 2) < nmb) ? *(const u32x2*)(GG + (size_t)(row0 + 16 * (q >> 2) + fr) * D + n * 64 + 16 * (q & 3) + 4 * fq) : (u32x2){0u, 0u};
#pragma unroll
            for (int q = 0; q < 16; ++q) gst[q * 64] = gtmp[q];
        }
        {
            const int rr = lane >> 3, cc = (lane & 7) * 8;
            u32x4 stg[9];
#pragma unroll
            for (int i = 0; i < 9; ++i) {
                const int tr = 8 * i + rr - 3;
                stg[i] = (u32x4){0u, 0u, 0u, 0u};
                if (tr < ntok) {
                    if (tr >= 0 || (!sample && j > 0)) stg[i] = *(const u32x4*)(XR + (size_t)(row0 + tr) * D + n * 64 + cc);
                    else if (sample) { float hv[8]; ld8f(p.in[4] + ((size_t)b * 3 + (tr + 3)) * D + n * 64 + cc, hv); stg[i] = pack8(hv); }
                }
            }
#pragma unroll
            for (int i = 0; i < 9; ++i) { const int tr = 8 * i + rr - 3; if (tr < ntok) *(LAS u32x4*)(xcs + (tr + 3) * XCS + cc) = stg[i]; }
            asm volatile("s_waitcnt lgkmcnt(0)" ::: "memory");
            float x3 = bf2f(xcs[0 * XCS + lane]), x2 = bf2f(xcs[1 * XCS + lane]), x1 = bf2f(xcs[2 * XCS + lane]);
#pragma unroll 8
            for (int t = 0; t < ntok; ++t) {
                const float x0 = bf2f(xcs[(t + 3) * XCS + lane]);
                const float y = w0 * x3 + w1 * x2 + w2 * x1 + w3 * x0 + cbias;
                xcs[t * XCS + lane] = (bf16)(pk2(y, 0.f) & 0xffffu);
                x3 = x2; x2 = x1; x1 = x0;
            }
            if (FINAL && (sample || j == NCHUNK - 1)) {
                float* o = p.out + (sample ? O_RCS + (size_t)b * 3 * D : O_RCP + (size_t)b * 3 * D) + c;
                o[0] = x3; o[D] = x2; o[2 * D] = x1;
            }
        }
        asm volatile("s_waitcnt lgkmcnt(0)" ::: "memory");
        if (!FINAL) {
#pragma unroll
            for (int nb = 0; nb < 4; ++nb) { Hc[nb] = (f32x4){0.f, 0.f, 0.f, 0.f}; Pc[nb] = (f32x4){1.f, 1.f, 1.f, 1.f}; }
        }
#pragma unroll 1
        for (int mb = 0; mb < 4; ++mb) {
            if (mb < nmb) {
                const LAS bf16* xrow = xcs + (16 * mb + fr) * XCS;
                const bf16x8 xf0 = *(const LAS bf16x8*)(xrow + 8 * fq), xf1 = *(const LAS bf16x8*)(xrow + 8 * fq + 32);
#pragma unroll
                for (int hf = 0; hf < 2; ++hf) {
                    f32x4 A[2], B[2];
#pragma unroll
                    for (int q = 0; q < 2; ++q) {
                        const int nb = 2 * hf + q;
                        f32x4 aa = (f32x4){0.f, 0.f, 0.f, 0.f}, ax = aa;
                        aa = MFMA16(wa[nb][0], xf0, aa); aa = MFMA16(wa[nb][1], xf1, aa);
                        ax = MFMA16(wx[nb][0], xf0, ax); ax = MFMA16(wx[nb][1], xf1, ax);
                        const u32x2 xw = *(const LAS u32x2*)(xrow + 16 * nb + 4 * fq);
                        const f32x4 c8v = *(const LAS f32x4*)(cst + 16 * nb + 4 * fq), bav = *(const LAS f32x4*)(cst + 64 + 16 * nb + 4 * fq), bxv = *(const LAS f32x4*)(cst + 128 + 16 * nb + 4 * fq);
                        const float xc[4] = {bflo(xw.x), bfhi(xw.x), bflo(xw.y), bfhi(xw.y)};
#pragma unroll
                        for (int i = 0; i < 4; ++i) {
                            const float ra = sigmoid_f(aa[i] + bav[i]), ri = sigmoid_f(ax[i] + bxv[i]);
                            const float a = __expf(c8v[i] * ra);
                            A[q][i] = a; B[q][i] = __builtin_amdgcn_sqrtf(fmaxf(1.f - a * a, 0.f)) * (ri * xc[i]);
                        }
                    }
                    scan16<2>(A, B, fr);
#pragma unroll
                    for (int q = 0; q < 2; ++q) {
                        const int nb = 2 * hf + q;
                        f32x4 hv = B[q] + A[q] * Hc[nb], pv = A[q] * Pc[nb];
                        if (!FINAL) {
                            const size_t off = (size_t)(row0 + 16 * mb + fr) * D + n * 64 + 16 * nb + 4 * fq;
                            u32x2 hw; hw.x = pk2(hv.x, hv.y); hw.y = pk2(hv.z, hv.w); *(u32x2*)(HLB + off) = hw;
                            u32x2 pw; pw.x = pk2(pv.x, pv.y); pw.y = pk2(pv.z, pv.w); *(u32x2*)(PCB + off) = pw;
                        }
                        if (FINAL) {
                            const u32x2 gw = gst[(mb * 4 + nb) * 64];
                            u32x2 yw; yw.x = pk2(hv.x * bflo(gw.x), hv.y * bfhi(gw.x)); yw.y = pk2(hv.z * bflo(gw.y), hv.w * bfhi(gw.y));
                            *(u32x2*)(GG + (size_t)(row0 + 16 * mb + fr) * D + n * 64 + 16 * nb + 4 * fq) = yw;
                        }
#pragma unroll
                        for (int i = 0; i < 4; ++i) { Hc[nb][i] = __shfl(hv[i], 15, 16); Pc[nb][i] = __shfl(pv[i], 15, 16); }
                    }
                }
            }
        }
        if (fr == 0) {
#pragma unroll
            for (int nb = 0; nb < 4; ++nb) {
                const int d0 = n * 64 + 16 * nb + 4 * fq;
                if (!FINAL) { const size_t so = ((size_t)b * NCHUNK + j) * D + d0; *(f32x4*)(SUMP + so) = Pc[nb]; *(f32x4*)(SUMH + so) = Hc[nb]; }
                else if (sample || j == NCHUNK - 1) *(f32x4*)(p.out + (sample ? O_HS + (size_t)b * D : O_HP + (size_t)b * D) + d0) = Hc[nb];
            }
        }
        asm volatile("s_waitcnt lgkmcnt(0)" ::: "memory");
    }
}


__device__ __forceinline__ void lru_final_light(const Params& p, int b, int j0, int n, int lane) {
    const int fr = lane & 15, fq = lane >> 4;
    f32x4 Hc[4];
#pragma unroll
    for (int nb = 0; nb < 4; ++nb) Hc[nb] = (f32x4){0.f, 0.f, 0.f, 0.f};
    const float* sp = SUMP + (size_t)b * NCHUNK * D + n * 64 + 4 * fq; const float* sh = SUMH + (size_t)b * NCHUNK * D + n * 64 + 4 * fq;
#pragma unroll 1
    for (int g = 0; g < j0; g += 16) {
        const int jj = g + fr; f32x4 A[4], B[4];
#pragma unroll
        for (int nb = 0; nb < 4; ++nb) { A[nb] = (f32x4){1.f, 1.f, 1.f, 1.f}; B[nb] = (f32x4){0.f, 0.f, 0.f, 0.f};
            if (jj < j0) { A[nb] = *(const f32x4*)(sp + (size_t)jj * D + 16 * nb); B[nb] = *(const f32x4*)(sh + (size_t)jj * D + 16 * nb); } }
        scan16<4>(A, B, fr);
#pragma unroll
        for (int nb = 0; nb < 4; ++nb)
#pragma unroll
            for (int i = 0; i < 4; ++i) { const float pt = __shfl(A[nb][i], 15, 16), ht = __shfl(B[nb][i], 15, 16); Hc[nb][i] = pt * Hc[nb][i] + ht; }
    }
#pragma unroll 1
    for (int jc = 0; jc < 2; ++jc) {
        const int j = j0 + jc, row0 = b * TP + j * 64;
        u32x2 hl[4][4], pc[4][4], gg[4][4];
#pragma unroll
        for (int mb = 0; mb < 4; ++mb)
#pragma unroll
            for (int nb = 0; nb < 4; ++nb) { const size_t off = (size_t)(row0 + 16 * mb + fr) * D + n * 64 + 16 * nb + 4 * fq; hl[mb][nb] = *(const u32x2*)(HLB + off); pc[mb][nb] = *(const u32x2*)(PCB + off); gg[mb][nb] = *(const u32x2*)(GG + off); }
        f32x4 pe[4], he[4];
#pragma unroll
        for (int nb = 0; nb < 4; ++nb) { const size_t so = ((size_t)b * NCHUNK + j) * D + n * 64 + 16 * nb + 4 * fq; pe[nb] = *(const f32x4*)(SUMP + so); he[nb] = *(const f32x4*)(SUMH + so); }
#pragma unroll
        for (int mb = 0; mb < 4; ++mb)
#pragma unroll
            for (int nb = 0; nb < 4; ++nb) {
                const u32x2 a = hl[mb][nb], c = pc[mb][nb], g = gg[mb][nb];
                const float h0 = bflo(a.x) + bflo(c.x) * Hc[nb].x, h1 = bfhi(a.x) + bfhi(c.x) * Hc[nb].y, h2 = bflo(a.y) + bflo(c.y) * Hc[nb].z, h3 = bfhi(a.y) + bfhi(c.y) * Hc[nb].w;
                u32x2 yw; yw.x = pk2(h0 * bflo(g.x), h1 * bfhi(g.x)); yw.y = pk2(h2 * bflo(g.y), h3 * bfhi(g.y));
                *(u32x2*)(GG + (size_t)(row0 + 16 * mb + fr) * D + n * 64 + 16 * nb + 4 * fq) = yw;
            }
#pragma unroll
        for (int nb = 0; nb < 4; ++nb) Hc[nb] = pe[nb] * Hc[nb] + he[nb];
        if (j == NCHUNK - 1) {
            if (fr == 0) {
#pragma unroll
                for (int nb = 0; nb < 4; ++nb) *(f32x4*)(p.out + O_HP + (size_t)b * D + n * 64 + 16 * nb + 4 * fq) = Hc[nb];
            }
            const int c = n * 64 + lane;
#pragma unroll
            for (int i = 0; i < 3; ++i) p.out[O_RCP + ((size_t)b * 3 + i) * D + c] = bf2f(XR[(size_t)(b * TP + TP - 3 + i) * D + c]);
        }
    }
}

constexpr int RSTR = 132;
template <int K>
__device__ __forceinline__ void sgemm_tile(const bf16* A, const bf16* Bt, LAS float* red, int tid, float (&v)[8]) {
    const int lane = tid & 63, w = __builtin_amdgcn_readfirstlane(tid >> 6), fr = lane & 15, fq = lane >> 4;
    constexpr int KW = K / 8, NKS = KW / 32;
    f32x4 acc[2][8];
#pragma unroll
    for (int mb = 0; mb < 2; ++mb)
#pragma unroll
        for (int nb = 0; nb < 8; ++nb) acc[mb][nb] = (f32x4){0.f, 0.f, 0.f, 0.f};
    const bf16* ap = A + (size_t)fr * K + w * KW + 8 * fq;
    const bf16* bp = Bt + (size_t)fr * K + w * KW + 8 * fq;
#pragma unroll (NKS == 4 ? 4 : 3)
    for (int ks = 0; ks < NKS; ++ks) {
        bf16x8 af[2], bb[8];
#pragma unroll
        for (int mb = 0; mb < 2; ++mb) af[mb] = *(const bf16x8*)(ap + (size_t)mb * 16 * K + ks * 32);
#pragma unroll
        for (int nb = 0; nb < 8; ++nb) bb[nb] = *(const bf16x8*)(bp + (size_t)nb * 16 * K + ks * 32);
#pragma unroll
        for (int mb = 0; mb < 2; ++mb)
#pragma unroll
            for (int nb = 0; nb < 8; ++nb) acc[mb][nb] = MFMA16(bb[nb], af[mb], acc[mb][nb]);
    }
    LAS float* slab = red + w * (32 * RSTR);
#pragma unroll
    for (int mb = 0; mb < 2; ++mb)
#pragma unroll
        for (int nb = 0; nb < 8; ++nb) *(LAS f32x4*)(slab + (16 * mb + fr) * RSTR + 16 * nb + 4 * fq) = acc[mb][nb];
    __syncthreads();
    const int row = tid >> 4, c8 = (tid & 15) * 8;
    f32x4 s0 = (f32x4){0.f, 0.f, 0.f, 0.f}, s1 = s0;
#pragma unroll
    for (int sl = 0; sl < 8; ++sl) { const LAS float* q = red + sl * (32 * RSTR) + row * RSTR + c8; s0 += *(const LAS f32x4*)q; s1 += *(const LAS f32x4*)(q + 4); }
    v[0] = s0.x; v[1] = s0.y; v[2] = s0.z; v[3] = s0.w; v[4] = s1.x; v[5] = s1.y; v[6] = s1.z; v[7] = s1.w;
    __syncthreads();
}

#define XB_TMO      128
#define XB_XCNT(j)  (256  + 64 * (j))
#define XB_XSUB(j)  (1280 + 64 * (j))
#define XB_XGEN(j)  (2304 + 64 * (j))
#define XB_TOP      3328
#define XB_TOPGEN   3392
#define XCD_BAR_WORDS 3456
#define XB_SPIN_CAP (1u << 18)

__device__ __forceinline__ unsigned xb_ld(unsigned* p)              { return __hip_atomic_load(p, __ATOMIC_RELAXED, __HIP_MEMORY_SCOPE_AGENT); }
__device__ __forceinline__ unsigned xb_add(unsigned* p, unsigned v) { return __hip_atomic_fetch_add(p, v, __ATOMIC_RELAXED, __HIP_MEMORY_SCOPE_AGENT); }
__device__ __forceinline__ unsigned xb_xcc_id() { return (unsigned)__builtin_amdgcn_s_getreg((3 << 11) | 20) & 0xFu; }
#define XB_SPIN(cond, bar) do { unsigned _sp = 0; while (cond) { __builtin_amdgcn_s_sleep(1); \
    if ((++_sp & 255u) == 0u) { if (xb_ld(&(bar)[XB_TMO])) break; if (_sp > XB_SPIN_CAP) { atomicAdd(&(bar)[XB_TMO], 1u); break; } } } } while (0)

struct XcdBarrier {
    unsigned* bar; unsigned x;
    volatile LAS unsigned* st;
};

__device__ __forceinline__ XcdBarrier xcd_barrier_post(unsigned* bar, volatile LAS unsigned* st) {
    XcdBarrier b; b.bar = bar; b.x = xb_xcc_id(); b.st = st;
    if (threadIdx.x == 0) (void)xb_add(&bar[XB_XCNT(b.x)], 1u);
    return b;
}
__device__ __forceinline__ void xcd_barrier_complete(unsigned* bar, unsigned x, unsigned& nloc, unsigned& nx) {
    const unsigned G = gridDim.x * gridDim.y * gridDim.z;
    unsigned sum, cnt, mine, sp = 0u;
    for (;;) {
        sum = 0u; cnt = 0u; mine = 0u;
#pragma unroll
        for (unsigned j = 0; j < 16; ++j) { const unsigned c = xb_ld(&bar[XB_XCNT(j)]); sum += c; cnt += (c > 0u) ? 1u : 0u; mine = (j == x) ? c : mine; }
        if (sum == G) break;
        __builtin_amdgcn_s_sleep(1);
        if ((++sp & 255u) == 0u) { if (xb_ld(&bar[XB_TMO])) break; if (sp > XB_SPIN_CAP) { atomicAdd(&bar[XB_TMO], 1u); break; } }
    }
    nloc = mine > 0u ? mine : 1u; nx = cnt > 0u ? cnt : 1u;
}

__device__ __forceinline__ void xcd_barrier(const XcdBarrier& b) {
    asm volatile("s_waitcnt vmcnt(0)" ::: "memory");
    __syncthreads();
    if (threadIdx.x == 0) {
        unsigned* bar = b.bar;
        __builtin_amdgcn_s_waitcnt(0);
        unsigned nloc = b.st[0], nx = b.st[1];
        if (nloc == 0u) { xcd_barrier_complete(bar, b.x, nloc, nx); b.st[0] = nloc; b.st[1] = nx; }
        const unsigned old = xb_add(&bar[XB_XSUB(b.x)], 1u);
        const unsigned gen = old / nloc;
        if (old + 1u == (gen + 1u) * nloc) {
            __builtin_amdgcn_fence(__ATOMIC_RELEASE, "agent");
            asm volatile("s_waitcnt vmcnt(0)" ::: "memory");
            const unsigned og = xb_add(&bar[XB_TOP], 1u);
            const unsigned tg = og / nx;
            if (og + 1u == (tg + 1u) * nx) xb_add(&bar[XB_TOPGEN], 1u);
            else XB_SPIN(xb_ld(&bar[XB_TOPGEN]) == tg, bar);
            __builtin_amdgcn_fence(__ATOMIC_ACQUIRE, "agent");
            xb_add(&bar[XB_XGEN(b.x)], 1u);
            asm volatile("s_waitcnt vmcnt(0)" ::: "memory");
        } else {
            XB_SPIN(xb_ld(&bar[XB_XGEN(b.x)]) == gen, bar);
            __builtin_amdgcn_fence(__ATOMIC_ACQUIRE, "agent");
            asm volatile("s_waitcnt vmcnt(0)" ::: "memory");
        }
    }
    __syncthreads();
}

__global__ void __launch_bounds__(512, 2) hawk_fwd(Params p) {
    extern __shared__ __attribute__((aligned(16))) unsigned char lds_raw[];
    cg::grid_group grid = cg::this_grid();
    LAS unsigned char* lds = (LAS unsigned char*)lds_raw;
    const int G = gridDim.x, NGW = G * 8;
    { volatile LAS unsigned* xb_st0 = (volatile LAS unsigned*)(lds + (LDS_BYTES - 16)); if (threadIdx.x < 4) xb_st0[threadIdx.x] = 0u; }
    __syncthreads();
    volatile LAS unsigned* xb_st = (volatile LAS unsigned*)(lds + (LDS_BYTES - 16));
    (void)xcd_barrier_post((unsigned*)(p.ws + WS_CTL + 69632), xb_st);
    if (p.ws == nullptr) grid.sync();
#define XBAR() do { XcdBarrier xb_; xb_.bar = (unsigned*)(p.ws + WS_CTL + 69632); xb_.x = xb_xcc_id(); xb_.st = (volatile LAS unsigned*)(lds + (LDS_BYTES - 16)); xcd_barrier(xb_); } while (0)
    unsigned long long pr_acc = 0, pr_t = 0; (void)pr_acc; (void)pr_t;
#define PR_BEGIN(k) do { if constexpr ((PROBE_MASK >> (k)) & 1) pr_t = __builtin_amdgcn_s_memrealtime(); } while (0)
#define PR_END(k) do { if constexpr ((PROBE_MASK >> (k)) & 1) pr_acc += __builtin_amdgcn_s_memrealtime() - pr_t; } while (0)
#define PHASE_IDS int tid = threadIdx.x; asm volatile("" : "+v"(tid)); const int lane = tid & 63, wave = __builtin_amdgcn_readfirstlane(tid >> 6), gw = blockIdx.x * 8 + wave; (void)lane; (void)gw;

    PR_BEGIN(0);
    if constexpr ((PH_MASK >> 0) & 1) {
        PHASE_IDS
        LAS float* scr = (LAS float*)(lds + wave * 16384);
        constexpr int I_IN = (D / 64) * (DIN / 32), I_LB = 2;
        constexpr int NITEMS = I_IN + 32 * I_LB;
        for (int it = gw; it < NITEMS; it += NGW) {
            int r = it;
            if (r < I_IN) { p0_transpose_item(p.in[8], D, DIN, WIN, scr, r, lane); continue; } r -= I_IN;
            { const int which = r / (16 * I_LB), rr = r % (16 * I_LB), blk = rr / I_LB, item = rr % I_LB;
              p0_transpose_item((which ? p.in[13] : p.in[11]) + (size_t)blk * 4096, 64, 64, (which ? WXT : WAT) + (size_t)blk * 4096, scr, item, lane); }
        }
        if (blockIdx.x == 0) for (int d = tid; d < D; d += 512) C8T[d] = -8.f * log1pf(expf(-p.in[15][d]));
        for (int m = gw; m < MROWS; m += NGW)
            rms_row(m < MPR ? p.in[0] + (size_t)m * D : p.in[1] + (size_t)(m - MPR) * D, p.in[7], U1 + (size_t)m * D, lane);
    }
    XBAR();
    PR_END(0);

    PR_BEGIN(1);
    if constexpr ((PH_MASK >> 1) & 1) {
        {
            int tid = threadIdx.x; asm volatile("" : "+v"(tid));
            for (int un = blockIdx.x; un < 4 * (DIN / 128); un += G) {
                const int ru = un & 3, n0 = (un >> 2) * 128; float v[8];
                sgemm_tile<D>(U1 + (size_t)(MPR + 32 * ru) * D, WIN + (size_t)n0 * D, (LAS float*)lds, tid, v);
                const int r = MPR + 32 * ru + (tid >> 4), seg = n0 >> 10, cin = (tid & 15) * 8, c = (n0 & 1023) + cin;
                if (seg == 2 || seg == 3) {
                    float ss = 0.f;
#pragma unroll
                    for (int e = 0; e < 8; ++e) ss += v[e] * v[e];
                    const float rs = rsqrtf(sum16(ss) * (1.f / HD) + EPS);
                    float gn[8]; ld8f((seg == 2 ? p.in[16] : p.in[17]) + cin, gn);
#pragma unroll
                    for (int e = 0; e < 8; ++e) v[e] = v[e] * rs * gn[e];
                    if (seg == 3) { st8f(p.out + O_KS + (size_t)(r - MPR) * D + c, v); const int sb = (r - MPR) >> 4, t = (r - MPR) & 15, hh = (n0 & 1023) >> 7;
                        *(u32x4*)(KFs + (((size_t)(sb * NH + hh) * 8 + (cin >> 4)) * 512 + (t + 32 * ((cin >> 3) & 1)) * 8)) = pack8(v); }
                    else {
#pragma unroll
                        for (int e = 0; e < 8; ++e) v[e] *= 0.08838834764831845f;
                        *(u32x4*)(QN + (size_t)r * D + c) = pack8(v); }
                } else if (seg == 4) {
                    st8f(p.out + O_VS + (size_t)(r - MPR) * D + c, v);
                    const int sb = (r - MPR) >> 4, t = (r - MPR) & 15, hh = (n0 & 1023) >> 7;
                    bf16* vt = VFs + (((size_t)(sb * NH + hh) * 4 + (cin >> 5)) * 2 + 0) * 512 + ((cin & 31) + 32 * ((t >> 2) & 1)) * 8 + 4 * (t >> 3) + (t & 3); const u32x4 w = pack8(v);
                    vt[0] = (bf16)w.x; vt[8] = (bf16)(w.x >> 16); vt[16] = (bf16)w.y; vt[24] = (bf16)(w.y >> 16); vt[32] = (bf16)w.z; vt[40] = (bf16)(w.z >> 16); vt[48] = (bf16)w.w; vt[56] = (bf16)(w.w >> 16);
                } else {
                    if (seg == 1) {
#pragma unroll
                        for (int e = 0; e < 8; ++e) v[e] = gelu_f(v[e]);
                    } else if (seg >= 5) {
#pragma unroll
                        for (int e = 0; e < 8; ++e) v[e] = sigmoid_f(v[e]);
                    }
                    bf16* dst = (seg == 0) ? XR : (seg == 1) ? GG : (seg == 5) ? SG1 : SG2;
                    *(u32x4*)(dst + (size_t)r * D + c) = pack8(v);
                }
            }
        }
        pg8::Gemm g{U1, WIN, MPR, DIN, D}; pg8::StaticOrder S; S.init(MPR, DIN, G, (int)blockIdx.x);
        EpiIn E{XR, GG, QN, KF, VF, SG1, SG2, p.out, p.in[16], p.in[17], (LAS float*)(lds + LDS_SCR)};
        pg8::gemm_phase<EpiIn, pg8::StaticOrder, true, true>(lds, g, S, E);
    }
    XBAR();
    PR_END(1);

    PR_BEGIN(2);
    if constexpr ((PH_MASK >> 2) & 1) {
        PHASE_IDS
        constexpr int NA_P = BP * NH * (TP / 32), NA_S = BS * NH, NL = BP * (NCHUNK / 2) * 16;
        for (int su = blockIdx.x; su < NA_S; su += G) {
            const int b = su / NH, h = su % NH, r32 = lane & 31, hi = lane >> 5, kb = PAST / 32 - 1 - wave;
            LAS bf16x8* sl = (LAS bf16x8*)(lds + wave * 16384) + lane;
            const float* kp = p.in[2] + (((size_t)b * PAST + 32 * kb + r32) * NH + h) * HD + 8 * hi;
#pragma unroll
            for (int ks = 0; ks < 8; ++ks) { const f32x4 a = *(const f32x4*)(kp + 16 * ks), c = *(const f32x4*)(kp + 16 * ks + 4);
                u32x4 w; w.x = pk2(a.x, a.y); w.y = pk2(a.z, a.w); w.z = pk2(c.x, c.y); w.w = pk2(c.z, c.w); sl[ks * 64] = __builtin_bit_cast(bf16x8, w); }
#pragma unroll
            for (int f = 0; f < 8; ++f) {
                const int k0 = 32 * kb + 16 * (f & 1) + 4 * hi;
                const float* vp = p.in[3] + (((size_t)b * PAST + k0) * NH + h) * HD + (f >> 1) * 32 + r32;
                float e[8];
#pragma unroll
                for (int j = 0; j < 8; ++j) e[j] = vp[(size_t)(8 * (j >> 2) + (j & 3)) * (NH * HD)];
                u32x4 w; w.x = pk2(e[0], e[1]); w.y = pk2(e[2], e[3]); w.z = pk2(e[4], e[5]); w.w = pk2(e[6], e[7]); sl[512 + f * 64] = __builtin_bit_cast(bf16x8, w);
            }
            __syncthreads();
            if (wave == 0) { PR_BEGIN(9); attn_unit<true>(QN, KF, VF, KFs, VFs, p.in[2], p.in[3], QN, b, h, 0, lds + LDS_SCR, lds, lane); PR_END(9); }
            __syncthreads();
        }
        for (int it = gw; it < NA_P; it += NGW) {
            const int grp = it >> 3, bh = grp & (BP * NH - 1), qb = (TP / 32 - 1) - ((grp / (BP * NH)) * 8 + (it & 7)); attn_unit<false>(QN, KF, VF, KFs, VFs, p.in[2], p.in[3], QN, bh / NH, bh % NH, qb, lds + wave * WLDS, lds, lane); }
        PR_BEGIN(10);
        for (int r = gw; r < NL; r += NGW) lru_unit<false, false>(p, r / ((NCHUNK / 2) * 16), 2 * ((r / 16) % (NCHUNK / 2)), r % 16, lds + wave * WLDS, lane);
        PR_END(10);
        {
            const int nsb = (G > NA_S) ? NA_S : 0;
            if ((int)blockIdx.x >= nsb) {
                LAS float* scr = (LAS float*)(lds + wave * WLDS);
                constexpr int I_SQ = (D / 64) * (D / 32), I_UP = (D / 64) * (2 * DFF / 32), I_DN = (DFF / 64) * (D / 32);
                for (int it = gw - nsb * 8; it < 3 * I_SQ + I_UP + I_DN; it += NGW - nsb * 8) {
                    int r = it;
                    if (r < I_SQ) { p0_transpose_item(p.in[18], D, D, WPR, scr, r, lane); continue; } r -= I_SQ;
                    if (r < I_SQ) { p0_transpose_item(p.in[19], D, D, WPA, scr, r, lane); continue; } r -= I_SQ;
                    if (r < I_SQ) { p0_transpose_item(p.in[20], D, D, WOUT, scr, r, lane); continue; } r -= I_SQ;
                    if (r < I_UP) { p0_transpose_item(p.in[22], D, 2 * DFF, WUP, scr, r, lane); continue; } r -= I_UP;
                    p0_transpose_item(p.in[25], DFF, D, WDN, scr, r, lane);
                }
            }
        }
    }
    XBAR();
    PR_END(2);

    PR_BEGIN(3);
    if constexpr ((PH_MASK >> 3) & 1) {
        PHASE_IDS
        constexpr int NL = BP * (NCHUNK / 2) * 16, NLS = BS * 16;
        if (NGW == 2048) {
            const int q = (gw >> 4) & 31;
            if (q >= 30) { const int r = (q - 30) * 64 + (gw >> 9) * 16 + (gw & 15); lru_unit<true, true>(p, r / 16, 0, r % 16, lds + wave * WLDS, lane); }
            lru_final_light(p, gw / ((NCHUNK / 2) * 16), 2 * ((NCHUNK / 2 - 1) - q), gw % 16, lane);
        } else {
            for (int it = gw; it < NL + NLS; it += NGW) {
                if (it < NL) lru_final_light(p, it / ((NCHUNK / 2) * 16), 2 * ((NCHUNK / 2 - 1) - ((it / 16) % (NCHUNK / 2))), it % 16, lane);
                else { const int r = it - NL; lru_unit<true, true>(p, r / 16, 0, r % 16, lds + wave * WLDS, lane); }
            }
        }
    }
    XBAR();
    PR_END(3);

    PR_BEGIN(4);
    if constexpr ((PH_MASK >> 4) & 1) {
        {
            int tid = threadIdx.x; asm volatile("" : "+v"(tid));
            for (int un = blockIdx.x; un < 4 * (D / 128); un += G) {
                const int ru = un & 3, n0 = (un >> 2) * 128; float a[8], b2[8];
                sgemm_tile<D>(GG + (size_t)(MPR + 32 * ru) * D, WPR + (size_t)n0 * D, (LAS float*)lds, tid, a);
                sgemm_tile<D>(QN + (size_t)(MPR + 32 * ru) * D, WPA + (size_t)n0 * D, (LAS float*)lds, tid, b2);
                const size_t off = (size_t)(MPR + 32 * ru + (tid >> 4)) * D + n0 + (tid & 15) * 8;
                float g1[8], g2[8]; unpack8(*(const u32x4*)(SG1 + off), g1); unpack8(*(const u32x4*)(SG2 + off), g2);
#pragma unroll
                for (int e = 0; e < 8; ++e) a[e] = a[e] * g1[e] + b2[e] * g2[e];
                *(u32x4*)(MG + off) = pack8(a);
            }
        }
        static_assert(WS_S1 - WS_S0 == (size_t)(MP / 256) * 256 * D * 2 && WS_WPA - WS_WPR == (size_t)4 * 256 * D * 2, "operand adjacency the paired units rely on");
        PairOrder S; S.base.init(MPR, D, G, (int)blockIdx.x);
        pg8::Gemm g{GG, WPR, MPR, D, D}; EpiP4 E{EpiT1{SG1, T1}, EpiMG{SG2, T1, MG}};
        pg8::gemm_phase<EpiP4, PairOrder, true, true>(lds, g, S, E);
    }
    XBAR();
    PR_END(4);

    PR_BEGIN(5);
    if constexpr ((PH_MASK >> 5) & 1) {
        {
            int tid = threadIdx.x; asm volatile("" : "+v"(tid));
            for (int un = blockIdx.x; un < 4 * (D / 128); un += G) {
                const int ru = un & 3, n0 = (un >> 2) * 128; float v[8], xv[8], lv[8];
                sgemm_tile<D>(MG + (size_t)(MPR + 32 * ru) * D, WOUT + (size_t)n0 * D, (LAS float*)lds, tid, v);
                const int r = MPR + 32 * ru + (tid >> 4), col = n0 + (tid & 15) * 8;
                ld8f(p.in[1] + (size_t)(r - MPR) * D + col, xv); ld8f(p.in[21] + col, lv);
                float ss = 0.f;
#pragma unroll
                for (int e = 0; e < 8; ++e) { v[e] += xv[e]; ss += v[e] * v[e]; }
                st8f(p.out + (size_t)r * D + col, v);
#pragma unroll
                for (int e = 0; e < 8; ++e) v[e] *= lv[e];
                *(u32x4*)(U2 + (size_t)r * D + col) = pack8(v);
                ss = sum16(ss);
                if ((tid & 15) == 0) atomicAdd(SS2 + r, ss);
            }
        }
        pg8::Gemm g{MG, WOUT, MPR, D, D}; pg8::StaticOrder S; S.init(MPR, D, G, (int)blockIdx.x);
        EpiX1 E{p.in[0], p.in[1], p.in[21], p.out, U2, SS2};
        pg8::gemm_phase<EpiX1, pg8::StaticOrder, true, true>(lds, g, S, E);
    }
    XBAR();
    PR_END(5);

    PR_BEGIN(6);
    if constexpr ((PH_MASK >> 6) & 1) {
        {
            int tid = threadIdx.x; asm volatile("" : "+v"(tid));
            for (int un = blockIdx.x; un < 4 * (2 * DFF / 128); un += G) {
                const int ru = un & 3, n0 = (un >> 2) * 128; float v[8];
                sgemm_tile<D>(U2 + (size_t)(MPR + 32 * ru) * D, WUP + (size_t)n0 * D, (LAS float*)lds, tid, v);
                const int r = MPR + 32 * ru + (tid >> 4), col = n0 + (tid & 15) * 8;
                const float rs = rsqrtf(SS2[r] * (1.f / D) + EPS);
#pragma unroll
                for (int e = 0; e < 8; ++e) v[e] *= rs;
                bf16* dst = (col < DFF) ? GP + (size_t)r * DFF + col : VAL + (size_t)r * DFF + (col - DFF);
                *(u32x4*)dst = pack8(v);
            }
        }
        pg8::Gemm g{U2, WUP, MPR, 2 * DFF, D}; pg8::StaticOrder S; S.init(MPR, 2 * DFF, G, (int)blockIdx.x);
        EpiUp E{SS2, GP, VAL};
        pg8::gemm_phase<EpiUp, pg8::StaticOrder, true, true>(lds, g, S, E);
    }
    XBAR();
    PR_END(6);

    PR_BEGIN(7);
    if constexpr ((PH_MASK >> 7) & 1) {
        PHASE_IDS
        constexpr int NCC = DFF / 8, NITEMS = (MROWS / 16) * NCC;
        const float* fw = p.in[23]; const float* fb = p.in[24];
        for (int it = blockIdx.x * 512 + tid; it < NITEMS; it += G * 512) {
            const int rg = it / NCC, c0 = (it % NCC) * 8, r0 = rg * 16;
            float gm2[8], gm1[8], w0[8], w1[8], w2[8], bb[8];
#pragma unroll
            for (int e = 0; e < 8; ++e) { w0[e] = fw[c0 + e]; w1[e] = fw[DFF + c0 + e]; w2[e] = fw[2 * DFF + c0 + e]; bb[e] = fb[c0 + e]; gm2[e] = 0.f; gm1[e] = 0.f; }
            const bool smp = r0 >= MPR;
            if (smp) { const float* hs = p.in[6] + (size_t)((r0 - MPR) >> 4) * 2 * DFF + c0;
#pragma unroll
                for (int e = 0; e < 8; ++e) { gm2[e] = hs[e]; gm1[e] = hs[DFF + e]; } }
            else if ((r0 & (TP - 1)) != 0) { unpack8(*(const u32x4*)(GP + (size_t)(r0 - 2) * DFF + c0), gm2); unpack8(*(const u32x4*)(GP + (size_t)(r0 - 1) * DFF + c0), gm1); }
#pragma unroll 4
            for (int k = 0; k < 16; ++k) {
                float g2[8], vv[8]; const size_t off = (size_t)(r0 + k) * DFF + c0;
                unpack8(*(const u32x4*)(GP + off), g2); unpack8(*(const u32x4*)(VAL + off), vv);
                float hm[8];
#pragma unroll
                for (int e = 0; e < 8; ++e) { hm[e] = gelu_f(w0[e] * gm2[e] + w1[e] * gm1[e] + w2[e] * g2[e] + bb[e]) * vv[e]; gm2[e] = gm1[e]; gm1[e] = g2[e]; }
                u32x4 w; w.x = pk2(hm[0], hm[1]); w.y = pk2(hm[2], hm[3]); w.z = pk2(hm[4], hm[5]); w.w = pk2(hm[6], hm[7]);
                *(u32x4*)(VAL + off) = w;
            }
            if (smp || ((r0 + 16) & (TP - 1)) == 0) {
                float* o = p.out + (smp ? O_FCS + (size_t)((r0 - MPR) >> 4) * 2 * DFF : O_FCP + (size_t)(r0 >> 12) * 2 * DFF) + c0;
#pragma unroll
                for (int e = 0; e < 8; ++e) { o[e] = gm2[e]; o[DFF + e] = gm1[e]; }
            }
        }
    }
    XBAR();
    PR_END(7);

    PR_BEGIN(8);
    if constexpr ((PH_MASK >> 8) & 1) {
        {
            int tid = threadIdx.x; asm volatile("" : "+v"(tid));
            for (int un = blockIdx.x; un < 4 * (D / 128); un += G) {
                const int ru = un & 3, n0 = (un >> 2) * 128; float v[8], xv[8];
                sgemm_tile<DFF>(VAL + (size_t)(MPR + 32 * ru) * DFF, WDN + (size_t)n0 * DFF, (LAS float*)lds, tid, v);
                float* o = p.out + (size_t)(MPR + 32 * ru + (tid >> 4)) * D + n0 + (tid & 15) * 8;
                ld8f(o, xv);
#pragma unroll
                for (int e = 0; e < 8; ++e) v[e] += xv[e];
                st8f(o, v);
            }
        }
        pg8::Gemm g{VAL, WDN, MPR, D, DFF}; pg8::StaticOrder S; S.init(MPR, D, G, (int)blockIdx.x);
        EpiDown E{p.out};
        pg8::gemm_phase<EpiDown, pg8::StaticOrder, true, true>(lds, g, S, E);
    }
    PR_END(8);
    if constexpr (PROBE_MASK != 0) { const unsigned long long te = __builtin_amdgcn_s_memrealtime(); while (__builtin_amdgcn_s_memrealtime() - te < PROBE_MULT * pr_acc) __builtin_amdgcn_s_sleep(8); }
}

extern "C" void kernel_launch(void* const* d_in, const int* in_sizes, int n_in, void* d_out, int out_size, void* d_ws, size_t ws_size, hipStream_t stream) {
    static int grid = 0;
    if (grid == 0) {
        if (n_in != 26 || (size_t)out_size != O_END || ws_size < WS_END) { fprintf(stderr, "kernel_launch: unexpected shapes: n_in %d out %d ws %zu (need %zu)\n", n_in, out_size, ws_size, (size_t)WS_END); grid = -1; return; }
        int dev = 0, cus = 0, per_cu = 0;
        hipGetDevice(&dev); hipDeviceGetAttribute(&cus, hipDeviceAttributeMultiprocessorCount, dev);
        if (hipFuncSetAttribute((const void*)hawk_fwd, hipFuncAttributeMaxDynamicSharedMemorySize, LDS_BYTES) != hipSuccess) { fprintf(stderr, "kernel_launch: hipFuncSetAttribute failed\n"); grid = -1; return; }
        if (hipOccupancyMaxActiveBlocksPerMultiprocessor(&per_cu, (const void*)hawk_fwd, 512, LDS_BYTES) != hipSuccess || per_cu < 1) { fprintf(stderr, "kernel_launch: occupancy query gave %d\n", per_cu); (void)hipGetLastError(); per_cu = 1; }
        grid = cus * per_cu;
    }
    if (grid < 0) return;
    (void)hipMemsetAsync((char*)d_ws + WS_CTL, 0, 131072, stream);
    Params prm{};
    for (int i = 0; i < 26; ++i) prm.in[i] = (const float*)d_in[i];
    prm.out = (float*)d_out; prm.ws = (unsigned char*)d_ws;
    void* args[] = {&prm};
    hipError_t e = hipLaunchCooperativeKernel((const void*)hawk_fwd, dim3(grid), dim3(512), args, LDS_BYTES, stream);
    if (e != hipSuccess) fprintf(stderr, "cooperative launch failed: %s (grid %d)\n", hipGetErrorString(e), grid);
}
```
